# Optimizing an MI355X kernel written in HIP

```python
import math
import jax
import jax.numpy as jnp
from jax import lax
import numpy as np

D_MODEL = 1024
BATCH = 8
SEQ = 2048
DEPTH = 1
DEC_BATCH = 128
DEC_SEQ = 1
PAST_LEN = 16384
PAGE_SIZE = 128

D_MIX = 2 * D_MODEL
D_SSD = D_MIX // 2
SSD_HEAD_DIM = 64
SSD_HEADS = D_SSD // SSD_HEAD_DIM
SSD_GROUPS = 2
SSD_STATE = 128
SSD_CHUNK = 128
CONV_W = 4
CONV_DIM = D_SSD + 2 * SSD_GROUPS * SSD_STATE
D_S5 = D_MIX - D_SSD
S5_CH = 16
S5_GROUPS = D_S5 // S5_CH
S5_STATE = 64
D_IN_PROJ = D_SSD + CONV_DIM + SSD_HEADS + D_S5
N_MEM = 256
X_HEADS = 4
X_HEAD_DIM = D_MODEL // X_HEADS
D_FF = -(-8 * D_MODEL // (3 * 256)) * 256
EPS = 1e-6

kernel_name = 'hymba_ssd_s5_xattn_step'


def _rmsnorm(x, g):
    xf = x.astype(jnp.float32)
    y = xf * lax.rsqrt(jnp.mean(xf * xf, axis=-1, keepdims=True) + EPS)
    return (y * g.astype(jnp.float32)).astype(x.dtype)


def _causal_dwconv(x, conv_state, w, b):
    xp = jnp.concatenate([conv_state.astype(x.dtype), x], axis=1)
    y = lax.conv_general_dilated(xp, w[:, None, :].astype(x.dtype), window_strides=(1,),
                                 padding='VALID', dimension_numbers=('NWC', 'WIO', 'NWC'),
                                 feature_group_count=x.shape[-1])
    return y + b.astype(x.dtype), xp[:, -(CONV_W - 1):]


def _ssd_scan(x, dt, a, bm, cm, s0):
    f32 = jnp.float32
    bsz, l = x.shape[0], x.shape[1]
    q = min(SSD_CHUNK, l)
    pad = (-l) % q
    nc = (l + pad) // q
    g_, e_ = SSD_GROUPS, SSD_HEADS // SSD_GROUPS

    def padt(t):
        return jnp.pad(t.astype(f32), [(0, 0), (0, pad)] + [(0, 0)] * (t.ndim - 2))

    xc = padt(x).reshape(bsz, nc, q, g_, e_, SSD_HEAD_DIM)
    dtc = padt(dt).reshape(bsz, nc, q, g_, e_)
    bc = padt(bm).reshape(bsz, nc, q, g_, SSD_STATE)
    cc = padt(cm).reshape(bsz, nc, q, g_, SSD_STATE)
    acum = jnp.cumsum(dtc * a.astype(f32).reshape(g_, e_), axis=2)
    dtx = dtc[..., None] * xc
    at = jnp.moveaxis(acum, 2, -1)
    seg = at[..., :, None] - at[..., None, :]
    causal = jnp.tril(jnp.ones((q, q), dtype=bool))
    lmat = jnp.exp(jnp.where(causal, seg, -jnp.inf))
    cb = jnp.einsum('bcign,bcjgn->bcgij', cc, bc)
    y_diag = jnp.einsum('bcgij,bcgeij,bcjgep->bcigep', cb, lmat, dtx)
    decay_end = jnp.exp(acum[:, :, -1:] - acum)
    chunk_states = jnp.einsum('bcjgn,bcjge,bcjgep->bcgepn', bc, decay_end, dtx)
    chunk_decay = jnp.exp(acum[:, :, -1])

    def step(s, inp):
        cd, cs = inp
        return cd[..., None, None] * s + cs, s

    s_init = s0.astype(f32).reshape(bsz, g_, e_, SSD_HEAD_DIM, SSD_STATE)
    s_fin, prev = lax.scan(step, s_init, (jnp.moveaxis(chunk_decay, 1, 0),
                                          jnp.moveaxis(chunk_states, 1, 0)))
    prev = jnp.moveaxis(prev, 0, 1)
    y_off = jnp.einsum('bcign,bcgepn,bcige->bcigep', cc, prev, jnp.exp(acum))
    y = (y_diag + y_off).reshape(bsz, nc * q, SSD_HEADS, SSD_HEAD_DIM)[:, :l]
    return y, s_fin.reshape(bsz, SSD_HEADS, SSD_HEAD_DIM, SSD_STATE)


def _s5_combine(e1, e2):
    a1r, a1i, b1r, b1i = e1
    a2r, a2i, b2r, b2i = e2
    return (a1r * a2r - a1i * a2i, a1r * a2i + a1i * a2r,
            a2r * b1r - a2i * b1i + b2r, a2r * b1i + a2i * b1r + b2i)


def _s5_scan(u, s0_re, s0_im, lam_re, lam_im, log_step, b_re, b_im, c_re, c_im, d_s5):
    f32 = jnp.float32
    bsz, l = u.shape[0], u.shape[1]
    uf = u.astype(f32)
    ug = uf.reshape(bsz, l, S5_GROUPS, S5_CH)
    lr = lam_re.astype(f32)
    li = lam_im.astype(f32)
    step = jnp.exp(log_step.astype(f32))[:, None]
    mag = jnp.exp(lr * step)
    ang = li * step
    lb_re = mag * jnp.cos(ang)
    lb_im = mag * jnp.sin(ang)
    den = lr * lr + li * li
    k_re = ((lb_re - 1.0) * lr + lb_im * li) / den
    k_im = (lb_im * lr - (lb_re - 1.0) * li) / den
    br = b_re.astype(f32)
    bi = b_im.astype(f32)
    bb_re = k_re[..., None] * br - k_im[..., None] * bi
    bb_im = k_re[..., None] * bi + k_im[..., None] * br
    bu_re = jnp.einsum('gpc,blgc->blgp', bb_re, ug)
    bu_im = jnp.einsum('gpc,blgc->blgp', bb_im, ug)
    s0r = s0_re.astype(f32)
    s0i = s0_im.astype(f32)
    bu_re = bu_re.at[:, 0].add(lb_re * s0r - lb_im * s0i)
    bu_im = bu_im.at[:, 0].add(lb_re * s0i + lb_im * s0r)
    ar = jnp.broadcast_to(lb_re, bu_re.shape)
    ai = jnp.broadcast_to(lb_im, bu_re.shape)
    _, _, s_re, s_im = lax.associative_scan(_s5_combine, (ar, ai, bu_re, bu_im), axis=1)
    y = (jnp.einsum('gcp,blgp->blgc', c_re.astype(f32), s_re)
         - jnp.einsum('gcp,blgp->blgc', c_im.astype(f32), s_im))
    y = y.reshape(bsz, l, D_S5) + d_s5.astype(f32) * uf
    return y.astype(u.dtype), s_re[:, -1], s_im[:, -1]


def _cross_attend(h, mem_k, mem_v, w_xq, w_xo):
    bsz, l = h.shape[0], h.shape[1]
    q = (h @ w_xq).reshape(bsz, l, X_HEADS, X_HEAD_DIM)
    s = jnp.einsum('blhd,bmhd->bhlm', q, mem_k.astype(h.dtype)).astype(jnp.float32)
    p = jax.nn.softmax(s * (X_HEAD_DIM ** -0.5), axis=-1).astype(h.dtype)
    o = jnp.einsum('bhlm,bmhd->blhd', p, mem_v.astype(h.dtype)).reshape(bsz, l, D_MODEL)
    return o @ w_xo


def _block(x, mem_k, mem_v, conv_state, ssm_state, s5_re, s5_im,
           ln1_g, w_in, conv_w, conv_b, dt_bias, a_log, d_ssd, gn_g,
           lam_re, lam_im, log_step, b_re, b_im, c_re, c_im, d_s5, w_glu, b_glu,
           w_out, ln2_g, w_xq, w_xo, ln3_g, w_gate, w_up, w_down):
    f32 = jnp.float32
    bsz, l = x.shape[0], x.shape[1]
    h = _rmsnorm(x, ln1_g)
    proj = h @ w_in
    o1 = D_SSD
    o2 = o1 + CONV_DIM
    o3 = o2 + SSD_HEADS
    z = proj[..., :o1]
    xbc = proj[..., o1:o2]
    dt_raw = proj[..., o2:o3]
    u = proj[..., o3:]
    xbc, new_conv = _causal_dwconv(xbc, conv_state, conv_w, conv_b)
    xbc = jax.nn.silu(xbc)
    nb = SSD_GROUPS * SSD_STATE
    xs = xbc[..., :D_SSD].reshape(bsz, l, SSD_HEADS, SSD_HEAD_DIM)
    bm = xbc[..., D_SSD:D_SSD + nb].reshape(bsz, l, SSD_GROUPS, SSD_STATE)
    cm = xbc[..., D_SSD + nb:].reshape(bsz, l, SSD_GROUPS, SSD_STATE)
    dt = jax.nn.softplus(dt_raw.astype(f32) + dt_bias.astype(f32))
    a = -jnp.exp(a_log.astype(f32))
    y, new_ssm = _ssd_scan(xs, dt, a, bm, cm, ssm_state)
    y = y + d_ssd.astype(f32)[:, None] * xs.astype(f32)
    y = y.reshape(bsz, l, D_SSD) * jax.nn.silu(z.astype(f32))
    y_ssd = _rmsnorm(y, gn_g).astype(x.dtype)
    ys5, new_re, new_im = _s5_scan(u, s5_re, s5_im, lam_re, lam_im, log_step,
                                   b_re, b_im, c_re, c_im, d_s5)
    g = jax.nn.gelu(ys5)
    y_s5 = g * jax.nn.sigmoid(g @ w_glu + b_glu)
    x = x + jnp.concatenate([y_ssd, y_s5], axis=-1) @ w_out
    x = x + _cross_attend(_rmsnorm(x, ln2_g), mem_k, mem_v, w_xq, w_xo)
    hf = _rmsnorm(x, ln3_g)
    x = x + (jax.nn.silu(hf @ w_gate) * (hf @ w_up)) @ w_down
    return (x, new_conv, new_ssm.astype(ssm_state.dtype),
            new_re.astype(s5_re.dtype), new_im.astype(s5_im.dtype))


def setup_inputs(seed: int = 0) -> dict:
    key = jax.random.key(seed)
    ks = iter(jax.random.split(key, 64))
    f32 = jnp.float32

    def nrm(shape, scale=1.0):
        return jax.random.normal(next(ks), shape, f32) * scale

    def gain(shape):
        return 1.0 + 0.01 * jax.random.normal(next(ks), shape, f32)

    def log_uniform(shape, lo, hi):
        return jax.random.uniform(next(ks), shape, f32, math.log(lo), math.log(hi))

    dt0 = jnp.exp(log_uniform((DEPTH, SSD_HEADS), 1e-3, 1e-1))
    lam_im0 = math.pi * jnp.arange(S5_STATE, dtype=f32)
    inp = {}
    inp['x_prompt'] = nrm((BATCH, SEQ, D_MODEL))
    inp['x_sample'] = nrm((DEC_BATCH, DEC_SEQ, D_MODEL))
    inp['mem_prompt'] = nrm((BATCH, N_MEM, D_MODEL))
    inp['state_conv'] = nrm((DEPTH, DEC_BATCH, CONV_W - 1, CONV_DIM), 0.5)
    inp['state_ssm'] = nrm((DEPTH, DEC_BATCH, SSD_HEADS, SSD_HEAD_DIM, SSD_STATE), 0.1)
    inp['state_s5_re'] = nrm((DEPTH, DEC_BATCH, S5_GROUPS, S5_STATE), 0.5)
    inp['state_s5_im'] = nrm((DEPTH, DEC_BATCH, S5_GROUPS, S5_STATE), 0.5)
    inp['cache_mem_k'] = nrm((DEPTH, DEC_BATCH, N_MEM, X_HEADS, X_HEAD_DIM))
    inp['cache_mem_v'] = nrm((DEPTH, DEC_BATCH, N_MEM, X_HEADS, X_HEAD_DIM))
    inp['ln1_g'] = gain((DEPTH, D_MODEL))
    inp['w_in'] = nrm((DEPTH, D_MODEL, D_IN_PROJ), D_MODEL ** -0.5)
    inp['conv_w'] = nrm((DEPTH, CONV_W, CONV_DIM), CONV_W ** -0.5)
    inp['conv_b'] = nrm((DEPTH, CONV_DIM), 0.01)
    inp['dt_bias'] = dt0 + jnp.log(-jnp.expm1(-dt0))
    inp['a_log'] = jnp.log(jax.random.uniform(next(ks), (DEPTH, SSD_HEADS), f32, 1.0, 16.0))
    inp['d_ssd'] = gain((DEPTH, SSD_HEADS))
    inp['gn_g'] = gain((DEPTH, D_SSD))
    inp['lam_re'] = -0.5 + nrm((DEPTH, S5_GROUPS, S5_STATE), 0.01)
    inp['lam_im'] = lam_im0 + nrm((DEPTH, S5_GROUPS, S5_STATE), 0.01)
    inp['log_step'] = log_uniform((DEPTH, S5_GROUPS), 1e-3, 1e-1)
    inp['b_re'] = nrm((DEPTH, S5_GROUPS, S5_STATE, S5_CH), (2 * S5_CH) ** -0.5)
    inp['b_im'] = nrm((DEPTH, S5_GROUPS, S5_STATE, S5_CH), (2 * S5_CH) ** -0.5)
    inp['c_re'] = nrm((DEPTH, S5_GROUPS, S5_CH, S5_STATE), (2 * S5_STATE) ** -0.5)
    inp['c_im'] = nrm((DEPTH, S5_GROUPS, S5_CH, S5_STATE), (2 * S5_STATE) ** -0.5)
    inp['d_s5'] = nrm((DEPTH, D_S5))
    inp['w_glu'] = nrm((DEPTH, D_S5, D_S5), D_S5 ** -0.5)
    inp['b_glu'] = nrm((DEPTH, D_S5), 0.01)
    inp['w_out'] = nrm((DEPTH, D_MIX, D_MODEL), D_MIX ** -0.5)
    inp['ln2_g'] = gain((DEPTH, D_MODEL))
    inp['w_xq'] = nrm((DEPTH, D_MODEL, D_MODEL), D_MODEL ** -0.5)
    inp['w_xk'] = nrm((DEPTH, D_MODEL, D_MODEL), D_MODEL ** -0.5)
    inp['w_xv'] = nrm((DEPTH, D_MODEL, D_MODEL), D_MODEL ** -0.5)
    inp['w_xo'] = nrm((DEPTH, D_MODEL, D_MODEL), D_MODEL ** -0.5)
    inp['ln3_g'] = gain((DEPTH, D_MODEL))
    inp['w_gate'] = nrm((DEPTH, D_MODEL, D_FF), D_MODEL ** -0.5)
    inp['w_up'] = nrm((DEPTH, D_MODEL, D_FF), D_MODEL ** -0.5)
    inp['w_down'] = nrm((DEPTH, D_FF, D_MODEL), D_FF ** -0.5)
    inp['final_g'] = gain((D_MODEL,))
    return inp


def reference(x_prompt, x_sample, mem_prompt, state_conv, state_ssm, state_s5_re, state_s5_im,
              cache_mem_k, cache_mem_v, ln1_g, w_in, conv_w, conv_b, dt_bias, a_log, d_ssd, gn_g,
              lam_re, lam_im, log_step, b_re, b_im, c_re, c_im, d_s5, w_glu, b_glu, w_out,
              ln2_g, w_xq, w_xk, w_xv, w_xo, ln3_g, w_gate, w_up, w_down, final_g):
    bp = x_prompt.shape[0]
    dt_ = x_prompt.dtype
    hp = x_prompt
    hs = x_sample
    conv_p, ssm_p, re_p, im_p, mk_p, mv_p = [], [], [], [], [], []
    conv_s, ssm_s, re_s, im_s = [], [], [], []
    for i in range(DEPTH):
        lw = (ln1_g[i], w_in[i], conv_w[i], conv_b[i], dt_bias[i], a_log[i], d_ssd[i], gn_g[i],
              lam_re[i], lam_im[i], log_step[i], b_re[i], b_im[i], c_re[i], c_im[i], d_s5[i],
              w_glu[i], b_glu[i], w_out[i], ln2_g[i], w_xq[i], w_xo[i], ln3_g[i],
              w_gate[i], w_up[i], w_down[i])
        mk = (mem_prompt @ w_xk[i]).reshape(bp, N_MEM, X_HEADS, X_HEAD_DIM)
        mv = (mem_prompt @ w_xv[i]).reshape(bp, N_MEM, X_HEADS, X_HEAD_DIM)
        z_conv = jnp.zeros((bp, CONV_W - 1, CONV_DIM), dt_)
        z_ssm = jnp.zeros((bp, SSD_HEADS, SSD_HEAD_DIM, SSD_STATE), dt_)
        z_s5 = jnp.zeros((bp, S5_GROUPS, S5_STATE), dt_)
        hp, c1, s1, r1, m1 = _block(hp, mk, mv, z_conv, z_ssm, z_s5, z_s5, *lw)
        conv_p.append(c1)
        ssm_p.append(s1)
        re_p.append(r1)
        im_p.append(m1)
        mk_p.append(mk)
        mv_p.append(mv)
        hs, c2, s2, r2, m2 = _block(hs, cache_mem_k[i], cache_mem_v[i], state_conv[i], state_ssm[i],
                                    state_s5_re[i], state_s5_im[i], *lw)
        conv_s.append(c2)
        ssm_s.append(s2)
        re_s.append(r2)
        im_s.append(m2)
    y_prompt = _rmsnorm(hp, final_g)
    y_sample = _rmsnorm(hs, final_g)
    return (y_prompt, y_sample,
            jnp.stack(conv_p), jnp.stack(ssm_p), jnp.stack(re_p), jnp.stack(im_p),
            jnp.stack(mk_p), jnp.stack(mv_p),
            jnp.stack(conv_s), jnp.stack(ssm_s), jnp.stack(re_s), jnp.stack(im_s))
```

```cpp
#include <hip/hip_runtime.h>
#include <hip/hip_cooperative_groups.h>
#include <cstdio>
#include <cstdint>
namespace cg = cooperative_groups;

#ifndef MK_MULTI
#define MK_MULTI 0
#endif

#define DEVI __device__ __forceinline__
#define LAS __attribute__((address_space(3)))
typedef unsigned short bf16_t;
typedef short bf16x8 __attribute__((ext_vector_type(8)));
typedef float f32x4 __attribute__((ext_vector_type(4)));
typedef unsigned u32x4 __attribute__((ext_vector_type(4)));
typedef unsigned u32x2 __attribute__((ext_vector_type(2)));

constexpr int TP = 16384, TS = 128, TALL = 16640;
constexpr int DM = 1024, NPROJ = 3584, WIN_LD = 3600, DFF = 2816, CONVD = 1536;
constexpr float EPS = 1e-6f;
constexpr int S5LC = 64, S5NCH = 32;

constexpr size_t MiB = 1u << 20;
constexpr size_t WS_SSQ_SSD = 0, WS_SSQ1 = 128 * 1024, WS_SSQ2 = 256 * 1024, WS_SSQ3 = 384 * 1024, WS_LSUM = 512 * 1024, WS_ZERO_END = 896 * 1024;
constexpr size_t WS_DECAY = 896 * 1024;
constexpr size_t WS_BAR = 960 * 1024;
constexpr size_t WS_DTRAW = 1 * MiB;
constexpr size_t WS_WT_IN = 3 * MiB, WS_WT_GLU = 10 * MiB, WS_WT_OUT = 12 * MiB, WS_WT_XQ = 16 * MiB, WS_WT_KV = 18 * MiB, WS_WT_XO = 22 * MiB,
                 WS_WT_GU = 24 * MiB, WS_WT_DOWN = 35 * MiB;
constexpr size_t WS_KB = 41 * MiB, WS_VT = 45 * MiB, WS_MEMB = 49 * MiB, WS_S5END = 53 * MiB, WS_S5CAR = 61 * MiB;
constexpr size_t WS_PROJ = 70 * MiB, WS_MID = 70 * MiB;
constexpr size_t WS_HB = 184 * MiB, WS_X1B = 184 * MiB;
constexpr size_t WS_CS = 217 * MiB, WS_QB = 217 * MiB, WS_PB = 250 * MiB;
constexpr size_t WS_SIN = 281 * MiB, WS_OB = 283 * MiB;
constexpr size_t WS_CAT = 316 * MiB, WS_GB = 382 * MiB, WS_X1F = 415 * MiB, WS_END = 481 * MiB;

constexpr size_t O_YP = 0, O_YS = 16777216, O_CONVP = 16908288, O_SSMP = 16945152, O_S5RP = 17993728, O_S5IP = 18026496,
                 O_MEMK = 18059264, O_MEMV = 20156416, O_CONVS = 22253568, O_SSMS = 22843392, O_S5RS = 39620608, O_S5IS = 40144896;

constexpr int LDS_BYTES = 147456;
constexpr int MISC_OFF = 131072 + 8192;

struct Args { const float* in[38]; float* out; unsigned char* ws; int ph_lo, ph_hi; };
enum { I_XP = 0, I_XS, I_MEM, I_SCONV, I_SSSM, I_SS5R, I_SS5I, I_CK, I_CV, I_LN1, I_WIN, I_CONVW, I_CONVB, I_DTB, I_ALOG, I_DSSD, I_GN,
       I_LAMR, I_LAMI, I_LSTEP, I_BRE, I_BIM, I_CRE, I_CIM, I_DS5, I_WGLU, I_BGLU, I_WOUT, I_LN2, I_WXQ, I_WXK, I_WXV, I_WXO, I_LN3,
       I_WGATE, I_WUP, I_WDOWN, I_FING };

DEVI unsigned cvt_pk(float lo, float hi) { unsigned r; asm("v_cvt_pk_bf16_f32 %0, %1, %2" : "=v"(r) : "v"(lo), "v"(hi)); return r; }
DEVI bf16_t f2bf(float x) { return (bf16_t)(cvt_pk(x, 0.f) & 0xffffu); }
DEVI float bf2f(unsigned b) { return __uint_as_float(b << 16); }
DEVI float bflo(unsigned w) { return __uint_as_float(w << 16); }
DEVI float bfhi(unsigned w) { return __uint_as_float(w & 0xffff0000u); }
DEVI float rcp_(float x) { return __builtin_amdgcn_rcpf(x); }
DEVI float silu_(float x) { return x * rcp_(1.f + __expf(-x)); }
DEVI float sigmoid_(float x) { return rcp_(1.f + __expf(-x)); }
DEVI float gelu_(float x) { const float y = 0.7978845608f * (x + 0.044715f * x * x * x); const float t = 1.f - 2.f * rcp_(1.f + __expf(2.f * y)); return 0.5f * x * (1.f + t); }
DEVI float softplus_(float x) { return x > 20.f ? x : log1pf(expf(x)); }
DEVI float wave_sum(float v) {
#pragma unroll
    for (int o = 1; o < 64; o <<= 1) v += __shfl_xor(v, o);
    return v;
}
DEVI u32x4 pack8(const f32x4& a, const f32x4& b) { u32x4 w; w.x = cvt_pk(a[0], a[1]); w.y = cvt_pk(a[2], a[3]); w.z = cvt_pk(b[0], b[1]); w.w = cvt_pk(b[2], b[3]); return w; }
DEVI void unpack8(const u32x4& w, float* o) { o[0] = bflo(w.x); o[1] = bfhi(w.x); o[2] = bflo(w.y); o[3] = bfhi(w.y); o[4] = bflo(w.z); o[5] = bfhi(w.z); o[6] = bflo(w.w); o[7] = bfhi(w.w); }
#define LDS_WAIT() asm volatile("s_waitcnt lgkmcnt(0)" ::: "memory")

namespace pg8 {
constexpr int BM = 256, BK = 64, HALF = 128, HTB = HALF * BK * 2, STAGE_BYTES = 8 * HTB, NXCD = 8, WGM = 8;
DEVI int lds_byte(int r, int c) { const int st = (r >> 4) * 2 + (c >> 5), rr = r & 15, cc = c & 31, ob = rr * 64 + cc * 2; return st * 1024 + (ob ^ (((ob >> 9) & 1) << 5)); }
DEVI void stage_rc(int b, int& R, int& C) { const int st = b / 1024, sb = b % 1024, swz = sb ^ (((sb >> 9) & 1) << 5); R = (st >> 1) * 16 + swz / 64; C = (st & 1) * 32 + (swz % 64) / 2; }
DEVI int perm32(int rho) { const int n = rho >> 4, i = rho & 15; return 8 * (i >> 2) + 4 * n + (i & 3); }

struct Unit { int pm, pn; };
struct Gemm { const bf16_t* A; const bf16_t* Bt; int lda, ldb, K, mode; };
DEVI size_t a_off(const Gemm& g, const Unit& u) { size_t o = (size_t)u.pm * 256 * g.lda; if (g.mode) o += (size_t)u.pn * 256; return o * 2; }
DEVI size_t b_off(const Gemm& g, const Unit& u) {
    const size_t r = g.mode == 0 ? (size_t)u.pn : (g.mode == 1 ? (size_t)(u.pm >> 3) : (size_t)((u.pm >> 3) * 4 + u.pn));
    size_t o = r * 256 * g.ldb; if (g.mode == 1) o += (size_t)u.pn * 256; return o * 2;
}
struct StaticOrder {
    int nM, nN, nwg, G, c;
    DEVI void init(int nM_, int nN_, int G_, int c_) { nM = nM_; nN = nN_; nwg = nM * nN; G = G_; c = c_; }
    DEVI bool next(int i, Unit& u) const {
        const long L = (long)i * G + c; if (L >= nwg) return false;
        int wgid = (int)L; { const int q = nwg / NXCD, r = nwg % NXCD, xcd = wgid % NXCD, off = wgid / NXCD; wgid = (xcd < r ? xcd * (q + 1) : r * (q + 1) + (xcd - r) * q) + off; }
        const int nig = WGM * nN, gid = wgid / nig, fm = gid * WGM, gsz = (nM - fm) < WGM ? (nM - fm) : WGM;
        u.pm = fm + ((wgid % nig) % gsz); u.pn = (wgid % nig) / gsz; return true;
    }
};

template <class F> struct EpiRow {
    F f;
    DEVI void operator()(const f32x4 (&acc)[2][2][4][2], const Unit& u, int wr, int wc, int fr, int fq) const {
        const int c8 = wc * 32 + 8 * fq;
#pragma unroll
        for (int ai = 0; ai < 2; ++ai)
#pragma unroll
            for (int m = 0; m < 4; ++m) {
                const int row = u.pm * BM + ai * HALF + wr * 64 + m * 16 + fr;
                f(row, u.pn, c8, acc[ai][0][m][0], acc[ai][0][m][1], acc[ai][1][m][0], acc[ai][1][m][1]);
            }
    }
};

template <class Epi, class Sched>
DEVI void gemm_phase(LAS unsigned char* lds, const Gemm g, const Sched& S, const Epi& E) {
    const int tid = threadIdx.x, wid = __builtin_amdgcn_readfirstlane(tid >> 6), lane = tid & 63, wr = wid >> 2, wc = wid & 3, fr = lane & 15, fq = lane >> 4;
    const int K = g.K, nt = K / BK;
    unsigned voffA[2], voffB[2];
#pragma unroll
    for (int i = 0; i < 2; ++i) { int R, C; stage_rc(tid * 16 + i * 8192, R, C); const int Rb = (R & ~31) + perm32(R & 31);
        voffA[i] = (unsigned)(R * g.lda + C) * 2u; voffB[i] = (unsigned)(Rb * g.ldb + C) * 2u; }
    const size_t kstep = (size_t)(BK * 2);
    const size_t hsA = (size_t)HALF * g.lda * 2, hsB = (size_t)HALF * g.ldb * 2;
    const unsigned ldsw = (unsigned)wid * 1024u;
    const int aoff = lds_byte(wr * 64 + fr, fq * 8), boff = lds_byte(wc * 32 + fr, fq * 8);
#define PG8_SA(b, h) (((b) * 2 + (h)) * HTB)
#define PG8_SB(b, h) ((4 + (b) * 2 + (h)) * HTB)
#define PG8_STAGE(bufoff, gbase, voff) do { _Pragma("unroll") for (int _i = 0; _i < 2; ++_i) \
        __builtin_amdgcn_global_load_lds((const unsigned*)((const char*)(gbase) + (voff)[_i]), (LAS unsigned*)(lds + (bufoff) + ldsw + _i * 8192), 16, 0, 0); } while (0)
#define PG8_LDA(dst, b, h) do { _Pragma("unroll") for (int m = 0; m < 4; ++m) _Pragma("unroll") for (int k = 0; k < 2; ++k) dst[m][k] = *(const LAS bf16x8*)(lds + PG8_SA(b, h) + aoff + m * 2048 + k * 1024); } while (0)
#define PG8_LDB(dst, b, h) do { _Pragma("unroll") for (int n = 0; n < 2; ++n) _Pragma("unroll") for (int k = 0; k < 2; ++k) dst[n][k] = *(const LAS bf16x8*)(lds + PG8_SB(b, h) + boff + n * 2048 + k * 1024); } while (0)
#define PG8_MMA(ai, bj, At, Bt) do { __builtin_amdgcn_s_setprio(1); _Pragma("unroll") for (int m = 0; m < 4; ++m) _Pragma("unroll") for (int n = 0; n < 2; ++n) _Pragma("unroll") for (int k = 0; k < 2; ++k) \
        acc[ai][bj][m][n] = __builtin_amdgcn_mfma_f32_16x16x32_bf16(Bt[n][k], At[m][k], acc[ai][bj][m][n], 0, 0, 0); __builtin_amdgcn_s_setprio(0); } while (0)
#define PG8_WAIT_V(n) asm volatile("s_waitcnt vmcnt(" #n ")" ::: "memory")
#define PG8_WAIT_L(n) asm volatile("s_waitcnt lgkmcnt(" #n ")" ::: "memory")
#define PG8_BAR __builtin_amdgcn_s_barrier()
#define PG8_SCHED __builtin_amdgcn_sched_barrier(0)
    Unit cur, nxt; int ui = 0;
    if (!S.next(0, cur)) return;
    f32x4 acc[2][2][4][2];
#pragma unroll
    for (int a = 0; a < 2; ++a)
#pragma unroll
        for (int b = 0; b < 2; ++b)
#pragma unroll
            for (int m = 0; m < 4; ++m)
#pragma unroll
                for (int n = 0; n < 2; ++n) acc[a][b][m][n] = (f32x4){0.f, 0.f, 0.f, 0.f};
    bf16x8 At[4][2], B0[2][2], B1[2][2];
    const char* cA = (const char*)g.A + a_off(g, cur); const char* cB = (const char*)g.Bt + b_off(g, cur);
    PG8_STAGE(PG8_SB(0, 0), cB, voffB); PG8_STAGE(PG8_SB(0, 1), cB + hsB, voffB); PG8_STAGE(PG8_SA(0, 0), cA, voffA); PG8_STAGE(PG8_SA(0, 1), cA + hsA, voffA);
    if (wr == 1) PG8_BAR;
    PG8_WAIT_V(2); PG8_BAR;
    PG8_STAGE(PG8_SB(1, 0), cB + kstep, voffB); PG8_STAGE(PG8_SA(1, 0), cA + kstep, voffA); PG8_STAGE(PG8_SB(1, 1), cB + hsB + kstep, voffB);
    PG8_WAIT_V(6); PG8_BAR;
    for (;;) {
        const bool has_next = S.next(ui + 1, nxt);
        const char* nA = has_next ? (const char*)g.A + a_off(g, nxt) : cA; const char* nB = has_next ? (const char*)g.Bt + b_off(g, nxt) : cB;
        for (int t = 0; t < nt; t += 2) {
            const bool last = (t == nt - 2);
            const char* a1 = cA + (size_t)(t + 1) * kstep;
            const char* a2 = last ? nA : cA + (size_t)(t + 2) * kstep; const char* b2 = last ? nB : cB + (size_t)(t + 2) * kstep;
            const char* a3 = a2 + kstep; const char* b3 = b2 + kstep;
            PG8_LDB(B0, 0, 0); PG8_LDB(B1, 0, 1); PG8_SCHED; PG8_LDA(At, 0, 0); PG8_STAGE(PG8_SA(1, 1), a1 + hsA, voffA);
            PG8_WAIT_V(8); PG8_WAIT_L(0); PG8_BAR; PG8_MMA(0, 0, At, B0); PG8_MMA(0, 1, At, B1); PG8_BAR; PG8_SCHED;
            PG8_LDA(At, 0, 1); PG8_STAGE(PG8_SB(0, 0), b2, voffB); PG8_STAGE(PG8_SB(0, 1), b2 + hsB, voffB); PG8_STAGE(PG8_SA(0, 0), a2, voffA);
            PG8_WAIT_V(8); PG8_WAIT_L(0); PG8_BAR; PG8_MMA(1, 0, At, B0); PG8_MMA(1, 1, At, B1); PG8_BAR; PG8_SCHED;
            PG8_LDB(B0, 1, 0); PG8_LDB(B1, 1, 1); PG8_SCHED; PG8_LDA(At, 1, 0); PG8_STAGE(PG8_SA(0, 1), a2 + hsA, voffA);
            PG8_WAIT_V(8); PG8_WAIT_L(0); PG8_BAR; PG8_MMA(0, 0, At, B0); PG8_MMA(0, 1, At, B1); PG8_BAR; PG8_SCHED;
            PG8_LDA(At, 1, 1); PG8_STAGE(PG8_SB(1, 0), b3, voffB); PG8_STAGE(PG8_SB(1, 1), b3 + hsB, voffB); PG8_STAGE(PG8_SA(1, 0), a3, voffA);
            PG8_WAIT_V(8); PG8_WAIT_L(0); PG8_BAR; PG8_MMA(1, 0, At, B0); PG8_MMA(1, 1, At, B1); PG8_BAR; PG8_SCHED;
        }
        if (wr == 0) PG8_BAR;
        E(acc, cur, wr, wc, fr, fq);
        if (!has_next) break;
#pragma unroll
        for (int a = 0; a < 2; ++a)
#pragma unroll
            for (int b = 0; b < 2; ++b)
#pragma unroll
                for (int m = 0; m < 4; ++m)
#pragma unroll
                    for (int n = 0; n < 2; ++n) acc[a][b][m][n] = (f32x4){0.f, 0.f, 0.f, 0.f};
        cur = nxt; cA = nA; cB = nB; ++ui;
        if (wr == 1) PG8_BAR;
    }
    PG8_WAIT_V(0);
    PG8_BAR;
#undef PG8_SA
#undef PG8_SB
#undef PG8_STAGE
#undef PG8_LDA
#undef PG8_LDB
#undef PG8_MMA
#undef PG8_WAIT_V
#undef PG8_WAIT_L
#undef PG8_BAR
#undef PG8_SCHED
}
}

struct FIn {
    bf16_t* proj; float* convP; float* convS;
    DEVI void operator()(int row, int pn, int c8, const f32x4& a0, const f32x4& a1, const f32x4& b0, const f32x4& b1) const {
#pragma unroll
        for (int bj = 0; bj < 2; ++bj) {
            const int col = pn * 256 + bj * 128 + c8; const f32x4 v0 = bj ? b0 : a0, v1 = bj ? b1 : a1;
            *(u32x4*)(proj + (size_t)row * NPROJ + col) = pack8(v0, v1);
            if (col >= 1024 && col < 2560) {
                float* dst = nullptr;
                if (row < TP) { const int t = row & 2047; if (t >= 2045) dst = convP + ((size_t)(row >> 11) * 3 + (t - 2045)) * CONVD + (col - 1024); }
                else if (row < TP + TS) dst = convS + ((size_t)(row - TP) * 3 + 2) * CONVD + (col - 1024);
                if (dst) { *(f32x4*)dst = v0; *(f32x4*)(dst + 4) = v1; }
            }
        }
    }
};
struct FKV {
    float* outk; float* outv; bf16_t* kb; bf16_t* vt;
    DEVI void operator()(int row, int pn, int c8, const f32x4& a0, const f32x4& a1, const f32x4& b0, const f32x4& b1) const {
#pragma unroll
        for (int bj = 0; bj < 2; ++bj) {
            const int col = pn * 256 + bj * 128 + c8; const f32x4 v0 = bj ? b0 : a0, v1 = bj ? b1 : a1;
            if (col < 1024) {
                float* d = outk + (size_t)row * 1024 + col; *(f32x4*)d = v0; *(f32x4*)(d + 4) = v1;
                *(u32x4*)(kb + (size_t)row * 1024 + col) = pack8(v0, v1);
            } else {
                const int c = col - 1024; float* d = outv + (size_t)row * 1024 + c; *(f32x4*)d = v0; *(f32x4*)(d + 4) = v1;
                const int b = row >> 8, m = row & 255, h = c >> 8, dd = c & 255;
                bf16_t* t = vt + ((size_t)(b * 4 + h) * 256 + dd) * 256 + m;
#pragma unroll
                for (int j = 0; j < 4; ++j) { t[(size_t)j * 256] = f2bf(v0[j]); t[(size_t)(j + 4) * 256] = f2bf(v1[j]); }
            }
        }
    }
};
struct FGlu {
    const bf16_t* gb; const float* bglu; bf16_t* cat; const float* ssq;
    DEVI void operator()(int row, int pn, int c8, const f32x4& a0, const f32x4& a1, const f32x4& b0, const f32x4& b1) const {
        const float rs = rsqrtf(ssq[row] * (1.f / 1024.f) + EPS);
#pragma unroll
        for (int bj = 0; bj < 2; ++bj) {
            const int col = pn * 256 + bj * 128 + c8; const f32x4 v0 = bj ? b0 : a0, v1 = bj ? b1 : a1;
            float g[8]; unpack8(*(const u32x4*)(gb + (size_t)row * 1024 + col), g);
            const f32x4 bb0 = *(const f32x4*)(bglu + col), bb1 = *(const f32x4*)(bglu + col + 4);
            f32x4 y0, y1;
#pragma unroll
            for (int j = 0; j < 4; ++j) { y0[j] = g[j] * sigmoid_(v0[j] + bb0[j]); y1[j] = g[4 + j] * sigmoid_(v1[j] + bb1[j]); }
            *(u32x4*)(cat + (size_t)row * 2048 + 1024 + col) = pack8(y0, y1);
            bf16_t* yp = cat + (size_t)row * 2048 + col;
            float yr[8]; unpack8(*(const u32x4*)yp, yr);
            f32x4 z0, z1;
#pragma unroll
            for (int j = 0; j < 4; ++j) { z0[j] = yr[j] * rs; z1[j] = yr[4 + j] * rs; }
            *(u32x4*)yp = pack8(z0, z1);
        }
    }
};
struct FRes {
    const float* baseP; const float* baseS; float* outP; float* outS; bf16_t* outb; float* ssq;
    DEVI void operator()(int row, int pn, int c8, const f32x4& a0, const f32x4& a1, const f32x4& b0, const f32x4& b1) const {
        const bool valid = row < TP + TS;
        const float* base = row < TP ? baseP + (size_t)row * 1024 : baseS + (size_t)(row - TP) * 1024;
        float* out = row < TP ? outP + (size_t)row * 1024 : outS + (size_t)(row - TP) * 1024;
        float ss = 0.f;
        if (valid) {
#pragma unroll
            for (int bj = 0; bj < 2; ++bj) {
                const int col = pn * 256 + bj * 128 + c8; const f32x4 v0 = bj ? b0 : a0, v1 = bj ? b1 : a1;
                const f32x4 x0 = *(const f32x4*)(base + col) + v0, x1 = *(const f32x4*)(base + col + 4) + v1;
                *(f32x4*)(out + col) = x0; *(f32x4*)(out + col + 4) = x1;
                if (outb) *(u32x4*)(outb + (size_t)row * 1024 + col) = pack8(x0, x1);
                ss += (x0[0] * x0[0] + x0[1] * x0[1]) + (x0[2] * x0[2] + x0[3] * x0[3]) + (x1[0] * x1[0] + x1[1] * x1[1]) + (x1[2] * x1[2] + x1[3] * x1[3]);
            }
        }
        ss += __shfl_xor(ss, 16); ss += __shfl_xor(ss, 32);
        if (valid && ((c8 >> 3) & 3) == 0) atomicAdd(ssq + row, ss);
    }
};
struct FQ {
    bf16_t* qb; const float* ssq;
    DEVI void operator()(int row, int pn, int c8, const f32x4& a0, const f32x4& a1, const f32x4& b0, const f32x4& b1) const {
        const float rs = rsqrtf(ssq[row] * (1.f / 1024.f) + EPS) * 0.0625f;
        *(u32x4*)(qb + (size_t)row * 1024 + pn * 256 + c8) = pack8(a0 * rs, a1 * rs);
        *(u32x4*)(qb + (size_t)row * 1024 + pn * 256 + 128 + c8) = pack8(b0 * rs, b1 * rs);
    }
};
struct FS {
    bf16_t* pb; float* lsum;
    DEVI void operator()(int row, int pn, int c8, const f32x4& a0, const f32x4& a1, const f32x4& b0, const f32x4& b1) const {
        float ls = 0.f;
#pragma unroll
        for (int bj = 0; bj < 2; ++bj) {
            const f32x4 v0 = bj ? b0 : a0, v1 = bj ? b1 : a1; f32x4 e0, e1;
#pragma unroll
            for (int j = 0; j < 4; ++j) { e0[j] = __expf(v0[j]); e1[j] = __expf(v1[j]); }
            const u32x4 w = pack8(e0, e1);
            *(u32x4*)(pb + (size_t)row * 1024 + pn * 256 + bj * 128 + c8) = w;
            ls += (bflo(w.x) + bfhi(w.x)) + (bflo(w.y) + bfhi(w.y)) + (bflo(w.z) + bfhi(w.z)) + (bflo(w.w) + bfhi(w.w));
        }
        ls += __shfl_xor(ls, 16); ls += __shfl_xor(ls, 32);
        if (((c8 >> 3) & 3) == 0) atomicAdd(lsum + (size_t)row * 4 + pn, ls);
    }
};
struct FPV {
    bf16_t* ob; const float* lsum;
    DEVI void operator()(int row, int pn, int c8, const f32x4& a0, const f32x4& a1, const f32x4& b0, const f32x4& b1) const {
        const float inv = 1.f / lsum[(size_t)row * 4 + pn];
        *(u32x4*)(ob + (size_t)row * 1024 + pn * 256 + c8) = pack8(a0 * inv, a1 * inv);
        *(u32x4*)(ob + (size_t)row * 1024 + pn * 256 + 128 + c8) = pack8(b0 * inv, b1 * inv);
    }
};
struct FUp {
    bf16_t* mid; const float* ssq;
    DEVI void operator()(int row, int pn, int c8, const f32x4& a0, const f32x4& a1, const f32x4& b0, const f32x4& b1) const {
        const float rs = rsqrtf(ssq[row] * (1.f / 1024.f) + EPS);
        f32x4 y0, y1;
#pragma unroll
        for (int j = 0; j < 4; ++j) { y0[j] = silu_(a0[j] * rs) * (b0[j] * rs); y1[j] = silu_(a1[j] * rs) * (b1[j] * rs); }
        *(u32x4*)(mid + (size_t)row * DFF + pn * 128 + c8) = pack8(y0, y1);
    }
};

#define XB_TMO      128
#define XB_XCNT(j)  (256  + 64 * (j))
#define XB_XSUB(j)  (1280 + 64 * (j))
#define XB_XGEN(j)  (2304 + 64 * (j))
#define XB_TOP      3328
#define XB_TOPGEN   3392
#define XCD_BAR_WORDS 3456
#define XB_SPIN_CAP (1u << 22)
DEVI unsigned xb_ld(unsigned* p)              { return __hip_atomic_load(p, __ATOMIC_RELAXED, __HIP_MEMORY_SCOPE_AGENT); }
DEVI unsigned xb_add(unsigned* p, unsigned v) { return __hip_atomic_fetch_add(p, v, __ATOMIC_RELAXED, __HIP_MEMORY_SCOPE_AGENT); }
DEVI unsigned xb_xcc_id() { return (unsigned)__builtin_amdgcn_s_getreg((3 << 11) | 20) & 0xFu; }
#define XB_SPIN(cond, bar) do { unsigned _sp = 0; while (cond) { __builtin_amdgcn_s_sleep(1); \
    if ((++_sp & 255u) == 0u) { if (xb_ld(&(bar)[XB_TMO])) break; if (_sp > XB_SPIN_CAP) { atomicAdd(&(bar)[XB_TMO], 1u); break; } } } } while (0)
struct XcdBarrier { unsigned* bar; unsigned x; volatile LAS unsigned* st; };
DEVI XcdBarrier xcd_barrier_post(unsigned* bar, volatile LAS unsigned* st) {
    XcdBarrier b; b.bar = bar; b.x = xb_xcc_id(); b.st = st;
    if (threadIdx.x == 0) (void)xb_add(&bar[XB_XCNT(b.x)], 1u);
    return b;
}
DEVI void xcd_barrier_complete(unsigned* bar, unsigned x, unsigned& nloc, unsigned& nx) {
    const unsigned G = gridDim.x * gridDim.y * gridDim.z;
    unsigned sum, cnt, mine, sp = 0u;
    for (;;) {
        sum = 0u; cnt = 0u; mine = 0u;
#pragma unroll
        for (unsigned j = 0; j < 16; ++j) { const unsigned c = xb_ld(&bar[XB_XCNT(j)]); sum += c; cnt += (c > 0u) ? 1u : 0u; mine = (j == x) ? c : mine; }
        if (sum == G) break;
        __builtin_amdgcn_s_sleep(1);
        if ((++sp & 255u) == 0u) { if (xb_ld(&bar[XB_TMO])) break; if (sp > XB_SPIN_CAP) { atomicAdd(&bar[XB_TMO], 1u); break; } }
    }
    nloc = mine > 0u ? mine : 1u; nx = cnt > 0u ? cnt : 1u;
}
DEVI void xcd_barrier(const XcdBarrier& b) {
    asm volatile("s_waitcnt vmcnt(0)" ::: "memory");
    __syncthreads();
    if (threadIdx.x == 0) {
        unsigned* bar = b.bar;
        __builtin_amdgcn_s_waitcnt(0);
        unsigned nloc = b.st[0], nx = b.st[1];
        if (nloc == 0u) { xcd_barrier_complete(bar, b.x, nloc, nx); b.st[0] = nloc; b.st[1] = nx; }
        const unsigned old = xb_add(&bar[XB_XSUB(b.x)], 1u);
        const unsigned gen = old / nloc;
        if (old + 1u == (gen + 1u) * nloc) {
            __builtin_amdgcn_fence(__ATOMIC_RELEASE, "agent");
            asm volatile("s_waitcnt vmcnt(0)" ::: "memory");
            const unsigned og = xb_add(&bar[XB_TOP], 1u);
            const unsigned tg = og / nx;
            if (og + 1u == (tg + 1u) * nx) xb_add(&bar[XB_TOPGEN], 1u);
            else XB_SPIN(xb_ld(&bar[XB_TOPGEN]) == tg, bar);
            __builtin_amdgcn_fence(__ATOMIC_ACQUIRE, "agent");
            xb_add(&bar[XB_XGEN(b.x)], 1u);
            asm volatile("s_waitcnt vmcnt(0)" ::: "memory");
        } else {
            XB_SPIN(xb_ld(&bar[XB_XGEN(b.x)]) == gen, bar);
            __builtin_amdgcn_fence(__ATOMIC_ACQUIRE, "agent");
            asm volatile("s_waitcnt vmcnt(0)" ::: "memory");
        }
    }
    __syncthreads();
}

DEVI void tr_item(const float* W, int ldw, int K, bf16_t* WT, int dst_row, const float* scale, int slim, LAS float* scr, int k0, int n_src0, int lane) {
#pragma unroll 8
    for (int i = 0; i < 32; ++i) { const int kk = 2 * i + (lane >> 5); float v = W[(size_t)(k0 + kk) * ldw + n_src0 + (lane & 31)];
        if (scale && (k0 + kk) < slim) v *= scale[k0 + kk]; scr[kk * 33 + (lane & 31)] = v; }
    LDS_WAIT();
    const int c = lane & 7;
#pragma unroll
    for (int j = 0; j < 4; ++j) { const int n = (lane >> 3) + 8 * j; const LAS float* s = scr + (8 * c) * 33 + n;
        u32x4 o; o.x = cvt_pk(s[0 * 33], s[1 * 33]); o.y = cvt_pk(s[2 * 33], s[3 * 33]); o.z = cvt_pk(s[4 * 33], s[5 * 33]); o.w = cvt_pk(s[6 * 33], s[7 * 33]);
        *(u32x4*)(WT + (size_t)(dst_row + n) * K + k0 + 8 * c) = o; }
    LDS_WAIT();
}
DEVI void p0_prologue(const Args& a, LAS unsigned char* L, int tid, int lane, int wave) {
    unsigned char* ws = a.ws;
    const int G = gridDim.x, gw = blockIdx.x * 8 + wave, NGW = G * 8, gt = blockIdx.x * 512 + tid, NT = G * 512;
    for (int i = gt; i < (int)(WS_ZERO_END / 16); i += NT) ((u32x4*)ws)[i] = (u32x4){0u, 0u, 0u, 0u};
    LAS float* scr = (LAS float*)(L + wave * 8448);
    constexpr int J0 = 16 * 80, J1 = 16 * 32, J2 = 512, J3 = 32 * 32, J4 = 512, J5 = 512, J6 = 512, J7 = 512, J8 = 16 * 88, J9 = 16 * 88, J10 = 44 * 32;
    constexpr int NIT = J0 + J1 + J2 + J3 + J4 + J5 + J6 + J7 + J8 + J9 + J10;
    for (int it = gw; it < NIT; it += NGW) {
        int r = it;
        if (r < J0) { tr_item(a.in[I_WIN], WIN_LD, 1024, (bf16_t*)(ws + WS_WT_IN), (r % 80) * 32, nullptr, 0, scr, (r / 80) * 64, (r % 80) * 32, lane); continue; } r -= J0;
        if (r < J1) { tr_item(a.in[I_WIN], WIN_LD, 1024, (bf16_t*)(ws + WS_WT_IN), 2560 + (r % 32) * 32, nullptr, 0, scr, (r / 32) * 64, 2576 + (r % 32) * 32, lane); continue; } r -= J1;
        if (r < J2) { tr_item(a.in[I_WGLU], 1024, 1024, (bf16_t*)(ws + WS_WT_GLU), (r % 32) * 32, nullptr, 0, scr, (r / 32) * 64, (r % 32) * 32, lane); continue; } r -= J2;
        if (r < J3) { tr_item(a.in[I_WOUT], 1024, 2048, (bf16_t*)(ws + WS_WT_OUT), (r % 32) * 32, a.in[I_GN], 1024, scr, (r / 32) * 64, (r % 32) * 32, lane); continue; } r -= J3;
        if (r < J4) { tr_item(a.in[I_WXQ], 1024, 1024, (bf16_t*)(ws + WS_WT_XQ), (r % 32) * 32, a.in[I_LN2], 1024, scr, (r / 32) * 64, (r % 32) * 32, lane); continue; } r -= J4;
        if (r < J5) { tr_item(a.in[I_WXK], 1024, 1024, (bf16_t*)(ws + WS_WT_KV), (r % 32) * 32, nullptr, 0, scr, (r / 32) * 64, (r % 32) * 32, lane); continue; } r -= J5;
        if (r < J6) { tr_item(a.in[I_WXV], 1024, 1024, (bf16_t*)(ws + WS_WT_KV), 1024 + (r % 32) * 32, nullptr, 0, scr, (r / 32) * 64, (r % 32) * 32, lane); continue; } r -= J6;
        if (r < J7) { tr_item(a.in[I_WXO], 1024, 1024, (bf16_t*)(ws + WS_WT_XO), (r % 32) * 32, nullptr, 0, scr, (r / 32) * 64, (r % 32) * 32, lane); continue; } r -= J7;
        if (r < J8) { const int n0 = (r % 88) * 32; tr_item(a.in[I_WGATE], DFF, 1024, (bf16_t*)(ws + WS_WT_GU), (n0 >> 7) * 256 + (n0 & 127), a.in[I_LN3], 1024, scr, (r / 88) * 64, n0, lane); continue; } r -= J8;
        if (r < J9) { const int n0 = (r % 88) * 32; tr_item(a.in[I_WUP], DFF, 1024, (bf16_t*)(ws + WS_WT_GU), (n0 >> 7) * 256 + 128 + (n0 & 127), a.in[I_LN3], 1024, scr, (r / 88) * 64, n0, lane); continue; } r -= J9;
        tr_item(a.in[I_WDOWN], 1024, DFF, (bf16_t*)(ws + WS_WT_DOWN), (r % 32) * 32, nullptr, 0, scr, (r / 32) * 64, (r % 32) * 32, lane);
    }
    { const float* mp = a.in[I_MEM]; bf16_t* mb = (bf16_t*)(ws + WS_MEMB);
      for (int i = gt; i < 2048 * 1024 / 8; i += NT) { const f32x4 v0 = *(const f32x4*)(mp + (size_t)i * 8), v1 = *(const f32x4*)(mp + (size_t)i * 8 + 4); *(u32x4*)(mb + (size_t)i * 8) = pack8(v0, v1); } }
    { const float* sc = a.in[I_SCONV]; float* cs = a.out + O_CONVS;
      for (int i = gt; i < TS * 2 * CONVD / 4; i += NT) { const int e = i * 4, b = e / (2 * CONVD), rem = e % (2 * CONVD), r = rem / CONVD, c = rem % CONVD;
          *(f32x4*)(cs + ((size_t)b * 3 + r) * CONVD + c) = *(const f32x4*)(sc + ((size_t)b * 3 + r + 1) * CONVD + c); } }
    __syncthreads();
    LAS float* slab = (LAS float*)L;
    for (int i = tid; i < 1024 * 4; i += 512) { const int k = i >> 2, c4 = (i & 3) * 4; *(LAS f32x4*)(slab + k * 20 + c4) = *(const f32x4*)(a.in[I_WIN] + (size_t)k * WIN_LD + 2560 + c4); }
    __syncthreads();
    bf16_t* hb = (bf16_t*)(ws + WS_HB); float* dtraw = (float*)(ws + WS_DTRAW);
    float g1[16];
#pragma unroll
    for (int j = 0; j < 16; ++j) g1[j] = a.in[I_LN1][lane + 64 * j];
    for (int row = gw; row < TALL; row += NGW) {
        if (row >= TP + TS) {
#pragma unroll
            for (int j = 0; j < 16; ++j) hb[(size_t)row * 1024 + lane + 64 * j] = 0;
            if (lane < 16) dtraw[(size_t)row * 16 + lane] = 0.f;
            continue;
        }
        const float* src = row < TP ? a.in[I_XP] + (size_t)row * 1024 : a.in[I_XS] + (size_t)(row - TP) * 1024;
        float x[16]; float ss = 0.f;
#pragma unroll
        for (int j = 0; j < 16; ++j) { x[j] = src[lane + 64 * j]; ss += x[j] * x[j]; }
        const float rstd = rsqrtf(wave_sum(ss) * (1.f / 1024.f) + EPS);
        float acc[16];
#pragma unroll
        for (int e = 0; e < 16; ++e) acc[e] = 0.f;
#pragma unroll
        for (int j = 0; j < 16; ++j) {
            const float h = x[j] * rstd * g1[j];
            hb[(size_t)row * 1024 + lane + 64 * j] = f2bf(h);
            const LAS float* wrow = slab + (lane + 64 * j) * 20;
#pragma unroll
            for (int q = 0; q < 4; ++q) { const f32x4 w = *(const LAS f32x4*)(wrow + 4 * q);
                acc[4 * q] += h * w[0]; acc[4 * q + 1] += h * w[1]; acc[4 * q + 2] += h * w[2]; acc[4 * q + 3] += h * w[3]; }
        }
        float outv = 0.f;
#pragma unroll
        for (int e = 0; e < 16; ++e) { const float s = wave_sum(acc[e]); if (lane == e) outv = s; }
        if (lane < 16) dtraw[(size_t)row * 16 + lane] = outv;
    }
}

struct ConvW { float w[4][8]; float b[8]; };
DEVI void convw_load(ConvW& cw, const float* conv_w, const float* conv_b, int ch) {
#pragma unroll
    for (int w = 0; w < 4; ++w) { const f32x4 p = *(const f32x4*)(conv_w + w * CONVD + ch), q = *(const f32x4*)(conv_w + w * CONVD + ch + 4);
#pragma unroll
        for (int j = 0; j < 4; ++j) { cw.w[w][j] = p[j]; cw.w[w][4 + j] = q[j]; } }
    const f32x4 p = *(const f32x4*)(conv_b + ch), q = *(const f32x4*)(conv_b + ch + 4);
#pragma unroll
    for (int j = 0; j < 4; ++j) { cw.b[j] = p[j]; cw.b[4 + j] = q[j]; }
}
DEVI void conv8_prompt(const ConvW& cw, const bf16_t* proj, int row, int t, int ch, float* o) {
#pragma unroll
    for (int j = 0; j < 8; ++j) o[j] = cw.b[j];
#pragma unroll
    for (int w = 0; w < 4; ++w) {
        if (t - 3 + w >= 0) { float x[8]; unpack8(*(const u32x4*)(proj + (size_t)(row - 3 + w) * NPROJ + 1024 + ch), x);
#pragma unroll
            for (int j = 0; j < 8; ++j) o[j] += x[j] * cw.w[w][j]; }
    }
#pragma unroll
    for (int j = 0; j < 8; ++j) o[j] = silu_(o[j]);
}
DEVI void ssd_dt_acum(const Args& a, LAS float* acum, LAS float* dtv, int row0, int g, int wave, int lane) {
    const int h = g * 8 + wave; const float* dtraw = (const float*)(a.ws + WS_DTRAW);
    const float A = -expf(a.in[I_ALOG][h]), bias = a.in[I_DTB][h];
    const float d0 = softplus_(dtraw[(size_t)(row0 + 2 * lane) * 16 + h] + bias), d1 = softplus_(dtraw[(size_t)(row0 + 2 * lane + 1) * 16 + h] + bias);
    const float v0 = d0 * A, v1 = v0 + d1 * A;
    float s = v1;
#pragma unroll
    for (int o = 1; o < 64; o <<= 1) { const float t = __shfl_up(s, o); if (lane >= o) s += t; }
    const float ex = s - v1;
    acum[wave * 128 + 2 * lane] = ex + v0; acum[wave * 128 + 2 * lane + 1] = ex + v1;
    dtv[wave * 128 + 2 * lane] = d0; dtv[wave * 128 + 2 * lane + 1] = d1;
}
constexpr int TLD = 136;
DEVI int swz(int r, int j) { return r * TLD + (j ^ (((r >> 3) & 15) << 3)); }
DEVI int swzb(int r, int kb) { return r * TLD + ((kb ^ ((r >> 3) & 15)) << 3); }

DEVI void ssd_pass1(const Args& a, LAS unsigned char* L, int unit, int tid, int lane, int wave) {
    const int g = unit & 1, c = (unit >> 1) & 15, b = unit >> 5, row0 = b * 2048 + c * 128, t0 = c * 128;
    LAS float* acum = (LAS float*)L; LAS float* dtv = (LAS float*)(L + 4096);
    LAS bf16_t* BT = (LAS bf16_t*)(L + 8192); LAS bf16_t* XT = (LAS bf16_t*)(L + 8192 + 128 * TLD * 2);
    const bf16_t* proj = (const bf16_t*)(a.ws + WS_PROJ); float* cs = (float*)(a.ws + WS_CS);
    ssd_dt_acum(a, acum, dtv, row0, g, wave, lane);
    { const int cgi = tid >> 5, tl = tid & 31, n0 = 8 * cgi; ConvW cw; convw_load(cw, a.in[I_CONVW], a.in[I_CONVB], 1024 + g * 128 + n0);
#pragma unroll
      for (int i = 0; i < 4; ++i) { const int j = tl + 32 * i; float v[8]; conv8_prompt(cw, proj, row0 + j, t0 + j, 1024 + g * 128 + n0, v);
#pragma unroll
          for (int q = 0; q < 8; ++q) BT[swz(n0 + q, j)] = f2bf(v[q]); } }
    const int r = lane & 15, q4 = lane >> 4, pb = wave & 3, nh = wave >> 2;
    for (int e = 0; e < 8; ++e) {
        const int h = g * 8 + e;
        __syncthreads();
        { const int cgi = tid >> 6, tl = tid & 63, p0 = 8 * cgi; ConvW cw; convw_load(cw, a.in[I_CONVW], a.in[I_CONVB], h * 64 + p0);
          const float aend = acum[e * 128 + 127];
#pragma unroll
          for (int i = 0; i < 2; ++i) { const int j = tl + 64 * i; float v[8]; conv8_prompt(cw, proj, row0 + j, t0 + j, h * 64 + p0, v);
              const float sc = dtv[e * 128 + j] * __expf(aend - acum[e * 128 + j]);
#pragma unroll
              for (int q = 0; q < 8; ++q) XT[swz(p0 + q, j)] = f2bf(v[q] * sc); } }
        __syncthreads();
        f32x4 acc[4];
#pragma unroll
        for (int t = 0; t < 4; ++t) acc[t] = (f32x4){0.f, 0.f, 0.f, 0.f};
#pragma unroll
        for (int ks = 0; ks < 4; ++ks) {
            const bf16x8 fa = *(const LAS bf16x8*)(XT + swzb(16 * pb + r, 4 * ks + q4));
#pragma unroll
            for (int t = 0; t < 4; ++t) { const bf16x8 fb = *(const LAS bf16x8*)(BT + swzb(64 * nh + 16 * t + r, 4 * ks + q4));
                acc[t] = __builtin_amdgcn_mfma_f32_16x16x32_bf16(fa, fb, acc[t], 0, 0, 0); }
        }
        float* dst = cs + ((size_t)((b * 16 + c) * 16 + h) * 64) * 128;
#pragma unroll
        for (int t = 0; t < 4; ++t)
#pragma unroll
            for (int k = 0; k < 4; ++k) dst[(size_t)(16 * pb + 4 * q4 + k) * 128 + 64 * nh + 16 * t + r] = acc[t][k];
        if (tid == 0) ((float*)(a.ws + WS_DECAY))[(b * 16 + c) * 16 + h] = __expf(acum[e * 128 + 127]);
    }
    __syncthreads();
}

DEVI void ssd_pass3(const Args& a, LAS unsigned char* L, int unit, int tid, int lane, int wave) {
    const int g = unit & 1, c = (unit >> 1) & 15, b = unit >> 5, row0 = b * 2048 + c * 128, t0 = c * 128;
    LAS float* acum = (LAS float*)L; LAS float* dtv = (LAS float*)(L + 4096);
    LAS bf16_t* CT = (LAS bf16_t*)(L + 8192); LAS bf16_t* BMt = (LAS bf16_t*)(L + 8192 + 34816); LAS bf16_t* XT = (LAS bf16_t*)(L + 8192 + 2 * 34816);
    LAS bf16_t* MW = (LAS bf16_t*)(L + 8192 + 2 * 34816 + 17408 + wave * 4352);
    const bf16_t* proj = (const bf16_t*)(a.ws + WS_PROJ); const bf16_t* sin_ = (const bf16_t*)(a.ws + WS_SIN);
    bf16_t* cat = (bf16_t*)(a.ws + WS_CAT); float* ssq = (float*)(a.ws + WS_SSQ_SSD);
    ssd_dt_acum(a, acum, dtv, row0, g, wave, lane);
    { const int cgi = tid & 15, tl = tid >> 4, n0 = 8 * cgi;
#pragma unroll
      for (int mat = 0; mat < 2; ++mat) { const int ch = 1024 + mat * 256 + g * 128 + n0; ConvW cw; convw_load(cw, a.in[I_CONVW], a.in[I_CONVB], ch);
          LAS bf16_t* dstm = mat ? CT : BMt;
#pragma unroll
          for (int i = 0; i < 4; ++i) { const int j = tl + 32 * i; float v[8]; conv8_prompt(cw, proj, row0 + j, t0 + j, ch, v);
              u32x4 w; w.x = cvt_pk(v[0], v[1]); w.y = cvt_pk(v[2], v[3]); w.z = cvt_pk(v[4], v[5]); w.w = cvt_pk(v[6], v[7]);
              *(LAS u32x4*)(dstm + j * TLD + n0) = w; } } }
    __syncthreads();
    const int r = lane & 15, q4 = lane >> 4;
    bf16x8 aC[4]; f32x4 cb[8];
#pragma unroll
    for (int ks = 0; ks < 4; ++ks) aC[ks] = *(const LAS bf16x8*)(CT + (16 * wave + r) * TLD + 32 * ks + 8 * q4);
#pragma unroll
    for (int t = 0; t < 8; ++t) { cb[t] = (f32x4){0.f, 0.f, 0.f, 0.f};
#pragma unroll
        for (int ks = 0; ks < 4; ++ks) { const bf16x8 fb = *(const LAS bf16x8*)(BMt + (16 * t + r) * TLD + 32 * ks + 8 * q4);
            cb[t] = __builtin_amdgcn_mfma_f32_16x16x32_bf16(aC[ks], fb, cb[t], 0, 0, 0); } }
    float ssacc[4] = {0.f, 0.f, 0.f, 0.f};
    for (int e = 0; e < 8; ++e) {
        const int h = g * 8 + e;
        __syncthreads();
        { const int cgi = tid >> 6, tl = tid & 63, p0 = 8 * cgi; ConvW cw; convw_load(cw, a.in[I_CONVW], a.in[I_CONVB], h * 64 + p0);
#pragma unroll
          for (int i = 0; i < 2; ++i) { const int j = tl + 64 * i; float v[8]; conv8_prompt(cw, proj, row0 + j, t0 + j, h * 64 + p0, v);
#pragma unroll
              for (int q = 0; q < 8; ++q) XT[swz(p0 + q, j)] = f2bf(v[q]); } }
        __syncthreads();
        float ai[4];
#pragma unroll
        for (int k = 0; k < 4; ++k) ai[k] = acum[e * 128 + 16 * wave + 4 * q4 + k];
#pragma unroll
        for (int t = 0; t < 8; ++t) { const int j = 16 * t + r; const float aj = acum[e * 128 + j], dj = dtv[e * 128 + j];
#pragma unroll
            for (int k = 0; k < 4; ++k) { const int i = 16 * wave + 4 * q4 + k; const float m = (j <= i) ? cb[t][k] * __expf(ai[k] - aj) * dj : 0.f;
                MW[(4 * q4 + k) * TLD + j] = f2bf(m); } }
        LDS_WAIT();
        f32x4 acc[4], acc2[4];
#pragma unroll
        for (int pt = 0; pt < 4; ++pt) { acc[pt] = (f32x4){0.f, 0.f, 0.f, 0.f}; acc2[pt] = (f32x4){0.f, 0.f, 0.f, 0.f}; }
#pragma unroll
        for (int ks = 0; ks < 4; ++ks) {
            const bf16x8 fm = *(const LAS bf16x8*)(MW + r * TLD + 32 * ks + 8 * q4);
#pragma unroll
            for (int pt = 0; pt < 4; ++pt) { const bf16x8 fx = *(const LAS bf16x8*)(XT + swzb(16 * pt + r, 4 * ks + q4));
                acc[pt] = __builtin_amdgcn_mfma_f32_16x16x32_bf16(fm, fx, acc[pt], 0, 0, 0); }
        }
        if (c > 0) {
            const bf16_t* sp = sin_ + ((size_t)((b * 16 + c) * 16 + h) * 64) * 128;
#pragma unroll
            for (int ks = 0; ks < 4; ++ks)
#pragma unroll
                for (int pt = 0; pt < 4; ++pt) { const bf16x8 fs = *(const bf16x8*)(sp + (size_t)(16 * pt + r) * 128 + 32 * ks + 8 * q4);
                    acc2[pt] = __builtin_amdgcn_mfma_f32_16x16x32_bf16(aC[ks], fs, acc2[pt], 0, 0, 0); }
        }
        const float Dh = a.in[I_DSSD][h];
#pragma unroll
        for (int k = 0; k < 4; ++k) {
            const int i = 16 * wave + 4 * q4 + k; const float ea = __expf(ai[k]);
#pragma unroll
            for (int pt = 0; pt < 4; ++pt) {
                const int p = 16 * pt + r;
                const float xv = bf2f(XT[swz(p, i)]);
                const float y = acc[pt][k] + ea * acc2[pt][k] + Dh * xv;
                const float z = bf2f(proj[(size_t)(row0 + i) * NPROJ + h * 64 + p]);
                const float yz = y * silu_(z);
                cat[(size_t)(row0 + i) * 2048 + h * 64 + p] = f2bf(yz);
                ssacc[k] += yz * yz;
            }
        }
    }
#pragma unroll
    for (int k = 0; k < 4; ++k) { float s = ssacc[k]; s += __shfl_xor(s, 1); s += __shfl_xor(s, 2); s += __shfl_xor(s, 4); s += __shfl_xor(s, 8);
        if (r == 0) atomicAdd(ssq + row0 + 16 * wave + 4 * q4 + k, s); }
    __syncthreads();
}

DEVI void ssd_step(const Args& a, LAS unsigned char* L, int unit, int tid, int lane) {
    const int h = unit & 15, b = unit >> 4, g = h >> 3, row = TP + b;
    LAS float* xs = (LAS float*)L; LAS float* Bv = xs + 64; LAS float* Cv = Bv + 128; LAS float* sc = Cv + 128;
    const bf16_t* proj = (const bf16_t*)(a.ws + WS_PROJ);
    if (tid < 40) {
        int ch; LAS float* dst;
        if (tid < 8) { ch = h * 64 + 8 * tid; dst = xs + 8 * tid; } else if (tid < 24) { ch = 1024 + g * 128 + 8 * (tid - 8); dst = Bv + 8 * (tid - 8); } else { ch = 1280 + g * 128 + 8 * (tid - 24); dst = Cv + 8 * (tid - 24); }
        ConvW cw; convw_load(cw, a.in[I_CONVW], a.in[I_CONVB], ch);
        float o[8]; float xn[8]; unpack8(*(const u32x4*)(proj + (size_t)row * NPROJ + 1024 + ch), xn);
#pragma unroll
        for (int j = 0; j < 8; ++j) o[j] = cw.b[j] + xn[j] * cw.w[3][j];
#pragma unroll
        for (int w = 0; w < 3; ++w) { const float* sp = a.in[I_SCONV] + ((size_t)b * 3 + w) * CONVD + ch; const f32x4 p = *(const f32x4*)sp, q = *(const f32x4*)(sp + 4);
#pragma unroll
            for (int j = 0; j < 4; ++j) { o[j] += p[j] * cw.w[w][j]; o[4 + j] += q[j] * cw.w[w][4 + j]; } }
#pragma unroll
        for (int j = 0; j < 8; ++j) dst[j] = silu_(o[j]);
    }
    if (tid == 64) { const float dt = softplus_(((const float*)(a.ws + WS_DTRAW))[(size_t)row * 16 + h] + a.in[I_DTB][h]); sc[0] = dt; sc[1] = expf(-expf(a.in[I_ALOG][h]) * dt); }
    __syncthreads();
    const float dt = sc[0], dA = sc[1], Dh = a.in[I_DSSD][h];
    const int n4 = (tid & 31) * 4;
    const f32x4 bv = *(const LAS f32x4*)(Bv + n4), cv = *(const LAS f32x4*)(Cv + n4);
    const float* s0p = a.in[I_SSSM] + ((size_t)(b * 16 + h) * 64) * 128; float* s1p = a.out + O_SSMS + ((size_t)(b * 16 + h) * 64) * 128;
    bf16_t* cat = (bf16_t*)(a.ws + WS_CAT); float* ssq = (float*)(a.ws + WS_SSQ_SSD);
#pragma unroll
    for (int it = 0; it < 4; ++it) {
        const int p = it * 16 + (tid >> 5); const float xp = xs[p];
        const f32x4 s0 = *(const f32x4*)(s0p + (size_t)p * 128 + n4);
        const f32x4 sn = s0 * dA + bv * (dt * xp);
        *(f32x4*)(s1p + (size_t)p * 128 + n4) = sn;
        float part = (cv[0] * sn[0] + cv[1] * sn[1]) + (cv[2] * sn[2] + cv[3] * sn[3]);
        part += __shfl_xor(part, 1); part += __shfl_xor(part, 2); part += __shfl_xor(part, 4); part += __shfl_xor(part, 8); part += __shfl_xor(part, 16);
        if ((tid & 31) == 0) {
            const float y = part + Dh * xp; const float z = bf2f(proj[(size_t)row * NPROJ + h * 64 + p]); const float yz = y * silu_(z);
            cat[(size_t)row * 2048 + h * 64 + p] = f2bf(yz); atomicAdd(ssq + row, yz * yz);
        }
    }
    __syncthreads();
}

template <bool WRITE_Y>
DEVI void s5_unit(const Args& a, LAS unsigned char* Lw, int g, int row0, int ntok, const float* cin_re, const float* cin_im, float* out_re, float* out_im, int lane) {
    LAS float* U = (LAS float*)Lw; LAS bf16_t* SX = (LAS bf16_t*)(Lw + 1024);
    const bf16_t* proj = (const bf16_t*)(a.ws + WS_PROJ); bf16_t* gb = (bf16_t*)(a.ws + WS_GB);
    const int p = lane, gp = g * 64 + p;
    const float lr = a.in[I_LAMR][gp], li = a.in[I_LAMI][gp], step = expf(a.in[I_LSTEP][g]);
    const float mag = expf(lr * step); float sn, cs; sincosf(li * step, &sn, &cs);
    const float lbr = mag * cs, lbi = mag * sn, den = lr * lr + li * li;
    const float kre = ((lbr - 1.f) * lr + lbi * li) / den, kim = (lbi * lr - (lbr - 1.f) * li) / den;
    float bbr[16], bbi[16];
#pragma unroll
    for (int q = 0; q < 4; ++q) { const f32x4 br = *(const f32x4*)(a.in[I_BRE] + (size_t)gp * 16 + 4 * q), bi = *(const f32x4*)(a.in[I_BIM] + (size_t)gp * 16 + 4 * q);
#pragma unroll
        for (int j = 0; j < 4; ++j) { bbr[4 * q + j] = kre * br[j] - kim * bi[j]; bbi[4 * q + j] = kre * bi[j] + kim * br[j]; } }
    const int r = lane & 15, q4 = lane >> 4;
    bf16x8 bC[4];
    if (WRITE_Y) {
#pragma unroll
        for (int ks = 0; ks < 4; ++ks) { const float* src = (ks < 2 ? a.in[I_CRE] : a.in[I_CIM]) + (size_t)(g * 16 + r) * 64 + 32 * (ks & 1) + 8 * q4;
            f32x4 v0 = *(const f32x4*)src, v1 = *(const f32x4*)(src + 4); if (ks >= 2) { v0 = -v0; v1 = -v1; }
            const u32x4 w = pack8(v0, v1); bC[ks] = *(const bf16x8*)&w; }
    }
    float sre = cin_re ? cin_re[p] : 0.f, sim = cin_im ? cin_im[p] : 0.f;
    const float ds5 = WRITE_Y ? a.in[I_DS5][g * 16 + r] : 0.f;
    for (int tb = 0; tb < ntok; tb += 16) {
        const int nt = (ntok - tb) < 16 ? (ntok - tb) : 16;
        { const int tl = lane >> 2, c4 = (lane & 3) * 4;
          if (tl < nt) { const u32x2 w = *(const u32x2*)(proj + (size_t)(row0 + tb + tl) * NPROJ + 2560 + g * 16 + c4);
              *(LAS f32x4*)(U + tl * 16 + c4) = (f32x4){bflo(w.x), bfhi(w.x), bflo(w.y), bfhi(w.y)}; } }
        LDS_WAIT();
        for (int tl = 0; tl < nt; ++tl) {
            float bur = 0.f, bui = 0.f;
#pragma unroll
            for (int q = 0; q < 4; ++q) { const f32x4 u = *(const LAS f32x4*)(U + tl * 16 + 4 * q);
#pragma unroll
                for (int j = 0; j < 4; ++j) { bur += bbr[4 * q + j] * u[j]; bui += bbi[4 * q + j] * u[j]; } }
            const float nr = lbr * sre - lbi * sim + bur, ni = lbr * sim + lbi * sre + bui;
            sre = nr; sim = ni;
            if (WRITE_Y) { SX[tl * TLD + p] = f2bf(sre); SX[tl * TLD + 64 + p] = f2bf(sim); }
        }
        if (WRITE_Y) {
            LDS_WAIT();
            f32x4 acc = (f32x4){0.f, 0.f, 0.f, 0.f};
#pragma unroll
            for (int ks = 0; ks < 4; ++ks) { const bf16x8 fa = *(const LAS bf16x8*)(SX + r * TLD + 32 * ks + 8 * q4); acc = __builtin_amdgcn_mfma_f32_16x16x32_bf16(fa, bC[ks], acc, 0, 0, 0); }
#pragma unroll
            for (int k = 0; k < 4; ++k) { const int tl = 4 * q4 + k;
                if (tl < nt) { const float uu = U[tl * 16 + r]; const float ys = acc[k] + ds5 * uu; gb[(size_t)(row0 + tb + tl) * 1024 + g * 16 + r] = f2bf(gelu_(ys)); } }
            LDS_WAIT();
        }
    }
    if (out_re) { out_re[p] = sre; out_im[p] = sim; }
}

DEVI void attn_sample(const Args& a, LAS unsigned char* L, int unit, int tid, int lane, int wave) {
    const int h = unit & 3, b = unit >> 2, row = TP + b;
    LAS float* qs = (LAS float*)L; LAS float* sc = qs + 256; LAS float* red = sc + 256;
    const bf16_t* qb = (const bf16_t*)(a.ws + WS_QB); bf16_t* ob = (bf16_t*)(a.ws + WS_OB);
    if (tid < 256) qs[tid] = bf2f(qb[(size_t)row * 1024 + h * 256 + tid]);
    __syncthreads();
    const f32x4 q = *(const LAS f32x4*)(qs + 4 * lane);
    const float* kp = a.in[I_CK] + ((size_t)(b * 256) * 4 + h) * 256 + 4 * lane;
    const float* vp = a.in[I_CV] + ((size_t)(b * 256) * 4 + h) * 256 + 4 * lane;
#pragma unroll
    for (int i0 = 0; i0 < 32; i0 += 8) {
        f32x4 kv[8];
#pragma unroll
        for (int i = 0; i < 8; ++i) kv[i] = *(const f32x4*)(kp + (size_t)(wave * 32 + i0 + i) * 1024);
#pragma unroll
        for (int i = 0; i < 8; ++i) { const float d = wave_sum((kv[i][0] * q[0] + kv[i][1] * q[1]) + (kv[i][2] * q[2] + kv[i][3] * q[3])); if (lane == 0) sc[wave * 32 + i0 + i] = d; }
    }
    __syncthreads();
    const f32x4 s4 = *(const LAS f32x4*)(sc + 4 * lane);
    float mx = fmaxf(fmaxf(s4[0], s4[1]), fmaxf(s4[2], s4[3]));
#pragma unroll
    for (int o = 1; o < 64; o <<= 1) mx = fmaxf(mx, __shfl_xor(mx, o));
    const float inv = 1.f / wave_sum((__expf(s4[0] - mx) + __expf(s4[1] - mx)) + (__expf(s4[2] - mx) + __expf(s4[3] - mx)));
    f32x4 acc = (f32x4){0.f, 0.f, 0.f, 0.f};
#pragma unroll
    for (int i0 = 0; i0 < 32; i0 += 8) {
        f32x4 vv[8];
#pragma unroll
        for (int i = 0; i < 8; ++i) vv[i] = *(const f32x4*)(vp + (size_t)(wave * 32 + i0 + i) * 1024);
#pragma unroll
        for (int i = 0; i < 8; ++i) { const float pm = __expf(sc[wave * 32 + i0 + i] - mx) * inv; acc += vv[i] * pm; }
    }
    *(LAS f32x4*)(red + wave * 256 + 4 * lane) = acc;
    __syncthreads();
    if (tid < 256) { float o = 0.f;
#pragma unroll
        for (int w = 0; w < 8; ++w) o += red[w * 256 + tid];
        ob[(size_t)row * 1024 + h * 256 + tid] = f2bf(o); }
    __syncthreads();
}

constexpr int NPH = 14;
__global__ void __launch_bounds__(512, 2) hymba_fwd(Args a) {
    extern __shared__ __attribute__((aligned(16))) unsigned char lds_raw[];
    LAS unsigned char* L = (LAS unsigned char*)lds_raw;
    const int tid = threadIdx.x, lane = tid & 63, wave = __builtin_amdgcn_readfirstlane(tid >> 6);
    const int G = gridDim.x, bid = blockIdx.x, gw = bid * 8 + wave, NGW = G * 8, gt = bid * 512 + tid, NT = G * 512;
    unsigned char* ws = a.ws;
    volatile LAS unsigned* MISC = (volatile LAS unsigned*)(L + MISC_OFF);
    if (tid < 32) MISC[tid] = 0u;
    __syncthreads();
    XcdBarrier bar; bar.bar = (unsigned*)(ws + WS_BAR); bar.x = 0; bar.st = nullptr;
    if (a.ph_hi - a.ph_lo > 1) bar = xcd_barrier_post((unsigned*)(ws + WS_BAR), MISC + 8);
    if (a.ph_lo < 0) cg::this_grid().sync();
    const int lo = a.ph_lo, hi = a.ph_hi;
#define IN(k) (lo <= (k) && (k) < hi)
#define SEAM(k) do { if (IN(k) && IN((k) + 1)) xcd_barrier(bar); } while (0)
    bf16_t* const proj = (bf16_t*)(ws + WS_PROJ);
    float* const x1f = (float*)(ws + WS_X1F);

    if (IN(0)) { p0_prologue(a, L, tid, lane, wave); __syncthreads(); } SEAM(0);

    if (IN(1)) {
        { pg8::Gemm g{(const bf16_t*)(ws + WS_HB), (const bf16_t*)(ws + WS_WT_IN), 1024, 1024, 1024, 0}; pg8::StaticOrder S; S.init(65, 14, G, bid);
          pg8::EpiRow<FIn> E{FIn{proj, a.out + O_CONVP, a.out + O_CONVS}}; pg8::gemm_phase(L, g, S, E); }
        { pg8::Gemm g{(const bf16_t*)(ws + WS_MEMB), (const bf16_t*)(ws + WS_WT_KV), 1024, 1024, 1024, 0}; pg8::StaticOrder S; S.init(8, 8, G, G - 1 - bid);
          pg8::EpiRow<FKV> E{FKV{a.out + O_MEMK, a.out + O_MEMV, (bf16_t*)(ws + WS_KB), (bf16_t*)(ws + WS_VT)}}; pg8::gemm_phase(L, g, S, E); }
    } SEAM(1);

    if (IN(2)) {
        for (int u = bid; u < 256; u += G) ssd_pass1(a, L, u, tid, lane, wave);
        for (int u = bid; u < 2048; u += G) ssd_step(a, L, u, tid, lane);
        float* er = (float*)(ws + WS_S5END); float* ei = er + 8 * 64 * S5NCH * 64;
        for (int u = gw; u < 8 * 64 * S5NCH; u += NGW) { const int k = u & 31, g = (u >> 5) & 63, b = u >> 11;
            s5_unit<false>(a, L + wave * 5376, g, b * 2048 + k * S5LC, S5LC, nullptr, nullptr, er + (size_t)u * 64, ei + (size_t)u * 64, lane); }
    } SEAM(2);

    if (IN(3)) {
        const float* cs = (const float*)(ws + WS_CS); const float* dec = (const float*)(ws + WS_DECAY); bf16_t* sin_ = (bf16_t*)(ws + WS_SIN); float* sout = a.out + O_SSMP;
        for (int i = gt; i < 8 * 16 * 64 * 32; i += NT) {
            const int n4 = (i & 31) * 4, p = (i >> 5) & 63, h = (i >> 11) & 15, b = i >> 15;
            f32x4 S = (f32x4){0.f, 0.f, 0.f, 0.f};
#pragma unroll 4
            for (int c = 0; c < 16; ++c) { const size_t off = ((size_t)((b * 16 + c) * 16 + h) * 64 + p) * 128 + n4;
                u32x2 w; w.x = cvt_pk(S[0], S[1]); w.y = cvt_pk(S[2], S[3]); *(u32x2*)(sin_ + off) = w;
                S = S * dec[(b * 16 + c) * 16 + h] + *(const f32x4*)(cs + off); }
            *(f32x4*)(sout + ((size_t)(b * 16 + h) * 64 + p) * 128 + n4) = S;
        }
        const float* er = (const float*)(ws + WS_S5END); const float* ei = er + 8 * 64 * S5NCH * 64; float* cr = (float*)(ws + WS_S5CAR); float* ci = cr + 8 * 64 * S5NCH * 64;
        for (int i = gt; i < 8 * 64 * 64; i += NT) {
            const int p = i & 63, g = (i >> 6) & 63, b = i >> 12, gp = g * 64 + p;
            const float lr = a.in[I_LAMR][gp], li = a.in[I_LAMI][gp], step = expf(a.in[I_LSTEP][g]);
            const float mag = expf(lr * step); float sn, cs_; sincosf(li * step, &sn, &cs_);
            float pr = mag * cs_, pi = mag * sn;
#pragma unroll
            for (int s = 0; s < 6; ++s) { const float nr = pr * pr - pi * pi, ni = 2.f * pr * pi; pr = nr; pi = ni; }
            float c_r = 0.f, c_i = 0.f;
            for (int k = 0; k < S5NCH; ++k) { const size_t off = ((size_t)((b * 64 + g) * S5NCH + k)) * 64 + p;
                cr[off] = c_r; ci[off] = c_i;
                const float nr = pr * c_r - pi * c_i + er[off], ni = pr * c_i + pi * c_r + ei[off]; c_r = nr; c_i = ni; }
            a.out[O_S5RP + (size_t)(b * 64 + g) * 64 + p] = c_r; a.out[O_S5IP + (size_t)(b * 64 + g) * 64 + p] = c_i;
        }
    } SEAM(3);

    if (IN(4)) {
        for (int u = bid; u < 256; u += G) ssd_pass3(a, L, u, tid, lane, wave);
        const float* cr = (const float*)(ws + WS_S5CAR); const float* ci = cr + 8 * 64 * S5NCH * 64;
        for (int u = gw; u < 8 * 64 * S5NCH + TS * 64; u += NGW) {
            if (u < 8 * 64 * S5NCH) { const int k = u & 31, g = (u >> 5) & 63, b = u >> 11;
                s5_unit<true>(a, L + wave * 5376, g, b * 2048 + k * S5LC, S5LC, cr + (size_t)u * 64, ci + (size_t)u * 64, nullptr, nullptr, lane); }
            else { const int v = u - 8 * 64 * S5NCH, g = v & 63, b = v >> 6;
                s5_unit<true>(a, L + wave * 5376, g, TP + b, 1, a.in[I_SS5R] + (size_t)v * 64, a.in[I_SS5I] + (size_t)v * 64, a.out + O_S5RS + (size_t)v * 64, a.out + O_S5IS + (size_t)v * 64, lane); }
        }
        __syncthreads();
    } SEAM(4);

    if (IN(5)) {
        pg8::Gemm g{(const bf16_t*)(ws + WS_GB), (const bf16_t*)(ws + WS_WT_GLU), 1024, 1024, 1024, 0}; pg8::StaticOrder S; S.init(65, 4, G, bid);
        pg8::EpiRow<FGlu> E{FGlu{(const bf16_t*)(ws + WS_GB), a.in[I_BGLU], (bf16_t*)(ws + WS_CAT), (const float*)(ws + WS_SSQ_SSD)}}; pg8::gemm_phase(L, g, S, E);
    } SEAM(5);

    if (IN(6)) {
        pg8::Gemm g{(const bf16_t*)(ws + WS_CAT), (const bf16_t*)(ws + WS_WT_OUT), 2048, 2048, 2048, 0}; pg8::StaticOrder S; S.init(65, 4, G, bid);
        pg8::EpiRow<FRes> E{FRes{a.in[I_XP], a.in[I_XS], x1f, x1f + (size_t)TP * 1024, (bf16_t*)(ws + WS_X1B), (float*)(ws + WS_SSQ1)}}; pg8::gemm_phase(L, g, S, E);
    } SEAM(6);

    if (IN(7)) {
        pg8::Gemm g{(const bf16_t*)(ws + WS_X1B), (const bf16_t*)(ws + WS_WT_XQ), 1024, 1024, 1024, 0}; pg8::StaticOrder S; S.init(65, 4, G, bid);
        pg8::EpiRow<FQ> E{FQ{(bf16_t*)(ws + WS_QB), (const float*)(ws + WS_SSQ1)}}; pg8::gemm_phase(L, g, S, E);
    } SEAM(7);

    if (IN(8)) {
        { pg8::Gemm g{(const bf16_t*)(ws + WS_QB), (const bf16_t*)(ws + WS_KB), 1024, 1024, 256, 1}; pg8::StaticOrder S; S.init(64, 4, G, bid);
          pg8::EpiRow<FS> E{FS{(bf16_t*)(ws + WS_PB), (float*)(ws + WS_LSUM)}}; pg8::gemm_phase(L, g, S, E); }
        for (int u = bid; u < TS * 4; u += G) attn_sample(a, L, u, tid, lane, wave);
    } SEAM(8);

    if (IN(9)) {
        pg8::Gemm g{(const bf16_t*)(ws + WS_PB), (const bf16_t*)(ws + WS_VT), 1024, 256, 256, 2}; pg8::StaticOrder S; S.init(64, 4, G, bid);
        pg8::EpiRow<FPV> E{FPV{(bf16_t*)(ws + WS_OB), (const float*)(ws + WS_LSUM)}}; pg8::gemm_phase(L, g, S, E);
    } SEAM(9);

    if (IN(10)) {
        pg8::Gemm g{(const bf16_t*)(ws + WS_OB), (const bf16_t*)(ws + WS_WT_XO), 1024, 1024, 1024, 0}; pg8::StaticOrder S; S.init(65, 4, G, bid);
        pg8::EpiRow<FRes> E{FRes{x1f, x1f + (size_t)TP * 1024, x1f, x1f + (size_t)TP * 1024, (bf16_t*)(ws + WS_X1B), (float*)(ws + WS_SSQ2)}}; pg8::gemm_phase(L, g, S, E);
    } SEAM(10);

    if (IN(11)) {
        pg8::Gemm g{(const bf16_t*)(ws + WS_X1B), (const bf16_t*)(ws + WS_WT_GU), 1024, 1024, 1024, 0}; pg8::StaticOrder S; S.init(65, 22, G, bid);
        pg8::EpiRow<FUp> E{FUp{(bf16_t*)(ws + WS_MID), (const float*)(ws + WS_SSQ2)}}; pg8::gemm_phase(L, g, S, E);
    } SEAM(11);

    if (IN(12)) {
        pg8::Gemm g{(const bf16_t*)(ws + WS_MID), (const bf16_t*)(ws + WS_WT_DOWN), DFF, DFF, DFF, 0}; pg8::StaticOrder S; S.init(65, 4, G, bid);
        pg8::EpiRow<FRes> E{FRes{x1f, x1f + (size_t)TP * 1024, a.out + O_YP, a.out + O_YS, nullptr, (float*)(ws + WS_SSQ3)}}; pg8::gemm_phase(L, g, S, E);
    } SEAM(12);

    if (IN(13)) {
        const float* ssq = (const float*)(ws + WS_SSQ3); const float* fg = a.in[I_FING];
        for (int row = gw; row < TP + TS; row += NGW) {
            float* y = (row < TP ? a.out + O_YP + (size_t)row * 1024 : a.out + O_YS + (size_t)(row - TP) * 1024) + 4 * lane;
            const float rs = rsqrtf(ssq[row] * (1.f / 1024.f) + EPS);
#pragma unroll
            for (int j = 0; j < 4; ++j) { const f32x4 v = *(const f32x4*)(y + 256 * j); const f32x4 gg = *(const f32x4*)(fg + 4 * lane + 256 * j); *(f32x4*)(y + 256 * j) = v * rs * gg; }
        }
    }
#undef IN
#undef SEAM
}

extern "C" void kernel_launch(void* const* d_in, const int* in_sizes, int n_in, void* d_out, int out_size, void* d_ws, size_t ws_size, hipStream_t stream) {
    static int grid = 0;
    if (grid == 0) {
        if (n_in != 38 || ws_size < WS_END) { fprintf(stderr, "kernel_launch: unexpected n_in %d / ws %zu\n", n_in, ws_size); grid = -1; return; }
        int dev = 0, cus = 0, per_cu = 0;
        if (hipGetDevice(&dev) != hipSuccess || hipDeviceGetAttribute(&cus, hipDeviceAttributeMultiprocessorCount, dev) != hipSuccess) { grid = -1; return; }
        if (hipFuncSetAttribute((const void*)hymba_fwd, hipFuncAttributeMaxDynamicSharedMemorySize, LDS_BYTES) != hipSuccess) { fprintf(stderr, "kernel_launch: hipFuncSetAttribute failed\n"); grid = -1; return; }
        if (hipOccupancyMaxActiveBlocksPerMultiprocessor(&per_cu, (const void*)hymba_fwd, 512, LDS_BYTES) != hipSuccess || per_cu < 1) { fprintf(stderr, "kernel_launch: occupancy query says %d\n", per_cu); per_cu = 1; }
        (void)hipGetLastError();
        grid = cus;
    }
    if (grid < 0) return;
    (void)hipMemsetAsync((char*)d_ws + WS_BAR, 0, XCD_BAR_WORDS * 4, stream);
    Args a{};
    for (int i = 0; i < 38; ++i) a.in[i] = (const float*)d_in[i];
    a.out = (float*)d_out; a.ws = (unsigned char*)d_ws;
#if MK_MULTI
    for (int ph = 0; ph < NPH; ++ph) { a.ph_lo = ph; a.ph_hi = ph + 1; hipLaunchKernelGGL(hymba_fwd, dim3(grid), dim3(512), LDS_BYTES, stream, a); }
#else
    a.ph_lo = 0; a.ph_hi = NPH;
    void* args[] = {&a};
    hipError_t e = hipLaunchCooperativeKernel((const void*)hymba_fwd, dim3(grid), dim3(512), args, LDS_BYTES, stream);
    if (e != hipSuccess) fprintf(stderr, "kernel_launch: cooperative launch failed: %s (grid %d)\n", hipGetErrorString(e), grid);
#endif
}
```

```cpp
#include <hip/hip_runtime.h>
#include <hip/hip_cooperative_groups.h>
#include <cstdio>
#include <cstdint>
namespace cg = cooperative_groups;

#ifndef SK_MASK
#define SK_MASK 0x14E0
#endif
#define SKN(k) (((SK_MASK) >> (k)) & 1)
#ifndef MK_MULTI
#define MK_MULTI 0

#endif

#define DEVI __device__ __forceinline__
#define LAS __attribute__((address_space(3)))
typedef unsigned short bf16_t;
typedef short bf16x8 __attribute__((ext_vector_type(8)));
typedef float f32x4 __attribute__((ext_vector_type(4)));
typedef unsigned u32x4 __attribute__((ext_vector_type(4)));
typedef unsigned u32x2 __attribute__((ext_vector_type(2)));

constexpr int TP = 16384, TS = 128, TALL = 16640;
constexpr int DM = 1024, NPROJ = 3584, WIN_LD = 3600, DFF = 2816, CONVD = 1536;
constexpr float EPS = 1e-6f;
constexpr int S5LC = 256, S5NCH = 8;

constexpr size_t MiB = 1u << 20;
constexpr size_t WS_SSQ_SSD = 0, WS_SSQ1 = 128 * 1024, WS_SSQ2 = 256 * 1024, WS_SSQ3 = 384 * 1024, WS_LSUM = 512 * 1024, WS_ZERO_END = 896 * 1024;
constexpr size_t WS_DECAY = 896 * 1024;
constexpr size_t WS_BAR = 960 * 1024;
constexpr size_t WS_DTRAW = 1 * MiB;
constexpr size_t WS_WT_IN = 3 * MiB, WS_WT_GLU = 10 * MiB, WS_WT_OUT = 12 * MiB, WS_WT_XQ = 16 * MiB, WS_WT_KV = 18 * MiB, WS_WT_XO = 22 * MiB,
                 WS_WT_GU = 24 * MiB, WS_WT_DOWN = 35 * MiB;
constexpr size_t WS_KB = 41 * MiB, WS_VT = 45 * MiB, WS_MEMB = 49 * MiB, WS_S5END = 53 * MiB, WS_S5CAR = 61 * MiB;
constexpr size_t WS_PROJ = 70 * MiB, WS_MID = 70 * MiB;
constexpr size_t WS_HB = 184 * MiB, WS_X1B = 184 * MiB;
constexpr size_t WS_CS = 217 * MiB, WS_QB = 217 * MiB, WS_PB = 250 * MiB;
constexpr size_t WS_SIN = 281 * MiB, WS_OB = 283 * MiB;
constexpr size_t WS_CAT = 316 * MiB, WS_GB = 382 * MiB, WS_X1F = 415 * MiB, WS_END = 481 * MiB;

constexpr size_t O_YP = 0, O_YS = 16777216, O_CONVP = 16908288, O_SSMP = 16945152, O_S5RP = 17993728, O_S5IP = 18026496,
                 O_MEMK = 18059264, O_MEMV = 20156416, O_CONVS = 22253568, O_SSMS = 22843392, O_S5RS = 39620608, O_S5IS = 40144896;

constexpr int LDS_BYTES = 147456;
constexpr int MISC_OFF = 131072 + 8192;

struct Args { const float* in[38]; float* out; unsigned char* ws; int ph_lo, ph_hi; };
enum { I_XP = 0, I_XS, I_MEM, I_SCONV, I_SSSM, I_SS5R, I_SS5I, I_CK, I_CV, I_LN1, I_WIN, I_CONVW, I_CONVB, I_DTB, I_ALOG, I_DSSD, I_GN,
       I_LAMR, I_LAMI, I_LSTEP, I_BRE, I_BIM, I_CRE, I_CIM, I_DS5, I_WGLU, I_BGLU, I_WOUT, I_LN2, I_WXQ, I_WXK, I_WXV, I_WXO, I_LN3,
       I_WGATE, I_WUP, I_WDOWN, I_FING };

DEVI unsigned cvt_pk(float lo, float hi) { unsigned r; asm("v_cvt_pk_bf16_f32 %0, %1, %2" : "=v"(r) : "v"(lo), "v"(hi)); return r; }
DEVI bf16_t f2bf(float x) { return (bf16_t)(cvt_pk(x, 0.f) & 0xffffu); }
DEVI float bf2f(unsigned b) { return __uint_as_float(b << 16); }
DEVI float bflo(unsigned w) { return __uint_as_float(w << 16); }
DEVI float bfhi(unsigned w) { return __uint_as_float(w & 0xffff0000u); }
DEVI float rcp_(float x) { return __builtin_amdgcn_rcpf(x); }
DEVI float silu_(float x) { return x * rcp_(1.f + __expf(-x)); }
DEVI float sigmoid_(float x) { return rcp_(1.f + __expf(-x)); }
DEVI float gelu_(float x) { const float y = 0.7978845608f * (x + 0.044715f * x * x * x); const float t = 1.f - 2.f * rcp_(1.f + __expf(2.f * y)); return 0.5f * x * (1.f + t); }
DEVI float softplus_(float x) { return x > 20.f ? x : log1pf(expf(x)); }
DEVI int lane_id_() { int l = (int)__builtin_amdgcn_mbcnt_hi(~0u, __builtin_amdgcn_mbcnt_lo(~0u, 0u)); asm volatile("" : "+v"(l)); return l; }
DEVI float shfl_xor_(float v, int m) { return __builtin_bit_cast(float, __builtin_amdgcn_ds_bpermute((lane_id_() ^ m) << 2, __builtin_bit_cast(int, v))); }
DEVI float shfl_up_(float v, int o) { const int l = lane_id_(); return __builtin_bit_cast(float, __builtin_amdgcn_ds_bpermute((l >= o ? l - o : l) << 2, __builtin_bit_cast(int, v))); }
DEVI float shfl_(float v, int src) { return __builtin_bit_cast(float, __builtin_amdgcn_ds_bpermute(src << 2, __builtin_bit_cast(int, v))); }
DEVI float wave_sum(float v) {
    const int l = lane_id_();
#pragma unroll
    for (int o = 1; o < 64; o <<= 1) v += __builtin_bit_cast(float, __builtin_amdgcn_ds_bpermute((l ^ o) << 2, __builtin_bit_cast(int, v)));
    return v;
}
DEVI u32x4 pack8(const f32x4& a, const f32x4& b) { u32x4 w; w.x = cvt_pk(a[0], a[1]); w.y = cvt_pk(a[2], a[3]); w.z = cvt_pk(b[0], b[1]); w.w = cvt_pk(b[2], b[3]); return w; }
DEVI void unpack8(const u32x4& w, float* o) { o[0] = bflo(w.x); o[1] = bfhi(w.x); o[2] = bflo(w.y); o[3] = bfhi(w.y); o[4] = bflo(w.z); o[5] = bfhi(w.z); o[6] = bflo(w.w); o[7] = bfhi(w.w); }
#define LDS_WAIT() asm volatile("s_waitcnt lgkmcnt(0)" ::: "memory")

namespace pg8 {
constexpr int BM = 256, BK = 64, HALF = 128, HTB = HALF * BK * 2, STAGE_BYTES = 8 * HTB, NXCD = 8, WGM = 8;
DEVI int lds_byte(int r, int c) { const int st = (r >> 4) * 2 + (c >> 5), rr = r & 15, cc = c & 31, ob = rr * 64 + cc * 2; return st * 1024 + (ob ^ (((ob >> 9) & 1) << 5)); }
DEVI void stage_rc(int b, int& R, int& C) { const int st = b / 1024, sb = b % 1024, swz = sb ^ (((sb >> 9) & 1) << 5); R = (st >> 1) * 16 + swz / 64; C = (st & 1) * 32 + (swz % 64) / 2; }
DEVI int perm32(int rho) { const int n = rho >> 4, i = rho & 15; return 8 * (i >> 2) + 4 * n + (i & 3); }

struct Unit { int pm, pn; };
struct Gemm { const bf16_t* A; const bf16_t* Bt; int lda, ldb, K, mode; };
DEVI size_t a_off(const Gemm& g, const Unit& u) { size_t o = (size_t)u.pm * 256 * g.lda; if (g.mode) o += (size_t)u.pn * 256; return o * 2; }
DEVI size_t b_off(const Gemm& g, const Unit& u) {
    const size_t r = g.mode == 0 ? (size_t)u.pn : (g.mode == 1 ? (size_t)(u.pm >> 3) : (size_t)((u.pm >> 3) * 4 + u.pn));
    size_t o = r * 256 * g.ldb; if (g.mode == 1) o += (size_t)u.pn * 256; return o * 2;
}
struct StaticOrder {
    int nM, nN, nwg, G, c;
    DEVI void init(int nM_, int nN_, int G_, int c_) { nM = nM_; nN = nN_; nwg = nM * nN; G = G_; c = c_; }
    DEVI bool next(int i, Unit& u) const {
        const long L = (long)i * G + c; if (L >= nwg) return false;
        int wgid = (int)L; { const int q = nwg / NXCD, r = nwg % NXCD, xcd = wgid % NXCD, off = wgid / NXCD; wgid = (xcd < r ? xcd * (q + 1) : r * (q + 1) + (xcd - r) * q) + off; }
        const int nig = WGM * nN, gid = wgid / nig, fm = gid * WGM, gsz = (nM - fm) < WGM ? (nM - fm) : WGM;
        u.pm = fm + ((wgid % nig) % gsz); u.pn = (wgid % nig) / gsz; return true;
    }
};

template <class F> struct EpiRow {
    F f;
    DEVI void operator()(const f32x4 (&acc)[2][2][4][2], const Unit& u, int wr, int wc, int fr, int fq) const {
        const int c8 = wc * 32 + 8 * fq;
        typename F::UC uc; f.unit(u.pn, c8, uc);
#pragma unroll
        for (int ai = 0; ai < 2; ++ai) {
#pragma unroll
            for (int m0 = 0; m0 < 4; m0 += F::NB) {
                typename F::Pre p[F::NB];
#pragma unroll
                for (int m = 0; m < F::NB; ++m) f.load(u.pm * BM + ai * HALF + wr * 64 + (m0 + m) * 16 + fr, u.pn, c8, p[m]);
#pragma unroll
                for (int m = 0; m < F::NB; ++m) f.apply(u.pm * BM + ai * HALF + wr * 64 + (m0 + m) * 16 + fr, u.pn, c8, acc[ai][0][m0 + m][0], acc[ai][0][m0 + m][1], acc[ai][1][m0 + m][0], acc[ai][1][m0 + m][1], p[m], uc);
            }
        }
    }
};
template <class F> DEVI void epi_one(const F& f, int row, int pn, int c8, const f32x4& a0, const f32x4& a1, const f32x4& b0, const f32x4& b1) {
    typename F::UC uc; f.unit(pn, c8, uc); typename F::Pre p; f.load(row, pn, c8, p); f.apply(row, pn, c8, a0, a1, b0, b1, p, uc);
}

template <class Epi, class Sched>
DEVI void gemm_phase(LAS unsigned char* lds, const Gemm g, const Sched& S, const Epi& E, int wid, const float* hs = nullptr) {
    const int lane = lane_id_(), tid = wid * 64 + lane, wr = wid >> 2, wc = wid & 3, fr = lane & 15, fq = lane >> 4;
    const int K = g.K, nt = K / BK;
    unsigned voffA[2], voffB[2];
#pragma unroll
    for (int i = 0; i < 2; ++i) { int R, C; stage_rc(tid * 16 + i * 8192, R, C); const int Rb = (R & ~31) + perm32(R & 31);
        voffA[i] = (unsigned)(R * g.lda + C) * 2u; voffB[i] = (unsigned)(Rb * g.ldb + C) * 2u; }
    const size_t kstep = (size_t)(BK * 2);
    const size_t hsA = (size_t)HALF * g.lda * 2, hsB = (size_t)HALF * g.ldb * 2;
    const unsigned ldsw = (unsigned)wid * 1024u;
    const int aoff = lds_byte(wr * 64 + fr, fq * 8), boff = lds_byte(wc * 32 + fr, fq * 8);
#define PG8_SA(b, h) (((b) * 2 + (h)) * HTB)
#define PG8_SB(b, h) ((4 + (b) * 2 + (h)) * HTB)
#define PG8_STAGE(bufoff, gbase, voff) do { _Pragma("unroll") for (int _i = 0; _i < 2; ++_i) \
        __builtin_amdgcn_global_load_lds((const unsigned*)((const char*)(gbase) + (voff)[_i]), (LAS unsigned*)(lds + (bufoff) + ldsw + _i * 8192), 16, 0, 0); } while (0)
#define PG8_LDA(dst, b, h) do { _Pragma("unroll") for (int m = 0; m < 4; ++m) _Pragma("unroll") for (int k = 0; k < 2; ++k) dst[m][k] = *(const LAS bf16x8*)(lds + PG8_SA(b, h) + aoff + m * 2048 + k * 1024); } while (0)
#define PG8_LDB(dst, b, h) do { _Pragma("unroll") for (int n = 0; n < 2; ++n) _Pragma("unroll") for (int k = 0; k < 2; ++k) dst[n][k] = *(const LAS bf16x8*)(lds + PG8_SB(b, h) + boff + n * 2048 + k * 1024); } while (0)
#define PG8_MMA(ai, bj, At, Bt) do { __builtin_amdgcn_s_setprio(1); _Pragma("unroll") for (int m = 0; m < 4; ++m) _Pragma("unroll") for (int n = 0; n < 2; ++n) _Pragma("unroll") for (int k = 0; k < 2; ++k) \
        acc[ai][bj][m][n] = __builtin_amdgcn_mfma_f32_16x16x32_bf16(Bt[n][k], At[m][k], acc[ai][bj][m][n], 0, 0, 0); __builtin_amdgcn_s_setprio(0); } while (0)
#define PG8_WAIT_V(n) asm volatile("s_waitcnt vmcnt(" #n ")" ::: "memory")
#define PG8_WAIT_L(n) asm volatile("s_waitcnt lgkmcnt(" #n ")" ::: "memory")
#define PG8_BAR __builtin_amdgcn_s_barrier()
#define PG8_SCHED __builtin_amdgcn_sched_barrier(0)
    Unit cur, nxt; int ui = 0;
    if (!S.next(0, cur)) return;
    LAS float* const RS = (LAS float*)(lds + STAGE_BYTES);
    if (hs) { if (tid < 256) RS[tid] = rsqrtf(hs[cur.pm * BM + tid] * (1.f / 1024.f) + EPS); }
    f32x4 acc[2][2][4][2];
#pragma unroll
    for (int a = 0; a < 2; ++a)
#pragma unroll
        for (int b = 0; b < 2; ++b)
#pragma unroll
            for (int m = 0; m < 4; ++m)
#pragma unroll
                for (int n = 0; n < 2; ++n) acc[a][b][m][n] = (f32x4){0.f, 0.f, 0.f, 0.f};
    bf16x8 At[4][2], B0[2][2], B1[2][2];
    const char* cA = (const char*)g.A + a_off(g, cur); const char* cB = (const char*)g.Bt + b_off(g, cur);
    PG8_STAGE(PG8_SB(0, 0), cB, voffB); PG8_STAGE(PG8_SB(0, 1), cB + hsB, voffB); PG8_STAGE(PG8_SA(0, 0), cA, voffA); PG8_STAGE(PG8_SA(0, 1), cA + hsA, voffA);
    if (wr == 1) PG8_BAR;
    PG8_WAIT_V(2); PG8_BAR;
    PG8_STAGE(PG8_SB(1, 0), cB + kstep, voffB); PG8_STAGE(PG8_SA(1, 0), cA + kstep, voffA); PG8_STAGE(PG8_SB(1, 1), cB + hsB + kstep, voffB);
    PG8_WAIT_V(6); PG8_BAR;
    for (;;) {
        const bool has_next = S.next(ui + 1, nxt);
        const char* nA = has_next ? (const char*)g.A + a_off(g, nxt) : cA; const char* nB = has_next ? (const char*)g.Bt + b_off(g, nxt) : cB;
        for (int t = 0; t < nt; t += 2) {
            const bool last = (t == nt - 2);
            if (hs && t == (nt >> 1)) {
#pragma unroll
                for (int ai = 0; ai < 2; ++ai)
#pragma unroll
                    for (int m = 0; m < 4; ++m) { const float rs = RS[ai * HALF + wr * 64 + m * 16 + fr];
#pragma unroll
                        for (int bj = 0; bj < 2; ++bj)
#pragma unroll
                            for (int n = 0; n < 2; ++n) acc[ai][bj][m][n] = acc[ai][bj][m][n] * rs; }
            }
            const char* a1 = cA + (size_t)(t + 1) * kstep;
            const char* a2 = last ? nA : cA + (size_t)(t + 2) * kstep; const char* b2 = last ? nB : cB + (size_t)(t + 2) * kstep;
            const char* a3 = a2 + kstep; const char* b3 = b2 + kstep;
            PG8_LDB(B0, 0, 0); PG8_LDB(B1, 0, 1); PG8_SCHED; PG8_LDA(At, 0, 0); PG8_STAGE(PG8_SA(1, 1), a1 + hsA, voffA);
            PG8_WAIT_V(8); PG8_WAIT_L(0); PG8_BAR; PG8_MMA(0, 0, At, B0); PG8_MMA(0, 1, At, B1); PG8_BAR; PG8_SCHED;
            PG8_LDA(At, 0, 1); PG8_STAGE(PG8_SB(0, 0), b2, voffB); PG8_STAGE(PG8_SB(0, 1), b2 + hsB, voffB); PG8_STAGE(PG8_SA(0, 0), a2, voffA);
            PG8_WAIT_V(8); PG8_WAIT_L(0); PG8_BAR; PG8_MMA(1, 0, At, B0); PG8_MMA(1, 1, At, B1); PG8_BAR; PG8_SCHED;
            PG8_LDB(B0, 1, 0); PG8_LDB(B1, 1, 1); PG8_SCHED; PG8_LDA(At, 1, 0); PG8_STAGE(PG8_SA(0, 1), a2 + hsA, voffA);
            PG8_WAIT_V(8); PG8_WAIT_L(0); PG8_BAR; PG8_MMA(0, 0, At, B0); PG8_MMA(0, 1, At, B1); PG8_BAR; PG8_SCHED;
            PG8_LDA(At, 1, 1); PG8_STAGE(PG8_SB(1, 0), b3, voffB); PG8_STAGE(PG8_SB(1, 1), b3 + hsB, voffB); PG8_STAGE(PG8_SA(1, 0), a3, voffA);
            PG8_WAIT_V(8); PG8_WAIT_L(0); PG8_BAR; PG8_MMA(1, 0, At, B0); PG8_MMA(1, 1, At, B1); PG8_BAR; PG8_SCHED;
        }
        if (wr == 0) PG8_BAR;
        E(acc, cur, wr, wc, fr, fq);
        if (!has_next) break;
#pragma unroll
        for (int a = 0; a < 2; ++a)
#pragma unroll
            for (int b = 0; b < 2; ++b)
#pragma unroll
                for (int m = 0; m < 4; ++m)
#pragma unroll
                    for (int n = 0; n < 2; ++n) acc[a][b][m][n] = (f32x4){0.f, 0.f, 0.f, 0.f};
        cur = nxt; cA = nA; cB = nB; ++ui;
        if (wr == 1) PG8_BAR;
    }
    PG8_WAIT_V(0);
    PG8_BAR;
#undef PG8_SA
#undef PG8_SB
#undef PG8_STAGE
#undef PG8_LDA
#undef PG8_LDB
#undef PG8_MMA
#undef PG8_WAIT_V
#undef PG8_WAIT_L
#undef PG8_BAR
#undef PG8_SCHED
}
}

struct FIn {
    bf16_t* proj; float* convP; float* convS;
    static constexpr int NB = 4; struct UC {}; struct Pre {};
    DEVI void unit(int, int, UC&) const {} DEVI void load(int, int, int, Pre&) const {}
    DEVI void apply(int row, int pn, int c8, const f32x4& a0, const f32x4& a1, const f32x4& b0, const f32x4& b1, const Pre&, const UC&) const {
#pragma unroll
        for (int bj = 0; bj < 2; ++bj) {
            const int col = pn * 256 + bj * 128 + c8; const f32x4 v0 = bj ? b0 : a0, v1 = bj ? b1 : a1;
            *(u32x4*)(proj + (size_t)row * NPROJ + col) = pack8(v0, v1);
            if (col >= 1024 && col < 2560) {
                float* dst = nullptr;
                if (row < TP) { const int t = row & 2047; if (t >= 2045) dst = convP + ((size_t)(row >> 11) * 3 + (t - 2045)) * CONVD + (col - 1024); }
                else if (row < TP + TS) dst = convS + ((size_t)(row - TP) * 3 + 2) * CONVD + (col - 1024);
                if (dst) { *(f32x4*)dst = v0; *(f32x4*)(dst + 4) = v1; }
            }
        }
    }
};
struct FKV {
    float* outk; float* outv; bf16_t* kb; bf16_t* vt;
    static constexpr int NB = 4; struct UC {}; struct Pre {};
    DEVI void unit(int, int, UC&) const {} DEVI void load(int, int, int, Pre&) const {}
    DEVI void apply(int row, int pn, int c8, const f32x4& a0, const f32x4& a1, const f32x4& b0, const f32x4& b1, const Pre&, const UC&) const {
#pragma unroll
        for (int bj = 0; bj < 2; ++bj) {
            const int col = pn * 256 + bj * 128 + c8; const f32x4 v0 = bj ? b0 : a0, v1 = bj ? b1 : a1;
            if (col < 1024) {
                float* d = outk + (size_t)row * 1024 + col; __builtin_nontemporal_store(v0, (f32x4*)d); __builtin_nontemporal_store(v1, (f32x4*)(d + 4));
                *(u32x4*)(kb + (size_t)row * 1024 + col) = pack8(v0, v1);
            } else {
                const int c = col - 1024; float* d = outv + (size_t)row * 1024 + c; __builtin_nontemporal_store(v0, (f32x4*)d); __builtin_nontemporal_store(v1, (f32x4*)(d + 4));
                const int b = row >> 8, m = row & 255, h = c >> 8, dd = c & 255;
                bf16_t* t = vt + ((size_t)(b * 4 + h) * 256 + dd) * 256 + m;
#pragma unroll
                for (int j = 0; j < 4; ++j) { t[(size_t)j * 256] = f2bf(v0[j]); t[(size_t)(j + 4) * 256] = f2bf(v1[j]); }
            }
        }
    }
};
struct FGlu {
    const bf16_t* gb; const float* bglu; bf16_t* cat; const float* ssq;
    static constexpr int NB = 4; struct UC { f32x4 b[2][2]; }; struct Pre { u32x4 g[2]; };
    DEVI void unit(int pn, int c8, UC& uc) const {
#pragma unroll
        for (int bj = 0; bj < 2; ++bj) { const int col = pn * 256 + bj * 128 + c8; uc.b[bj][0] = *(const f32x4*)(bglu + col); uc.b[bj][1] = *(const f32x4*)(bglu + col + 4); } }
    DEVI void load(int row, int pn, int c8, Pre& p) const {
#pragma unroll
        for (int bj = 0; bj < 2; ++bj) p.g[bj] = *(const u32x4*)(gb + (size_t)row * 1024 + pn * 256 + bj * 128 + c8); }
    DEVI void apply(int row, int pn, int c8, const f32x4& a0, const f32x4& a1, const f32x4& b0, const f32x4& b1, const Pre& p, const UC& uc) const {
#pragma unroll
        for (int bj = 0; bj < 2; ++bj) {
            const int col = pn * 256 + bj * 128 + c8; const f32x4 v0 = bj ? b0 : a0, v1 = bj ? b1 : a1;
            float g[8]; unpack8(p.g[bj], g);
            f32x4 y0, y1;
#pragma unroll
            for (int j = 0; j < 4; ++j) { y0[j] = g[j] * sigmoid_(v0[j] + uc.b[bj][0][j]); y1[j] = g[4 + j] * sigmoid_(v1[j] + uc.b[bj][1][j]); }
            *(u32x4*)(cat + (size_t)row * 2048 + 1024 + col) = pack8(y0, y1);
        }
    }
};
template <bool BB>
struct FResT {
    const void* baseP; const void* baseS; float* outP; float* outS; bf16_t* outb; float* ssq;
    static constexpr int NB = 4; struct UC {}; struct Pre { f32x4 x[2][2]; };
    DEVI void unit(int, int, UC&) const {}
    DEVI void load(int row, int pn, int c8, Pre& p) const {
        const int rr = row < TP + TS ? row : 0;
#pragma unroll
        for (int bj = 0; bj < 2; ++bj) { const int col = pn * 256 + bj * 128 + c8;
            if (BB) { const bf16_t* base = rr < TP ? (const bf16_t*)baseP + (size_t)rr * 1024 : (const bf16_t*)baseS + (size_t)(rr - TP) * 1024;
                float f[8]; unpack8(*(const u32x4*)(base + col), f); p.x[bj][0] = (f32x4){f[0], f[1], f[2], f[3]}; p.x[bj][1] = (f32x4){f[4], f[5], f[6], f[7]}; }
            else { const float* base = rr < TP ? (const float*)baseP + (size_t)rr * 1024 : (const float*)baseS + (size_t)(rr - TP) * 1024;
                p.x[bj][0] = *(const f32x4*)(base + col); p.x[bj][1] = *(const f32x4*)(base + col + 4); } } }
    DEVI void apply(int row, int pn, int c8, const f32x4& a0, const f32x4& a1, const f32x4& b0, const f32x4& b1, const Pre& p, const UC&) const {
        const bool valid = row < TP + TS;
        float* out = outP ? (row < TP ? outP + (size_t)row * 1024 : outS + (size_t)(row - TP) * 1024) : nullptr;
        float ss = 0.f;
        if (valid) {
#pragma unroll
            for (int bj = 0; bj < 2; ++bj) {
                const int col = pn * 256 + bj * 128 + c8; const f32x4 v0 = bj ? b0 : a0, v1 = bj ? b1 : a1;
                const f32x4 x0 = p.x[bj][0] + v0, x1 = p.x[bj][1] + v1;
                if (out) { *(f32x4*)(out + col) = x0; *(f32x4*)(out + col + 4) = x1; }
                if (outb) *(u32x4*)(outb + (size_t)row * 1024 + col) = pack8(x0, x1);
                ss += (x0[0] * x0[0] + x0[1] * x0[1]) + (x0[2] * x0[2] + x0[3] * x0[3]) + (x1[0] * x1[0] + x1[1] * x1[1]) + (x1[2] * x1[2] + x1[3] * x1[3]);
            }
        }
        ss += shfl_xor_(ss, 16); ss += shfl_xor_(ss, 32);
        if (valid && ((c8 >> 3) & 3) == 0) atomicAdd(ssq + row, ss);
    }
};
struct FQ {
    bf16_t* qb; const float* ssq;
    static constexpr int NB = 4; struct UC {}; struct Pre { float ss; };
    DEVI void unit(int, int, UC&) const {} DEVI void load(int row, int, int, Pre& p) const { p.ss = ssq[row]; }
    DEVI void apply(int row, int pn, int c8, const f32x4& a0, const f32x4& a1, const f32x4& b0, const f32x4& b1, const Pre& p, const UC&) const {
        const float rs = rsqrtf(p.ss * (1.f / 1024.f) + EPS) * 0.0625f;
        *(u32x4*)(qb + (size_t)row * 1024 + pn * 256 + c8) = pack8(a0 * rs, a1 * rs);
        *(u32x4*)(qb + (size_t)row * 1024 + pn * 256 + 128 + c8) = pack8(b0 * rs, b1 * rs);
    }
};
struct FS {
    bf16_t* pb; float* lsum;
    static constexpr int NB = 4; struct UC {}; struct Pre {};
    DEVI void unit(int, int, UC&) const {} DEVI void load(int, int, int, Pre&) const {}
    DEVI void apply(int row, int pn, int c8, const f32x4& a0, const f32x4& a1, const f32x4& b0, const f32x4& b1, const Pre&, const UC&) const {
        float ls = 0.f;
#pragma unroll
        for (int bj = 0; bj < 2; ++bj) {
            const f32x4 v0 = bj ? b0 : a0, v1 = bj ? b1 : a1; f32x4 e0, e1;
#pragma unroll
            for (int j = 0; j < 4; ++j) { e0[j] = __expf(v0[j]); e1[j] = __expf(v1[j]); }
            const u32x4 w = pack8(e0, e1);
            *(u32x4*)(pb + (size_t)row * 1024 + pn * 256 + bj * 128 + c8) = w;
            ls += (bflo(w.x) + bfhi(w.x)) + (bflo(w.y) + bfhi(w.y)) + (bflo(w.z) + bfhi(w.z)) + (bflo(w.w) + bfhi(w.w));
        }
        ls += shfl_xor_(ls, 16); ls += shfl_xor_(ls, 32);
        if (((c8 >> 3) & 3) == 0) atomicAdd(lsum + (size_t)row * 4 + pn, ls);
    }
};
struct FPV {
    bf16_t* ob; const float* lsum;
    static constexpr int NB = 4; struct UC {}; struct Pre { float l; };
    DEVI void unit(int, int, UC&) const {} DEVI void load(int row, int pn, int, Pre& p) const { p.l = lsum[(size_t)row * 4 + pn]; }
    DEVI void apply(int row, int pn, int c8, const f32x4& a0, const f32x4& a1, const f32x4& b0, const f32x4& b1, const Pre& p, const UC&) const {
        const float inv = 1.f / p.l;
        *(u32x4*)(ob + (size_t)row * 1024 + pn * 256 + c8) = pack8(a0 * inv, a1 * inv);
        *(u32x4*)(ob + (size_t)row * 1024 + pn * 256 + 128 + c8) = pack8(b0 * inv, b1 * inv);
    }
};
struct FUp {
    bf16_t* mid; const float* ssq;
    static constexpr int NB = 4; struct UC {}; struct Pre { float ss; };
    DEVI void unit(int, int, UC&) const {} DEVI void load(int row, int, int, Pre& p) const { p.ss = ssq[row]; }
    DEVI void apply(int row, int pn, int c8, const f32x4& a0, const f32x4& a1, const f32x4& b0, const f32x4& b1, const Pre& p, const UC&) const {
        const float rs = rsqrtf(p.ss * (1.f / 1024.f) + EPS);
        f32x4 y0, y1;
#pragma unroll
        for (int j = 0; j < 4; ++j) { y0[j] = silu_(a0[j] * rs) * (b0[j] * rs); y1[j] = silu_(a1[j] * rs) * (b1[j] * rs); }
        *(u32x4*)(mid + (size_t)row * DFF + pn * 128 + c8) = pack8(y0, y1);
    }
};

template <class F>
DEVI void sgemm_unit(const bf16_t* A, int lda, const bf16_t* Wt, int ldb, int K, int pn, int wc, const F& f, int lane_, int wave) {
    int lane = lane_; asm volatile("" : "+v"(lane));
    const int r = lane & 15, q = lane >> 4;
    const bf16_t* ap = A + (size_t)(16 * wave + r) * lda + 8 * q;
    const bf16_t* wp[4];
#pragma unroll
    for (int t = 0; t < 4; ++t) wp[t] = Wt + (size_t)(256 * pn + 128 * (t >> 1) + 32 * wc + 8 * (r >> 2) + 4 * (t & 1) + (r & 3)) * ldb + 8 * q;
    f32x4 acc[4];
#pragma unroll
    for (int t = 0; t < 4; ++t) acc[t] = (f32x4){0.f, 0.f, 0.f, 0.f};
    for (int k0 = 0; k0 < K; k0 += 128) {
        bf16x8 fa[4], fw[4][4];
#pragma unroll
        for (int u = 0; u < 4; ++u) { fa[u] = *(const bf16x8*)(ap + k0 + 32 * u);
#pragma unroll
            for (int t = 0; t < 4; ++t) fw[u][t] = *(const bf16x8*)(wp[t] + k0 + 32 * u); }
#pragma unroll
        for (int u = 0; u < 4; ++u)
#pragma unroll
            for (int t = 0; t < 4; ++t) acc[t] = __builtin_amdgcn_mfma_f32_16x16x32_bf16(fw[u][t], fa[u], acc[t], 0, 0, 0);
    }
    pg8::epi_one(f, TP + 16 * wave + r, pn, 32 * wc + 8 * q, acc[0], acc[1], acc[2], acc[3]);
}

template <class F>
DEVI void sgemm2_unit(LAS unsigned char* L, const bf16_t* A, int lda, const bf16_t* Wt, int ldb, int K, int unit, const F& f, int lane_, int wave) {
    int lane = lane_; asm volatile("" : "+v"(lane));
    const int tq = unit & 3, wc = (unit >> 2) & 3, pn = unit >> 4;
    const int r = lane & 15, q = lane >> 4, tg = wave & 1, kq = wave >> 1;
    const int NK = K >> 5, per = (((NK >> 2) + 7) >> 3) << 3, ksb = kq * per, cnt = (NK - ksb) < per ? (NK - ksb) : per;
    const bf16_t* ap = A + (size_t)(32 * tq + 16 * tg + r) * lda + 8 * q + 32 * ksb;
    const bf16_t* wp[4];
#pragma unroll
    for (int t = 0; t < 4; ++t) wp[t] = Wt + (size_t)(256 * pn + 128 * (t >> 1) + 32 * wc + 8 * (r >> 2) + 4 * (t & 1) + (r & 3)) * ldb + 8 * q + 32 * ksb;
    f32x4 acc[4];
#pragma unroll
    for (int t = 0; t < 4; ++t) acc[t] = (f32x4){0.f, 0.f, 0.f, 0.f};
    for (int c0 = 0; c0 < cnt; c0 += 8) {
        bf16x8 fa[8], fw[8][4];
#pragma unroll
        for (int u = 0; u < 8; ++u) { fa[u] = *(const bf16x8*)(ap + (c0 + u) * 32);
#pragma unroll
            for (int t = 0; t < 4; ++t) fw[u][t] = *(const bf16x8*)(wp[t] + (c0 + u) * 32); }
#pragma unroll
        for (int u = 0; u < 8; ++u)
#pragma unroll
            for (int t = 0; t < 4; ++t) acc[t] = __builtin_amdgcn_mfma_f32_16x16x32_bf16(fw[u][t], fa[u], acc[t], 0, 0, 0);
    }
    LAS f32x4* red = (LAS f32x4*)L;
#pragma unroll
    for (int t = 0; t < 4; ++t) red[(wave * 4 + t) * 64 + lane] = acc[t];
    __syncthreads();
    if (kq == 0) {
#pragma unroll
        for (int t = 0; t < 4; ++t) acc[t] = (red[(tg * 4 + t) * 64 + lane] + red[((tg + 2) * 4 + t) * 64 + lane]) + (red[((tg + 4) * 4 + t) * 64 + lane] + red[((tg + 6) * 4 + t) * 64 + lane]);
        pg8::epi_one(f, TP + 32 * tq + 16 * tg + r, pn, 32 * wc + 8 * q, acc[0], acc[1], acc[2], acc[3]);
    }
    __syncthreads();
}

template <class F>
DEVI void sgemm3_unit(LAS unsigned char* L, const bf16_t* A, int lda, const bf16_t* Wt, int ldb, int K, int unit, const F& f, int lane_, int wave, const float* hs = nullptr) {
    int lane = lane_; asm volatile("" : "+v"(lane));
    const int tg = unit & 7, wc = (unit >> 3) & 3, pn = unit >> 5;
    const int r = lane & 15, q = lane >> 4;
    const int NK = K >> 5, per = (((NK >> 3) + 3) >> 2) << 2, ksb = wave * per; int cnt = NK - ksb; cnt = cnt < 0 ? 0 : (cnt < per ? cnt : per);
    const bf16_t* ap = A + (size_t)(16 * tg + r) * lda + 8 * q + 32 * ksb;
    const bf16_t* wp[4];
#pragma unroll
    for (int t = 0; t < 4; ++t) wp[t] = Wt + (size_t)(256 * pn + 128 * (t >> 1) + 32 * wc + 8 * (r >> 2) + 4 * (t & 1) + (r & 3)) * ldb + 8 * q + 32 * ksb;
    f32x4 acc[4];
#pragma unroll
    for (int t = 0; t < 4; ++t) acc[t] = (f32x4){0.f, 0.f, 0.f, 0.f};
    typename F::UC euc; typename F::Pre epre;
    if (wave == 0) { f.unit(pn, 32 * wc + 8 * q, euc); f.load(TP + 16 * tg + r, pn, 32 * wc + 8 * q, epre); }
    for (int c0 = 0; c0 < cnt; c0 += 4) {
        bf16x8 fa[4], fw[4][4];
#pragma unroll
        for (int u = 0; u < 4; ++u) { fa[u] = *(const bf16x8*)(ap + (c0 + u) * 32);
#pragma unroll
            for (int t = 0; t < 4; ++t) fw[u][t] = *(const bf16x8*)(wp[t] + (c0 + u) * 32); }
#pragma unroll
        for (int u = 0; u < 4; ++u)
#pragma unroll
            for (int t = 0; t < 4; ++t) acc[t] = __builtin_amdgcn_mfma_f32_16x16x32_bf16(fw[u][t], fa[u], acc[t], 0, 0, 0);
    }
    LAS f32x4* red = (LAS f32x4*)L;
#pragma unroll
    for (int t = 0; t < 4; ++t) red[(wave * 4 + t) * 64 + lane] = acc[t];
    __syncthreads();
    if (wave == 0) {
        const float hrs = hs ? rsqrtf(hs[TP + 16 * tg + r] * (1.f / 1024.f) + EPS) : 1.f;
#pragma unroll
        for (int t = 0; t < 4; ++t) { f32x4 v = red[t * 64 + lane];
#pragma unroll
            for (int w = 1; w < 4; ++w) v += red[(w * 4 + t) * 64 + lane];
            v = v * hrs;
#pragma unroll
            for (int w = 4; w < 8; ++w) v += red[(w * 4 + t) * 64 + lane];
            acc[t] = v; }
        f.apply(TP + 16 * tg + r, pn, 32 * wc + 8 * q, acc[0], acc[1], acc[2], acc[3], epre, euc);
    }
    __syncthreads();
}

#define XB_TMO      128
#define XB_XCNT(j)  (256  + 64 * (j))
#define XB_XSUB(j)  (1280 + 64 * (j))
#define XB_XGEN(j)  (2304 + 64 * (j))
#define XB_TOP      3328
#define XB_TOPGEN   3392
#define XCD_BAR_WORDS 3456
#define XB_SPIN_CAP (1u << 22)
DEVI unsigned xb_ld(unsigned* p)              { return __hip_atomic_load(p, __ATOMIC_RELAXED, __HIP_MEMORY_SCOPE_AGENT); }
DEVI unsigned xb_add(unsigned* p, unsigned v) { return __hip_atomic_fetch_add(p, v, __ATOMIC_RELAXED, __HIP_MEMORY_SCOPE_AGENT); }
DEVI unsigned xb_xcc_id() { return (unsigned)__builtin_amdgcn_s_getreg((3 << 11) | 20) & 0xFu; }
#define XB_SPIN(cond, bar) do { unsigned _sp = 0; while (cond) { __builtin_amdgcn_s_sleep(1); \
    if ((++_sp & 255u) == 0u) { if (xb_ld(&(bar)[XB_TMO])) break; if (_sp > XB_SPIN_CAP) { atomicAdd(&(bar)[XB_TMO], 1u); break; } } } } while (0)
struct XcdBarrier { unsigned* bar; unsigned x; volatile LAS unsigned* st; };
DEVI XcdBarrier xcd_barrier_post(unsigned* bar, volatile LAS unsigned* st, bool t0) {
    XcdBarrier b; b.bar = bar; b.x = xb_xcc_id(); b.st = st;
    if (t0) (void)xb_add(&bar[XB_XCNT(b.x)], 1u);
    return b;
}
DEVI void xcd_barrier_complete(unsigned* bar, unsigned x, unsigned& nloc, unsigned& nx) {
    const unsigned G = gridDim.x * gridDim.y * gridDim.z;
    unsigned sum, cnt, mine, sp = 0u;
    for (;;) {
        sum = 0u; cnt = 0u; mine = 0u;
#pragma unroll
        for (unsigned j = 0; j < 16; ++j) { const unsigned c = xb_ld(&bar[XB_XCNT(j)]); sum += c; cnt += (c > 0u) ? 1u : 0u; mine = (j == x) ? c : mine; }
        if (sum == G) break;
        __builtin_amdgcn_s_sleep(1);
        if ((++sp & 255u) == 0u) { if (xb_ld(&bar[XB_TMO])) break; if (sp > XB_SPIN_CAP) { atomicAdd(&bar[XB_TMO], 1u); break; } }
    }
    nloc = mine > 0u ? mine : 1u; nx = cnt > 0u ? cnt : 1u;
}
DEVI void xcd_barrier(const XcdBarrier& b, int wave) {
    asm volatile("s_waitcnt vmcnt(0)" ::: "memory");
    __syncthreads();
    if (wave == 0 && lane_id_() == 0) {
        unsigned* bar = b.bar;
        __builtin_amdgcn_s_waitcnt(0);
        unsigned nloc = b.st[0], nx = b.st[1];
        if (nloc == 0u) { xcd_barrier_complete(bar, b.x, nloc, nx); b.st[0] = nloc; b.st[1] = nx; }
        const unsigned old = xb_add(&bar[XB_XSUB(b.x)], 1u);
        const unsigned gen = old / nloc;
        if (old + 1u == (gen + 1u) * nloc) {
            __builtin_amdgcn_fence(__ATOMIC_RELEASE, "agent");
            asm volatile("s_waitcnt vmcnt(0)" ::: "memory");
            const unsigned og = xb_add(&bar[XB_TOP], 1u);
            const unsigned tg = og / nx;
            if (og + 1u == (tg + 1u) * nx) xb_add(&bar[XB_TOPGEN], 1u);
            else XB_SPIN(xb_ld(&bar[XB_TOPGEN]) == tg, bar);
            __builtin_amdgcn_fence(__ATOMIC_ACQUIRE, "agent");
            xb_add(&bar[XB_XGEN(b.x)], 1u);
            asm volatile("s_waitcnt vmcnt(0)" ::: "memory");
        } else {
            XB_SPIN(xb_ld(&bar[XB_XGEN(b.x)]) == gen, bar);
            __builtin_amdgcn_fence(__ATOMIC_ACQUIRE, "agent");
            asm volatile("s_waitcnt vmcnt(0)" ::: "memory");
        }
    }
    __syncthreads();
}

struct EpiFinal {
    const bf16_t* base; float* out; float* ssq; const float* fing; const XcdBarrier* bar; int wave;
    DEVI void operator()(f32x4 (&acc)[2][2][4][2], const pg8::Unit& u, int wr, int wc, int fr, int fq) const {
        const int c8 = wc * 32 + 8 * fq;
#pragma unroll
        for (int ai = 0; ai < 2; ++ai)
#pragma unroll
            for (int m0 = 0; m0 < 4; m0 += 2) {
                f32x4 x[2][2][2];
#pragma unroll
                for (int m = 0; m < 2; ++m) { const int row = u.pm * 256 + ai * 128 + wr * 64 + (m0 + m) * 16 + fr;
#pragma unroll
                    for (int bj = 0; bj < 2; ++bj) { float f[8]; unpack8(*(const u32x4*)(base + (size_t)row * 1024 + u.pn * 256 + bj * 128 + c8), f);
                        x[m][bj][0] = (f32x4){f[0], f[1], f[2], f[3]}; x[m][bj][1] = (f32x4){f[4], f[5], f[6], f[7]}; } }
#pragma unroll
                for (int m = 0; m < 2; ++m) { const int row = u.pm * 256 + ai * 128 + wr * 64 + (m0 + m) * 16 + fr; float ss = 0.f;
#pragma unroll
                    for (int bj = 0; bj < 2; ++bj)
#pragma unroll
                        for (int n = 0; n < 2; ++n) { f32x4 v = acc[ai][bj][m0 + m][n] + x[m][bj][n]; acc[ai][bj][m0 + m][n] = v; ss += (v[0] * v[0] + v[1] * v[1]) + (v[2] * v[2] + v[3] * v[3]); }
                    ss += shfl_xor_(ss, 16); ss += shfl_xor_(ss, 32);
                    if (fq == 0) atomicAdd(ssq + row, ss); }
            }
        xcd_barrier(*bar, wave);
        f32x4 gg[2][2];
#pragma unroll
        for (int bj = 0; bj < 2; ++bj) { const float* gp = fing + u.pn * 256 + bj * 128 + c8; gg[bj][0] = *(const f32x4*)gp; gg[bj][1] = *(const f32x4*)(gp + 4); }
#pragma unroll
        for (int ai = 0; ai < 2; ++ai)
#pragma unroll
            for (int m = 0; m < 4; ++m) { const int row = u.pm * 256 + ai * 128 + wr * 64 + m * 16 + fr;
                const float rs = rsqrtf(__hip_atomic_load(ssq + row, __ATOMIC_RELAXED, __HIP_MEMORY_SCOPE_AGENT) * (1.f / 1024.f) + EPS);
#pragma unroll
                for (int bj = 0; bj < 2; ++bj) { float* op = out + (size_t)row * 1024 + u.pn * 256 + bj * 128 + c8;
                    __builtin_nontemporal_store(acc[ai][bj][m][0] * rs * gg[bj][0], (f32x4*)op); __builtin_nontemporal_store(acc[ai][bj][m][1] * rs * gg[bj][1], (f32x4*)(op + 4)); } }
    }
};

DEVI void tr_item(const float* W, int ldw, int K, bf16_t* WT, int dst_row, const float* scale, int slim, LAS float* scr, int k0, int n_src0, int lane) {
    float wv[32];
#pragma unroll
    for (int i = 0; i < 32; ++i) wv[i] = W[(size_t)(k0 + 2 * i + (lane >> 5)) * ldw + n_src0 + (lane & 31)];
    if (scale) {
#pragma unroll
        for (int i = 0; i < 32; ++i) { const int k = k0 + 2 * i + (lane >> 5); const float sv = scale[k < slim ? k : slim - 1]; wv[i] *= (k < slim) ? sv : 1.f; }
    }
#pragma unroll
    for (int i = 0; i < 32; ++i) scr[(2 * i + (lane >> 5)) * 33 + (lane & 31)] = wv[i];
    LDS_WAIT();
    const int c = lane & 7;
#pragma unroll
    for (int j = 0; j < 4; ++j) { const int n = (lane >> 3) + 8 * j; const LAS float* s = scr + (8 * c) * 33 + n;
        u32x4 o; o.x = cvt_pk(s[0 * 33], s[1 * 33]); o.y = cvt_pk(s[2 * 33], s[3 * 33]); o.z = cvt_pk(s[4 * 33], s[5 * 33]); o.w = cvt_pk(s[6 * 33], s[7 * 33]);
        *(u32x4*)(WT + (size_t)(dst_row + n) * K + k0 + 8 * c) = o; }
    LDS_WAIT();
}
DEVI void p0_prologue(const Args& a, LAS unsigned char* L, int tid, int lane, int wave) {
    unsigned char* ws = a.ws;
    const int G = gridDim.x, gw = blockIdx.x * 8 + wave, NGW = G * 8, gt = blockIdx.x * 512 + tid, NT = G * 512;
    for (int i = gt; i < (int)(WS_ZERO_END / 16); i += NT) ((u32x4*)ws)[i] = (u32x4){0u, 0u, 0u, 0u};
    LAS float* scr = (LAS float*)(L + wave * 8448);
    constexpr int J0 = 16 * 80, J1 = 16 * 32, J5 = 512, J6 = 512;
    for (int it = gw; it < J0 + J1 + J5 + J6; it += NGW) {
        int r = it;
        if (r < J0) { tr_item(a.in[I_WIN], WIN_LD, 1024, (bf16_t*)(ws + WS_WT_IN), (r % 80) * 32, nullptr, 0, scr, (r / 80) * 64, (r % 80) * 32, lane); continue; } r -= J0;
        if (r < J1) { tr_item(a.in[I_WIN], WIN_LD, 1024, (bf16_t*)(ws + WS_WT_IN), 2560 + (r % 32) * 32, nullptr, 0, scr, (r / 32) * 64, 2576 + (r % 32) * 32, lane); continue; } r -= J1;
        if (r < J5) { tr_item(a.in[I_WXK], 1024, 1024, (bf16_t*)(ws + WS_WT_KV), (r % 32) * 32, nullptr, 0, scr, (r / 32) * 64, (r % 32) * 32, lane); continue; } r -= J5;
        tr_item(a.in[I_WXV], 1024, 1024, (bf16_t*)(ws + WS_WT_KV), 1024 + (r % 32) * 32, nullptr, 0, scr, (r / 32) * 64, (r % 32) * 32, lane);
    }
    { const float* mp = a.in[I_MEM]; bf16_t* mb = (bf16_t*)(ws + WS_MEMB);
      for (int i = gt; i < 2048 * 1024 / 8; i += NT) { const f32x4 v0 = *(const f32x4*)(mp + (size_t)i * 8), v1 = *(const f32x4*)(mp + (size_t)i * 8 + 4); *(u32x4*)(mb + (size_t)i * 8) = pack8(v0, v1); } }
    { const float* sc = a.in[I_SCONV]; float* cs = a.out + O_CONVS;
      for (int i = gt; i < TS * 2 * CONVD / 4; i += NT) { const int e = i * 4, b = e / (2 * CONVD), rem = e % (2 * CONVD), r = rem / CONVD, c = rem % CONVD;
          *(f32x4*)(cs + ((size_t)b * 3 + r) * CONVD + c) = *(const f32x4*)(sc + ((size_t)b * 3 + r + 1) * CONVD + c); } }
    __syncthreads();
    LAS float* slab = (LAS float*)L;
    for (int i = tid; i < 1024 * 4; i += 512) { const int k = i >> 2, c4 = (i & 3) * 4; *(LAS f32x4*)(slab + k * 20 + c4) = *(const f32x4*)(a.in[I_WIN] + (size_t)k * WIN_LD + 2560 + c4); }
    __syncthreads();
    bf16_t* hb = (bf16_t*)(ws + WS_HB); float* dtraw = (float*)(ws + WS_DTRAW);
    float g1[16];
#pragma unroll
    for (int j = 0; j < 16; ++j) g1[j] = a.in[I_LN1][lane + 64 * j];
    float xn[16];
#pragma unroll
    for (int j = 0; j < 16; ++j) xn[j] = 0.f;
    if (gw < TP + TS) { const float* src = gw < TP ? a.in[I_XP] + (size_t)gw * 1024 : a.in[I_XS] + (size_t)(gw - TP) * 1024;
#pragma unroll
        for (int j = 0; j < 16; ++j) xn[j] = src[lane + 64 * j]; }
    for (int row = gw; row < TALL; row += NGW) {
        if (row >= TP + TS) {
#pragma unroll
            for (int j = 0; j < 16; ++j) hb[(size_t)row * 1024 + lane + 64 * j] = 0;
            if (lane < 16) dtraw[(size_t)row * 16 + lane] = 0.f;
            continue;
        }
        float x[16]; float ss = 0.f;
#pragma unroll
        for (int j = 0; j < 16; ++j) { x[j] = xn[j]; ss += x[j] * x[j]; }
        { const int nr = row + NGW;
          if (nr < TP + TS) { const float* src = nr < TP ? a.in[I_XP] + (size_t)nr * 1024 : a.in[I_XS] + (size_t)(nr - TP) * 1024;
#pragma unroll
              for (int j = 0; j < 16; ++j) xn[j] = src[lane + 64 * j]; } }
        const float rstd = rsqrtf(wave_sum(ss) * (1.f / 1024.f) + EPS);
        float acc[16];
#pragma unroll
        for (int e = 0; e < 16; ++e) acc[e] = 0.f;
#pragma unroll
        for (int j = 0; j < 16; ++j) {
            const float h = x[j] * rstd * g1[j];
            hb[(size_t)row * 1024 + lane + 64 * j] = f2bf(h);
            const LAS float* wrow = slab + (lane + 64 * j) * 20;
#pragma unroll
            for (int q = 0; q < 4; ++q) { const f32x4 w = *(const LAS f32x4*)(wrow + 4 * q);
                acc[4 * q] += h * w[0]; acc[4 * q + 1] += h * w[1]; acc[4 * q + 2] += h * w[2]; acc[4 * q + 3] += h * w[3]; }
        }
        float outv = 0.f;
#pragma unroll
        for (int e = 0; e < 16; ++e) { const float s = wave_sum(acc[e]); if (lane == e) outv = s; }
        if (lane < 16) dtraw[(size_t)row * 16 + lane] = outv;
    }
}

DEVI void p3_weights(const Args& a, LAS unsigned char* L, int lane, int wave) {
    unsigned char* ws = a.ws; const int gw = blockIdx.x * 8 + wave, NGW = gridDim.x * 8;
    LAS float* scr = (LAS float*)(L + wave * 8448);
    constexpr int J2 = 512, J3 = 32 * 32, J4 = 512, J7 = 512, J8 = 16 * 88, J9 = 16 * 88, J10 = 44 * 32;
    for (int it = gw; it < J2 + J3 + J4 + J7 + J8 + J9 + J10; it += NGW) {
        int r = it;
        if (r < J2) { tr_item(a.in[I_WGLU], 1024, 1024, (bf16_t*)(ws + WS_WT_GLU), (r % 32) * 32, nullptr, 0, scr, (r / 32) * 64, (r % 32) * 32, lane); continue; } r -= J2;
        if (r < J3) { tr_item(a.in[I_WOUT], 1024, 2048, (bf16_t*)(ws + WS_WT_OUT), (r % 32) * 32, a.in[I_GN], 1024, scr, (r / 32) * 64, (r % 32) * 32, lane); continue; } r -= J3;
        if (r < J4) { tr_item(a.in[I_WXQ], 1024, 1024, (bf16_t*)(ws + WS_WT_XQ), (r % 32) * 32, a.in[I_LN2], 1024, scr, (r / 32) * 64, (r % 32) * 32, lane); continue; } r -= J4;
        if (r < J7) { tr_item(a.in[I_WXO], 1024, 1024, (bf16_t*)(ws + WS_WT_XO), (r % 32) * 32, nullptr, 0, scr, (r / 32) * 64, (r % 32) * 32, lane); continue; } r -= J7;
        if (r < J8) { const int n0 = (r % 88) * 32; tr_item(a.in[I_WGATE], DFF, 1024, (bf16_t*)(ws + WS_WT_GU), (n0 >> 7) * 256 + (n0 & 127), a.in[I_LN3], 1024, scr, (r / 88) * 64, n0, lane); continue; } r -= J8;
        if (r < J9) { const int n0 = (r % 88) * 32; tr_item(a.in[I_WUP], DFF, 1024, (bf16_t*)(ws + WS_WT_GU), (n0 >> 7) * 256 + 128 + (n0 & 127), a.in[I_LN3], 1024, scr, (r / 88) * 64, n0, lane); continue; } r -= J9;
        tr_item(a.in[I_WDOWN], 1024, DFF, (bf16_t*)(ws + WS_WT_DOWN), (r % 32) * 32, nullptr, 0, scr, (r / 32) * 64, (r % 32) * 32, lane);
    }
}

struct ConvW { float w[4][8]; float b[8]; };
DEVI void convw_load(ConvW& cw, const float* conv_w, const float* conv_b, int ch) {
#pragma unroll
    for (int w = 0; w < 4; ++w) { const f32x4 p = *(const f32x4*)(conv_w + w * CONVD + ch), q = *(const f32x4*)(conv_w + w * CONVD + ch + 4);
#pragma unroll
        for (int j = 0; j < 4; ++j) { cw.w[w][j] = p[j]; cw.w[w][4 + j] = q[j]; } }
    const f32x4 p = *(const f32x4*)(conv_b + ch), q = *(const f32x4*)(conv_b + ch + 4);
#pragma unroll
    for (int j = 0; j < 4; ++j) { cw.b[j] = p[j]; cw.b[4 + j] = q[j]; }
}
DEVI void conv8_prompt(const ConvW& cw, const bf16_t* proj, int row, int t, int ch, float* o) {
    u32x4 raw[4];
#pragma unroll
    for (int w = 0; w < 4; ++w) { const int d = (t - 3 + w >= 0) ? (3 - w) : 0;
        raw[w] = *(const u32x4*)(proj + (size_t)(row - d) * NPROJ + 1024 + ch); }
#pragma unroll
    for (int j = 0; j < 8; ++j) o[j] = cw.b[j];
#pragma unroll
    for (int w = 0; w < 4; ++w) { float x[8]; unpack8(raw[w], x); const float m = (t - 3 + w >= 0) ? 1.f : 0.f;
#pragma unroll
        for (int j = 0; j < 8; ++j) o[j] += (x[j] * m) * cw.w[w][j]; }
#pragma unroll
    for (int j = 0; j < 8; ++j) o[j] = silu_(o[j]);
}
DEVI void ssd_dt_acum(const Args& a, LAS float* acum, LAS float* dtv, int row0, int g, int wave, int lane) {
    const int h = g * 8 + wave; const float* dtraw = (const float*)(a.ws + WS_DTRAW);
    const float A = -expf(a.in[I_ALOG][h]), bias = a.in[I_DTB][h];
    const float d0 = softplus_(dtraw[(size_t)(row0 + 2 * lane) * 16 + h] + bias), d1 = softplus_(dtraw[(size_t)(row0 + 2 * lane + 1) * 16 + h] + bias);
    const float v0 = d0 * A, v1 = v0 + d1 * A;
    float s = v1;
#pragma unroll
    for (int o = 1; o < 64; o <<= 1) { const float t = shfl_up_(s, o); if (lane >= o) s += t; }
    const float ex = s - v1;
    acum[wave * 128 + 2 * lane] = ex + v0; acum[wave * 128 + 2 * lane + 1] = ex + v1;
    dtv[wave * 128 + 2 * lane] = d0; dtv[wave * 128 + 2 * lane + 1] = d1;
}
constexpr int TLD = 136;
DEVI int swz(int r, int j) { return r * TLD + (j ^ (((r >> 3) & 15) << 3)); }
DEVI int swzb(int r, int kb) { return r * TLD + ((kb ^ ((r >> 3) & 15)) << 3); }

DEVI void ssd_pass1(const Args& a, LAS unsigned char* L, int unit, int tid, int lane, int wave) {
    const int g = unit & 1, c = (unit >> 1) & 15, b = unit >> 5, row0 = b * 2048 + c * 128, t0 = c * 128;
    LAS float* acum = (LAS float*)L; LAS float* dtv = (LAS float*)(L + 4096);
    LAS bf16_t* BT = (LAS bf16_t*)(L + 8192); LAS bf16_t* XW = (LAS bf16_t*)(L + 8192 + 128 * TLD * 2 + wave * (32 * TLD * 2));
    const bf16_t* proj = (const bf16_t*)(a.ws + WS_PROJ); float* cs = (float*)(a.ws + WS_CS);
    ssd_dt_acum(a, acum, dtv, row0, g, wave, lane);
    { const int cgi = tid >> 5, tl = tid & 31, n0 = 8 * cgi; ConvW cw; convw_load(cw, a.in[I_CONVW], a.in[I_CONVB], 1024 + g * 128 + n0);
#pragma unroll
      for (int i = 0; i < 4; ++i) { const int j = tl + 32 * i; float v[8]; conv8_prompt(cw, proj, row0 + j, t0 + j, 1024 + g * 128 + n0, v);
#pragma unroll
          for (int q = 0; q < 8; ++q) BT[swz(n0 + q, j)] = f2bf(v[q]); } }
    __syncthreads();
    const int r = lane & 15, q4 = lane >> 4, e = wave, h = g * 8 + e;
    const float aend = acum[e * 128 + 127];
    float* dst = cs + ((size_t)((b * 16 + c) * 16 + h) * 64) * 128;
    for (int half = 0; half < 2; ++half) {
        { const int cgi = lane & 3, tl = lane >> 2, p0 = 32 * half + 8 * cgi; ConvW cw; convw_load(cw, a.in[I_CONVW], a.in[I_CONVB], h * 64 + p0);
#pragma unroll 4
          for (int tb = 0; tb < 8; ++tb) { const int j = 16 * tb + tl; float v[8]; conv8_prompt(cw, proj, row0 + j, t0 + j, h * 64 + p0, v);
              const float sc = dtv[e * 128 + j] * __expf(aend - acum[e * 128 + j]);
#pragma unroll
              for (int q = 0; q < 8; ++q) XW[swz(8 * cgi + q, j)] = f2bf(v[q] * sc); } }
        LDS_WAIT();
        f32x4 acc[2][8];
#pragma unroll
        for (int pt = 0; pt < 2; ++pt)
#pragma unroll
            for (int t = 0; t < 8; ++t) acc[pt][t] = (f32x4){0.f, 0.f, 0.f, 0.f};
#pragma unroll
        for (int ks = 0; ks < 4; ++ks) {
            const bf16x8 fa0 = *(const LAS bf16x8*)(XW + swzb(r, 4 * ks + q4)), fa1 = *(const LAS bf16x8*)(XW + swzb(16 + r, 4 * ks + q4));
#pragma unroll
            for (int t = 0; t < 8; ++t) { const bf16x8 fb = *(const LAS bf16x8*)(BT + swzb(16 * t + r, 4 * ks + q4));
                acc[0][t] = __builtin_amdgcn_mfma_f32_16x16x32_bf16(fa0, fb, acc[0][t], 0, 0, 0);
                acc[1][t] = __builtin_amdgcn_mfma_f32_16x16x32_bf16(fa1, fb, acc[1][t], 0, 0, 0); }
        }
#pragma unroll
        for (int pt = 0; pt < 2; ++pt)
#pragma unroll
            for (int t = 0; t < 8; ++t)
#pragma unroll
                for (int k = 0; k < 4; ++k) dst[(size_t)(32 * half + 16 * pt + 4 * q4 + k) * 128 + 16 * t + r] = acc[pt][t][k];
        LDS_WAIT();
    }
    if (lane == 0) ((float*)(a.ws + WS_DECAY))[(b * 16 + c) * 16 + h] = __expf(aend);
    __syncthreads();
}

DEVI void ssd_pass3(const Args& a, LAS unsigned char* L, int unit, int tid, int lane, int wave) {
    const int g = unit & 1, c = (unit >> 1) & 15, b = unit >> 5, row0 = b * 2048 + c * 128, t0 = c * 128;
    LAS float* acum = (LAS float*)L; LAS float* dtv = (LAS float*)(L + 4096);
    LAS bf16_t* CT = (LAS bf16_t*)(L + 8192); LAS bf16_t* BMt = (LAS bf16_t*)(L + 8192 + 34816); LAS bf16_t* XT = (LAS bf16_t*)(L + 8192 + 2 * 34816);
    LAS float* cwL = (LAS float*)(L + 8192 + 2 * 34816 + 17408);
    LAS bf16_t* MW = CT + wave * 16 * TLD;
    const bf16_t* proj = (const bf16_t*)(a.ws + WS_PROJ); const bf16_t* sin_ = (const bf16_t*)(a.ws + WS_SIN);
    bf16_t* cat = (bf16_t*)(a.ws + WS_CAT); float* ssq = (float*)(a.ws + WS_SSQ_SSD);
    const int xcg = tid >> 6, xtl = tid & 63, p0 = 8 * xcg;
    u32x4 rx[2][4], rz[2];
#define P3_LOAD_RAW(hh) do { _Pragma("unroll") for (int i_ = 0; i_ < 2; ++i_) { const int j_ = xtl + 64 * i_; \
        _Pragma("unroll") for (int w_ = 0; w_ < 4; ++w_) { const int d_ = (t0 + j_ - 3 + w_ >= 0) ? (3 - w_) : 0; \
            rx[i_][w_] = *(const u32x4*)(proj + (size_t)(row0 + j_ - d_) * NPROJ + 1024 + (hh) * 64 + p0); } \
        rz[i_] = *(const u32x4*)(proj + (size_t)(row0 + j_) * NPROJ + (hh) * 64 + p0); } } while (0)
    ssd_dt_acum(a, acum, dtv, row0, g, wave, lane);
    for (int i = tid; i < 640; i += 512) { const int w = i >> 7, c4 = (i & 127) * 4;
        *(LAS f32x4*)(cwL + w * 512 + c4) = *(const f32x4*)((w < 4 ? a.in[I_CONVW] + w * CONVD : a.in[I_CONVB]) + g * 512 + c4); }
    { const int cgi = tid & 15, tl = tid >> 4, n0 = 8 * cgi;
#pragma unroll
      for (int mat = 0; mat < 2; ++mat) { const int ch = 1024 + mat * 256 + g * 128 + n0; ConvW cw; convw_load(cw, a.in[I_CONVW], a.in[I_CONVB], ch);
          LAS bf16_t* dstm = mat ? CT : BMt;
#pragma unroll
          for (int i = 0; i < 4; ++i) { const int j = tl + 32 * i; float v[8]; conv8_prompt(cw, proj, row0 + j, t0 + j, ch, v);
              u32x4 w; w.x = cvt_pk(v[0], v[1]); w.y = cvt_pk(v[2], v[3]); w.z = cvt_pk(v[4], v[5]); w.w = cvt_pk(v[6], v[7]);
              *(LAS u32x4*)(dstm + j * TLD + n0) = w; } } }
    __syncthreads();
    const int r = lane & 15, q4 = lane >> 4;
    bf16x8 aC[4]; f32x4 cb[8];
#pragma unroll
    for (int ks = 0; ks < 4; ++ks) aC[ks] = *(const LAS bf16x8*)(CT + (16 * wave + r) * TLD + 32 * ks + 8 * q4);
#pragma unroll
    for (int t = 0; t < 8; ++t) { cb[t] = (f32x4){0.f, 0.f, 0.f, 0.f};
#pragma unroll
        for (int ks = 0; ks < 4; ++ks) { const bf16x8 fb = *(const LAS bf16x8*)(BMt + (16 * t + r) * TLD + 32 * ks + 8 * q4);
            cb[t] = __builtin_amdgcn_mfma_f32_16x16x32_bf16(aC[ks], fb, cb[t], 0, 0, 0); } }
    float ssacc[4] = {0.f, 0.f, 0.f, 0.f};
    __syncthreads();
    LAS bf16_t* const XT0 = XT; LAS bf16_t* const XT1 = (LAS bf16_t*)(L + 105472);
    LAS bf16_t* const ZT0 = BMt; LAS bf16_t* const ZT1 = (LAS bf16_t*)(L + 122880);
    P3_LOAD_RAW(g * 8);
    for (int e = 0; e < 8; ++e) {
        const int h = g * 8 + e;
        XT = (e & 1) ? XT1 : XT0; LAS bf16_t* const ZT = (e & 1) ? ZT1 : ZT0;
        {
            f32x4 wl[4][2];
#pragma unroll
            for (int w = 0; w < 4; ++w) { wl[w][0] = *(const LAS f32x4*)(cwL + w * 512 + e * 64 + p0); wl[w][1] = *(const LAS f32x4*)(cwL + w * 512 + e * 64 + p0 + 4); }
            const f32x4 bl0 = *(const LAS f32x4*)(cwL + 2048 + e * 64 + p0), bl1 = *(const LAS f32x4*)(cwL + 2048 + e * 64 + p0 + 4);
#pragma unroll
            for (int i = 0; i < 2; ++i) { const int j = xtl + 64 * i; float o[8];
#pragma unroll
                for (int q = 0; q < 4; ++q) { o[q] = bl0[q]; o[4 + q] = bl1[q]; }
#pragma unroll
                for (int w = 0; w < 4; ++w) { float x[8]; unpack8(rx[i][w], x); const float m = (t0 + j - 3 + w >= 0) ? 1.f : 0.f;
#pragma unroll
                    for (int q = 0; q < 4; ++q) { o[q] += (x[q] * m) * wl[w][0][q]; o[4 + q] += (x[4 + q] * m) * wl[w][1][q]; } }
                *(LAS u32x4*)(ZT + j * 64 + p0) = rz[i];
#pragma unroll
                for (int q = 0; q < 8; ++q) XT[swz(p0 + q, j)] = f2bf(silu_(o[q])); }
        }
        if (e < 7) P3_LOAD_RAW(h + 1);
        __syncthreads();
        float ai[4];
#pragma unroll
        for (int k = 0; k < 4; ++k) ai[k] = acum[e * 128 + 16 * wave + 4 * q4 + k];
#pragma unroll
        for (int t = 0; t < 8; ++t) { const int j = 16 * t + r; const float aj = acum[e * 128 + j], dj = dtv[e * 128 + j];
#pragma unroll
            for (int k = 0; k < 4; ++k) { const int i = 16 * wave + 4 * q4 + k; const float m = (j <= i) ? cb[t][k] * __expf(ai[k] - aj) * dj : 0.f;
                MW[(4 * q4 + k) * TLD + j] = f2bf(m); } }
        LDS_WAIT();
        f32x4 acc[4], acc2[4];
#pragma unroll
        for (int pt = 0; pt < 4; ++pt) { acc[pt] = (f32x4){0.f, 0.f, 0.f, 0.f}; acc2[pt] = (f32x4){0.f, 0.f, 0.f, 0.f}; }
        if (c > 0) {
            const bf16_t* sp = sin_ + ((size_t)((b * 16 + c) * 16 + h) * 64) * 128;
#pragma unroll
            for (int ks = 0; ks < 4; ++ks)
#pragma unroll
                for (int pt = 0; pt < 4; ++pt) { const bf16x8 fs = *(const bf16x8*)(sp + (size_t)(16 * pt + r) * 128 + 32 * ks + 8 * q4);
                    acc2[pt] = __builtin_amdgcn_mfma_f32_16x16x32_bf16(aC[ks], fs, acc2[pt], 0, 0, 0); }
        }
#pragma unroll
        for (int ks = 0; ks < 4; ++ks) {
            const bf16x8 fm = *(const LAS bf16x8*)(MW + r * TLD + 32 * ks + 8 * q4);
#pragma unroll
            for (int pt = 0; pt < 4; ++pt) { const bf16x8 fx = *(const LAS bf16x8*)(XT + swzb(16 * pt + r, 4 * ks + q4));
                acc[pt] = __builtin_amdgcn_mfma_f32_16x16x32_bf16(fm, fx, acc[pt], 0, 0, 0); }
        }
        const float Dh = a.in[I_DSSD][h];
#pragma unroll
        for (int k = 0; k < 4; ++k) {
            const int i = 16 * wave + 4 * q4 + k; const float ea = __expf(ai[k]);
#pragma unroll
            for (int pt = 0; pt < 4; ++pt) {
                const int p = 16 * pt + r;
                const float xv = bf2f(XT[swz(p, i)]);
                const float y = acc[pt][k] + ea * acc2[pt][k] + Dh * xv;
                const float z = bf2f(ZT[i * 64 + p]);
                const float yz = y * silu_(z);
                cat[(size_t)(row0 + i) * 2048 + h * 64 + p] = f2bf(yz);
                ssacc[k] += yz * yz;
            }
        }
    }
#undef P3_LOAD_RAW
#pragma unroll
    for (int k = 0; k < 4; ++k) { float s = ssacc[k]; s += shfl_xor_(s, 1); s += shfl_xor_(s, 2); s += shfl_xor_(s, 4); s += shfl_xor_(s, 8);
        if (r == 0) atomicAdd(ssq + row0 + 16 * wave + 4 * q4 + k, s); }
    __syncthreads();
}

DEVI void ssd_step(const Args& a, LAS unsigned char* L, int unit, int tid, int lane) {
    const int g = unit & 1, b = unit >> 1, row = TP + b;
    LAS float* xs = (LAS float*)L; LAS float* Bv = xs + 512; LAS float* Cv = Bv + 128; LAS float* zs = Cv + 128; LAS float* sc = zs + 512;
    const bf16_t* proj = (const bf16_t*)(a.ws + WS_PROJ);
    const int n4 = (tid & 31) * 4, pr = tid >> 5;
    const float* s0p = a.in[I_SSSM] + ((size_t)(b * 16 + g * 8) * 64) * 128; float* s1p = a.out + O_SSMS + ((size_t)(b * 16 + g * 8) * 64) * 128;
    f32x4 s0[4];
#pragma unroll
    for (int it = 0; it < 4; ++it) s0[it] = __builtin_nontemporal_load((const f32x4*)(s0p + (size_t)(it * 16 + pr) * 128 + n4));
    zs[tid] = bf2f(proj[(size_t)row * NPROJ + g * 512 + tid]);
    if (tid < 96) {
        int ch; LAS float* dst;
        if (tid < 64) { ch = g * 512 + 8 * tid; dst = xs + 8 * tid; } else if (tid < 80) { ch = 1024 + g * 128 + 8 * (tid - 64); dst = Bv + 8 * (tid - 64); } else { ch = 1280 + g * 128 + 8 * (tid - 80); dst = Cv + 8 * (tid - 80); }
        ConvW cw; convw_load(cw, a.in[I_CONVW], a.in[I_CONVB], ch);
        float o[8]; float xn[8]; unpack8(*(const u32x4*)(proj + (size_t)row * NPROJ + 1024 + ch), xn);
#pragma unroll
        for (int j = 0; j < 8; ++j) o[j] = cw.b[j] + xn[j] * cw.w[3][j];
#pragma unroll
        for (int w = 0; w < 3; ++w) { const float* sp = a.in[I_SCONV] + ((size_t)b * 3 + w) * CONVD + ch; const f32x4 p = *(const f32x4*)sp, q = *(const f32x4*)(sp + 4);
#pragma unroll
            for (int j = 0; j < 4; ++j) { o[j] += p[j] * cw.w[w][j]; o[4 + j] += q[j] * cw.w[w][4 + j]; } }
#pragma unroll
        for (int j = 0; j < 8; ++j) dst[j] = silu_(o[j]);
    }
    if (tid >= 128 && tid < 136) { const int h = g * 8 + tid - 128; const float dt = softplus_(((const float*)(a.ws + WS_DTRAW))[(size_t)row * 16 + h] + a.in[I_DTB][h]);
        sc[tid - 128] = dt; sc[8 + tid - 128] = expf(-expf(a.in[I_ALOG][h]) * dt); }
    __syncthreads();
    const f32x4 bv = *(const LAS f32x4*)(Bv + n4), cv = *(const LAS f32x4*)(Cv + n4);
    bf16_t* cat = (bf16_t*)(a.ws + WS_CAT); float* ssq = (float*)(a.ws + WS_SSQ_SSD);
    float ssl = 0.f;
    for (int e = 0; e < 8; ++e) {
        const int h = g * 8 + e; const float dt = sc[e], dA = sc[8 + e], Dh = a.in[I_DSSD][h];
        f32x4 sn[4];
#pragma unroll
        for (int it = 0; it < 4; ++it) sn[it] = s0[it] * dA + bv * (dt * xs[e * 64 + it * 16 + pr]);
        if (e < 7) {
#pragma unroll
            for (int it = 0; it < 4; ++it) s0[it] = __builtin_nontemporal_load((const f32x4*)(s0p + (size_t)((e + 1) * 64 + it * 16 + pr) * 128 + n4));
        }
#pragma unroll
        for (int it = 0; it < 4; ++it) {
            const int p = it * 16 + pr;
            __builtin_nontemporal_store(sn[it], (f32x4*)(s1p + (size_t)(e * 64 + p) * 128 + n4));
            float part = (cv[0] * sn[it][0] + cv[1] * sn[it][1]) + (cv[2] * sn[it][2] + cv[3] * sn[it][3]);
            part += shfl_xor_(part, 1); part += shfl_xor_(part, 2); part += shfl_xor_(part, 4); part += shfl_xor_(part, 8); part += shfl_xor_(part, 16);
            if ((tid & 31) == 0) {
                const float y = part + Dh * xs[e * 64 + p]; const float yz = y * silu_(zs[e * 64 + p]);
                cat[(size_t)row * 2048 + h * 64 + p] = f2bf(yz); ssl += yz * yz;
            }
        }
    }
    if ((tid & 31) == 0) sc[16 + pr] = ssl;
    __syncthreads();
    if (tid == 0) { float t = 0.f;
#pragma unroll
        for (int i = 0; i < 16; ++i) t += sc[16 + i];
        atomicAdd(ssq + row, t); }
    __syncthreads();
}

struct S5Setup { float lbr, lbi; bf16x8 fB[8], bC[4], fD; };
template <bool WRITE_Y>
DEVI void s5_setup(const Args& a, S5Setup& st, int g, int lane) {
    const int p = lane, gp = g * 64 + p, r = lane & 15, q4 = lane >> 4;
    const float lr = a.in[I_LAMR][gp], li = a.in[I_LAMI][gp], step = expf(a.in[I_LSTEP][g]);
    const float mag = expf(lr * step); float sn, cs; sincosf(li * step, &sn, &cs);
    const float lbr = mag * cs, lbi = mag * sn; st.lbr = lbr; st.lbi = lbi; const float den = lr * lr + li * li;
    const float kre = ((lbr - 1.f) * lr + lbi * li) / den, kim = (lbi * lr - (lbr - 1.f) * li) / den;
#pragma unroll
    for (int jt = 0; jt < 4; ++jt) {
        const int pp = 16 * jt + r; const float kr = shfl_(kre, pp), ki = shfl_(kim, pp);
        const float* bp = a.in[I_BRE] + (size_t)(g * 64 + pp) * 16 + 8 * (q4 & 1); const float* bq = a.in[I_BIM] + (size_t)(g * 64 + pp) * 16 + 8 * (q4 & 1);
        const f32x4 br0 = *(const f32x4*)bp, br1 = *(const f32x4*)(bp + 4), bi0 = *(const f32x4*)bq, bi1 = *(const f32x4*)(bq + 4);
        u32x4 wr = pack8(br0 * kr - bi0 * ki, br1 * kr - bi1 * ki), wi = pack8(bi0 * kr + br0 * ki, bi1 * kr + br1 * ki);
        if (q4 >= 2) { wr = (u32x4){0u, 0u, 0u, 0u}; wi = (u32x4){0u, 0u, 0u, 0u}; }
        st.fB[jt] = *(const bf16x8*)&wr; st.fB[4 + jt] = *(const bf16x8*)&wi;
    }
    if (WRITE_Y) {
#pragma unroll
        for (int ks = 0; ks < 4; ++ks) { const float* src = (ks < 2 ? a.in[I_CRE] : a.in[I_CIM]) + (size_t)(g * 16 + r) * 64 + 32 * (ks & 1) + 8 * q4;
            f32x4 v0 = *(const f32x4*)src, v1 = *(const f32x4*)(src + 4); if (ks >= 2) { v0 = -v0; v1 = -v1; }
            const u32x4 w = pack8(v0, v1); st.bC[ks] = *(const bf16x8*)&w; }
        const float dv = a.in[I_DS5][g * 16 + r]; f32x4 d0, d1;
#pragma unroll
        for (int j = 0; j < 4; ++j) { d0[j] = (q4 < 2 && 8 * q4 + j == r) ? dv : 0.f; d1[j] = (q4 < 2 && 8 * q4 + 4 + j == r) ? dv : 0.f; }
        const u32x4 w = pack8(d0, d1); st.fD = *(const bf16x8*)&w;
    }
}
template <bool WRITE_Y>
DEVI void s5_unit(const Args& a, const S5Setup& st, LAS unsigned char* Lw, int g, int row0_, int ntok, const float* cin_re_, const float* cin_im_, float* out_re_, float* out_im_, int lane, int nseq, int seq_rows, int seq_state) {
    LAS float* BU = (LAS float*)Lw; LAS bf16_t* SX = (LAS bf16_t*)(Lw + 10240);
    const bf16_t* proj = (const bf16_t*)(a.ws + WS_PROJ); bf16_t* gb = (bf16_t*)(a.ws + WS_GB);
    const int p = lane, r = lane & 15, q4 = lane >> 4;
    const float lbr = st.lbr, lbi = st.lbi;
  for (int sq = 0; sq < nseq; ++sq) {
    const int row0 = row0_ + sq * seq_rows;
    const float* cin_re = cin_re_ ? cin_re_ + (size_t)sq * seq_state : nullptr; const float* cin_im = cin_im_ ? cin_im_ + (size_t)sq * seq_state : nullptr;
    float* out_re = out_re_ ? out_re_ + (size_t)sq * seq_state : nullptr; float* out_im = out_im_ ? out_im_ + (size_t)sq * seq_state : nullptr;
    float sre = cin_re ? cin_re[p] : 0.f, sim = cin_im ? cin_im[p] : 0.f;
    const bf16_t* up = proj + (size_t)(row0 + r) * NPROJ + 2560 + g * 16 + 8 * (q4 & 1);
    u32x4 un = (u32x4){0u, 0u, 0u, 0u};
    if (q4 < 2 && r < ntok) un = *(const u32x4*)up;
    for (int tb = 0; tb < ntok; tb += 16) {
        const int nt = (ntok - tb) < 16 ? (ntok - tb) : 16;
        const u32x4 uc = un; const bf16x8 fu = *(const bf16x8*)&uc;
        un = (u32x4){0u, 0u, 0u, 0u};
        if (q4 < 2 && tb + 16 + r < ntok) un = *(const u32x4*)(up + (size_t)(tb + 16) * NPROJ);
#pragma unroll
        for (int j = 0; j < 8; ++j) { const f32x4 d = __builtin_amdgcn_mfma_f32_16x16x32_bf16(fu, st.fB[j], (f32x4){0.f, 0.f, 0.f, 0.f}, 0, 0, 0);
            *(LAS f32x4*)(BU + (64 * (j >> 2) + 16 * (j & 3) + r) * 20 + 4 * q4) = d; }
        LDS_WAIT();
        float bur[16], bui[16];
#pragma unroll
        for (int i = 0; i < 4; ++i) { const f32x4 vr = *(const LAS f32x4*)(BU + p * 20 + 4 * i), vi = *(const LAS f32x4*)(BU + (64 + p) * 20 + 4 * i);
#pragma unroll
            for (int k = 0; k < 4; ++k) { bur[4 * i + k] = vr[k]; bui[4 * i + k] = vi[k]; } }
#pragma unroll
        for (int tl = 0; tl < 16; ++tl) {
            if (tl < nt) {
                const float nr = lbr * sre - lbi * sim + bur[tl], ni = lbr * sim + lbi * sre + bui[tl];
                sre = nr; sim = ni;
                if (WRITE_Y) { SX[tl * TLD + p] = f2bf(sre); SX[tl * TLD + 64 + p] = f2bf(sim); }
            }
        }
        if (WRITE_Y) {
            LDS_WAIT();
            f32x4 acc = __builtin_amdgcn_mfma_f32_16x16x32_bf16(fu, st.fD, (f32x4){0.f, 0.f, 0.f, 0.f}, 0, 0, 0);
#pragma unroll
            for (int ks = 0; ks < 4; ++ks) { const bf16x8 fa = *(const LAS bf16x8*)(SX + r * TLD + 32 * ks + 8 * q4); acc = __builtin_amdgcn_mfma_f32_16x16x32_bf16(fa, st.bC[ks], acc, 0, 0, 0); }
#pragma unroll
            for (int k = 0; k < 4; ++k) { const int tl = 4 * q4 + k;
                if (tl < nt) gb[(size_t)(row0 + tb + tl) * 1024 + g * 16 + r] = f2bf(gelu_(acc[k])); }
        }
        LDS_WAIT();
    }
    if (out_re) { out_re[p] = sre; out_im[p] = sim; }
  }
}

DEVI void attn_sample(const Args& a, LAS unsigned char* L, int unit, int tid, int lane, int wave) {
    const int h = unit & 3, b = unit >> 2, row = TP + b;
    LAS float* qs = (LAS float*)L; LAS float* sc = qs + 256; LAS float* red = sc + 256;
    const bf16_t* qb = (const bf16_t*)(a.ws + WS_QB); bf16_t* ob = (bf16_t*)(a.ws + WS_OB);
    const float* kp = a.in[I_CK] + ((size_t)(b * 256 + wave * 32) * 4 + h) * 256 + 4 * lane;
    const float* vp = a.in[I_CV] + ((size_t)(b * 256 + wave * 32) * 4 + h) * 256 + 4 * lane;
    f32x4 kv[32];
#pragma unroll
    for (int i = 0; i < 32; ++i) kv[i] = __builtin_nontemporal_load((const f32x4*)(kp + (size_t)i * 1024));
    if (tid < 256) qs[tid] = bf2f(qb[(size_t)row * 1024 + h * 256 + tid]);
    __syncthreads();
    const f32x4 q = *(const LAS f32x4*)(qs + 4 * lane);
    float myd = 0.f;
#pragma unroll
    for (int i = 0; i < 32; ++i) { const float d = wave_sum((kv[i][0] * q[0] + kv[i][1] * q[1]) + (kv[i][2] * q[2] + kv[i][3] * q[3])); if (lane == i) myd = d; }
    if (lane < 32) sc[wave * 32 + lane] = myd;
#pragma unroll
    for (int i = 0; i < 32; ++i) kv[i] = __builtin_nontemporal_load((const f32x4*)(vp + (size_t)i * 1024));
    __syncthreads();
    const f32x4 s4 = *(const LAS f32x4*)(sc + 4 * lane);
    float mx = fmaxf(fmaxf(s4[0], s4[1]), fmaxf(s4[2], s4[3]));
#pragma unroll
    for (int o = 1; o < 64; o <<= 1) mx = fmaxf(mx, shfl_xor_(mx, o));
    const float inv = 1.f / wave_sum((__expf(s4[0] - mx) + __expf(s4[1] - mx)) + (__expf(s4[2] - mx) + __expf(s4[3] - mx)));
    f32x4 acc = (f32x4){0.f, 0.f, 0.f, 0.f};
#pragma unroll
    for (int i = 0; i < 32; ++i) { const float pm = __expf(sc[wave * 32 + i] - mx) * inv; acc += kv[i] * pm; }
    *(LAS f32x4*)(red + wave * 256 + 4 * lane) = acc;
    __syncthreads();
    if (tid < 256) { float o = 0.f;
#pragma unroll
        for (int w = 0; w < 8; ++w) o += red[w * 256 + tid];
        ob[(size_t)row * 1024 + h * 256 + tid] = f2bf(o); }
    __syncthreads();
}

constexpr int NPH = 14;
__global__ void __launch_bounds__(512, 2) hymba_fwd(Args a) {
    extern __shared__ __attribute__((aligned(16))) unsigned char lds_raw[];
    LAS unsigned char* L = (LAS unsigned char*)lds_raw;
    const int wave = __builtin_amdgcn_readfirstlane((int)threadIdx.x >> 6);
#define lane (lane_id_())
#define tid (wave * 64 + lane_id_())
    const int G = gridDim.x, bid = blockIdx.x, gw = bid * 8 + wave, NGW = G * 8, NT = G * 512;
#define gt (bid * 512 + tid)
    unsigned char* ws = a.ws;
    volatile LAS unsigned* MISC = (volatile LAS unsigned*)(L + MISC_OFF);
    if (tid < 32) MISC[tid] = 0u;
    __syncthreads();
    XcdBarrier bar; bar.bar = (unsigned*)(ws + WS_BAR); bar.x = 0; bar.st = nullptr;
    if (a.ph_hi - a.ph_lo > 1) bar = xcd_barrier_post((unsigned*)(ws + WS_BAR), MISC + 8, wave == 0 && lane_id_() == 0);
    if (a.ph_lo < 0) cg::this_grid().sync();
    const int lo = a.ph_lo, hi = a.ph_hi;
#define IN(k) (lo <= (k) && (k) < hi)
#ifndef PROBE_BAR2
#define PROBE_BAR2 0
#endif
#ifndef PROBE_MASK
#define PROBE_MASK 0
#endif
    unsigned long long tph = PROBE_MASK ? __builtin_amdgcn_s_memrealtime() : 0ull;
#ifndef PROBE_SUB
#define PROBE_SUB 0
#endif
    unsigned long long ts0 = 0ull;
#define SUBSPIN(id) do { if (PROBE_SUB == (id)) { __syncthreads(); const unsigned long long t1_ = __builtin_amdgcn_s_memrealtime(), d_ = t1_ - ts0; while (__builtin_amdgcn_s_memrealtime() - t1_ < d_) __builtin_amdgcn_s_sleep(8); } if (PROBE_SUB) ts0 = __builtin_amdgcn_s_memrealtime(); } while (0)
#define SEAM(k) do { if (((PROBE_MASK) >> (k)) & 1) { __syncthreads(); const unsigned long long t1_ = __builtin_amdgcn_s_memrealtime(), d_ = t1_ - tph; \
        while (__builtin_amdgcn_s_memrealtime() - t1_ < d_) __builtin_amdgcn_s_sleep(8); } \
    if (IN(k) && IN((k) + 1)) { xcd_barrier(bar, wave); if (PROBE_BAR2) xcd_barrier(bar, wave); } if (PROBE_MASK) tph = __builtin_amdgcn_s_memrealtime(); } while (0)
    bf16_t* const proj = (bf16_t*)(ws + WS_PROJ);
    float* const x1f = (float*)(ws + WS_X1F);

    if (IN(0)) { p0_prologue(a, L, tid, lane, wave); __syncthreads(); } SEAM(0);

    if (IN(1)) {
        { pg8::Gemm g{(const bf16_t*)(ws + WS_HB), (const bf16_t*)(ws + WS_WT_IN), 1024, 1024, 1024, 0}; pg8::StaticOrder S; S.init(SKN(1) ? 64 : 65, 14, G, bid);
          const FIn fin{proj, a.out + O_CONVP, a.out + O_CONVS}; pg8::EpiRow<FIn> E{fin}; pg8::gemm_phase(L, g, S, E, wave);
          for (int u = G - 1 - bid - 64; SKN(1) && u >= 0 && u < 56; u += G) sgemm_unit((const bf16_t*)(ws + WS_HB) + (size_t)TP * 1024, 1024, (const bf16_t*)(ws + WS_WT_IN), 1024, 1024, u >> 2, u & 3, fin, lane, wave); }
        { pg8::Gemm g{(const bf16_t*)(ws + WS_MEMB), (const bf16_t*)(ws + WS_WT_KV), 1024, 1024, 1024, 0}; pg8::StaticOrder S; S.init(8, 8, G, G - 1 - bid);
          pg8::EpiRow<FKV> E{FKV{a.out + O_MEMK, a.out + O_MEMV, (bf16_t*)(ws + WS_KB), (bf16_t*)(ws + WS_VT)}}; pg8::gemm_phase(L, g, S, E, wave); }
    } SEAM(1);

    if (IN(2)) {
        if (PROBE_SUB) ts0 = __builtin_amdgcn_s_memrealtime();
        for (int u = bid; u < 256; u += G) ssd_pass1(a, L, u, tid, lane, wave);
        SUBSPIN(1);
        for (int u = bid; u < 256; u += G) ssd_step(a, L, u, tid, lane);
        SUBSPIN(2);
        float* er = (float*)(ws + WS_S5END); float* ei = er + 8 * 64 * S5NCH * 64;
        { S5Setup st; int gc = -1;
          for (int u = gw; u < 8 * 64 * S5NCH; u += NGW) { const int g = (u & 7) | (((u >> 6) & 7) << 3), k = (u >> 3) & 7, b = u >> 9;
            const size_t ix = (size_t)((b * 64 + g) * S5NCH + k) * 64;
            if (g != gc) { s5_setup<false>(a, st, g, lane); gc = g; }
            s5_unit<false>(a, st, L + wave * 14592, g, b * 2048 + k * S5LC, S5LC, nullptr, nullptr, er + ix, ei + ix, lane, 1, 0, 0); } }
    } SEAM(2);

    if (IN(3)) {
        p3_weights(a, L, lane, wave);
        const float* cs = (const float*)(ws + WS_CS); const float* dec = (const float*)(ws + WS_DECAY); bf16_t* sin_ = (bf16_t*)(ws + WS_SIN); float* sout = a.out + O_SSMP;
        for (int i = gt; i < 8 * 16 * 64 * 32; i += NT) {
            const int n4 = (i & 31) * 4, p = (i >> 5) & 63, h = (i >> 11) & 15, b = i >> 15;
            f32x4 S = (f32x4){0.f, 0.f, 0.f, 0.f};
            f32x4 cv[16]; float dv[16];
#pragma unroll
            for (int c = 0; c < 16; ++c) { cv[c] = __builtin_nontemporal_load((const f32x4*)(cs + ((size_t)((b * 16 + c) * 16 + h) * 64 + p) * 128 + n4)); dv[c] = dec[(b * 16 + c) * 16 + h]; }
#pragma unroll
            for (int c = 0; c < 16; ++c) { const size_t off = ((size_t)((b * 16 + c) * 16 + h) * 64 + p) * 128 + n4;
                u32x2 w; w.x = cvt_pk(S[0], S[1]); w.y = cvt_pk(S[2], S[3]); *(u32x2*)(sin_ + off) = w;
                S = S * dv[c] + cv[c]; }
            __builtin_nontemporal_store(S, (f32x4*)(sout + ((size_t)(b * 16 + h) * 64 + p) * 128 + n4));
        }
        const float* er = (const float*)(ws + WS_S5END); const float* ei = er + 8 * 64 * S5NCH * 64; float* cr = (float*)(ws + WS_S5CAR); float* ci = cr + 8 * 64 * S5NCH * 64;
        for (int i = gt; i < 8 * 64 * 64; i += NT) {
            const int p = i & 63, g = (i >> 6) & 63, b = i >> 12, gp = g * 64 + p;
            const float lr = a.in[I_LAMR][gp], li = a.in[I_LAMI][gp], step = expf(a.in[I_LSTEP][g]);
            const float mag = expf(lr * step); float sn, cs_; sincosf(li * step, &sn, &cs_);
            float pr = mag * cs_, pi = mag * sn;
#pragma unroll
            for (int s = 0; s < 8; ++s) { const float nr = pr * pr - pi * pi, ni = 2.f * pr * pi; pr = nr; pi = ni; }
            float c_r = 0.f, c_i = 0.f; float evr[S5NCH], evi[S5NCH];
#pragma unroll
            for (int k = 0; k < S5NCH; ++k) { const size_t off = ((size_t)((b * 64 + g) * S5NCH + k)) * 64 + p; evr[k] = er[off]; evi[k] = ei[off]; }
#pragma unroll
            for (int k = 0; k < S5NCH; ++k) { const size_t off = ((size_t)((b * 64 + g) * S5NCH + k)) * 64 + p;
                cr[off] = c_r; ci[off] = c_i;
                const float nr = pr * c_r - pi * c_i + evr[k], ni = pr * c_i + pi * c_r + evi[k]; c_r = nr; c_i = ni; }
            a.out[O_S5RP + (size_t)(b * 64 + g) * 64 + p] = c_r; a.out[O_S5IP + (size_t)(b * 64 + g) * 64 + p] = c_i;
        }
    } SEAM(3);

    if (IN(4)) {
        if (PROBE_SUB) ts0 = __builtin_amdgcn_s_memrealtime();
        for (int u = bid; u < 256; u += G) ssd_pass3(a, L, u, tid, lane, wave);
        SUBSPIN(4);
        const float* cr = (const float*)(ws + WS_S5CAR); const float* ci = cr + 8 * 64 * S5NCH * 64;
        { S5Setup st; int gc = -1;
          for (int u = gw; u < 8 * 64 * S5NCH + 2048; u += NGW) {
            if (u < 8 * 64 * S5NCH) { const int g = (u & 7) | (((u >> 6) & 7) << 3), k = (u >> 3) & 7, b = u >> 9;
                const size_t ix = (size_t)((b * 64 + g) * S5NCH + k) * 64;
                if (g != gc) { s5_setup<true>(a, st, g, lane); gc = g; }
                s5_unit<true>(a, st, L + wave * 14592, g, b * 2048 + k * S5LC, S5LC, cr + ix, ci + ix, nullptr, nullptr, lane, 1, 0, 0); }
            else { const int v = u - 8 * 64 * S5NCH, g = (v & 7) | (((v >> 6) & 7) << 3), b4 = (((v >> 3) & 7) | ((v >> 9) << 3)) * 4; const size_t so = (size_t)(b4 * 64 + g) * 64;
                if (g != gc) { s5_setup<true>(a, st, g, lane); gc = g; }
                s5_unit<true>(a, st, L + wave * 14592, g, TP + b4, 1, a.in[I_SS5R] + so, a.in[I_SS5I] + so, a.out + O_S5RS + so, a.out + O_S5IS + so, lane, 4, 1, 64 * 64); }
          } }
        __syncthreads();
    } SEAM(4);

    if (IN(5)) {
        pg8::Gemm g{(const bf16_t*)(ws + WS_GB), (const bf16_t*)(ws + WS_WT_GLU), 1024, 1024, 1024, 0}; pg8::StaticOrder S; S.init(SKN(5) ? 64 : 65, 4, G, bid);
        const FGlu fg{(const bf16_t*)(ws + WS_GB), a.in[I_BGLU], (bf16_t*)(ws + WS_CAT), (const float*)(ws + WS_SSQ_SSD)}; pg8::EpiRow<FGlu> E{fg}; pg8::gemm_phase(L, g, S, E, wave);
        if (PROBE_SUB) { __syncthreads(); ts0 = __builtin_amdgcn_s_memrealtime(); }
        for (int u = bid; SKN(5) && u < 128; u += G) sgemm3_unit(L, (const bf16_t*)(ws + WS_GB) + (size_t)TP * 1024, 1024, (const bf16_t*)(ws + WS_WT_GLU), 1024, 1024, u, fg, lane, wave);
        SUBSPIN(5);
    } SEAM(5);

    if (IN(6)) {
        pg8::Gemm g{(const bf16_t*)(ws + WS_CAT), (const bf16_t*)(ws + WS_WT_OUT), 2048, 2048, 2048, 0}; pg8::StaticOrder S; S.init(SKN(6) ? 64 : 65, 4, G, bid);
        const FResT<false> fr{a.in[I_XP], a.in[I_XS], nullptr, nullptr, (bf16_t*)(ws + WS_X1B), (float*)(ws + WS_SSQ1)}; pg8::EpiRow<FResT<false>> E{fr}; pg8::gemm_phase(L, g, S, E, wave, (const float*)(ws + WS_SSQ_SSD));
        if (PROBE_SUB) { __syncthreads(); ts0 = __builtin_amdgcn_s_memrealtime(); }
        for (int u = bid; SKN(6) && u < 128; u += G) sgemm3_unit(L, (const bf16_t*)(ws + WS_CAT) + (size_t)TP * 2048, 2048, (const bf16_t*)(ws + WS_WT_OUT), 2048, 2048, u, fr, lane, wave, (const float*)(ws + WS_SSQ_SSD));
        SUBSPIN(5);
    } SEAM(6);

    if (IN(7)) {
        pg8::Gemm g{(const bf16_t*)(ws + WS_X1B), (const bf16_t*)(ws + WS_WT_XQ), 1024, 1024, 1024, 0}; pg8::StaticOrder S; S.init(SKN(7) ? 64 : 65, 4, G, bid);
        const FQ fq_{(bf16_t*)(ws + WS_QB), (const float*)(ws + WS_SSQ1)}; pg8::EpiRow<FQ> E{fq_}; pg8::gemm_phase(L, g, S, E, wave);
        if (PROBE_SUB) { __syncthreads(); ts0 = __builtin_amdgcn_s_memrealtime(); }
        for (int u = bid; SKN(7) && u < 128; u += G) sgemm3_unit(L, (const bf16_t*)(ws + WS_X1B) + (size_t)TP * 1024, 1024, (const bf16_t*)(ws + WS_WT_XQ), 1024, 1024, u, fq_, lane, wave);
        SUBSPIN(5);
    } SEAM(7);

    if (IN(8)) {
        { pg8::Gemm g{(const bf16_t*)(ws + WS_QB), (const bf16_t*)(ws + WS_KB), 1024, 1024, 256, 1}; pg8::StaticOrder S; S.init(64, 4, G, bid);
          pg8::EpiRow<FS> E{FS{(bf16_t*)(ws + WS_PB), (float*)(ws + WS_LSUM)}}; pg8::gemm_phase(L, g, S, E, wave); }
        for (int u = bid; u < TS * 4; u += G) attn_sample(a, L, u, tid, lane, wave);
    } SEAM(8);

    if (IN(9)) {
        pg8::Gemm g{(const bf16_t*)(ws + WS_PB), (const bf16_t*)(ws + WS_VT), 1024, 256, 256, 2}; pg8::StaticOrder S; S.init(64, 4, G, bid);
        pg8::EpiRow<FPV> E{FPV{(bf16_t*)(ws + WS_OB), (const float*)(ws + WS_LSUM)}}; pg8::gemm_phase(L, g, S, E, wave);
    } SEAM(9);

    if (IN(10)) {
        pg8::Gemm g{(const bf16_t*)(ws + WS_OB), (const bf16_t*)(ws + WS_WT_XO), 1024, 1024, 1024, 0}; pg8::StaticOrder S; S.init(SKN(10) ? 64 : 65, 4, G, bid);
        bf16_t* const x1b = (bf16_t*)(ws + WS_X1B);
        const FResT<true> fr{x1b, x1b + (size_t)TP * 1024, nullptr, nullptr, x1b, (float*)(ws + WS_SSQ2)}; pg8::EpiRow<FResT<true>> E{fr}; pg8::gemm_phase(L, g, S, E, wave);
        if (PROBE_SUB) { __syncthreads(); ts0 = __builtin_amdgcn_s_memrealtime(); }
        for (int u = bid; SKN(10) && u < 128; u += G) sgemm3_unit(L, (const bf16_t*)(ws + WS_OB) + (size_t)TP * 1024, 1024, (const bf16_t*)(ws + WS_WT_XO), 1024, 1024, u, fr, lane, wave);
        SUBSPIN(5);
    } SEAM(10);

    if (IN(11)) {
        pg8::Gemm g{(const bf16_t*)(ws + WS_X1B), (const bf16_t*)(ws + WS_WT_GU), 1024, 1024, 1024, 0}; pg8::StaticOrder S; S.init(SKN(11) ? 64 : 65, 22, G, bid);
        const FUp fu{(bf16_t*)(ws + WS_MID), (const float*)(ws + WS_SSQ2)}; pg8::EpiRow<FUp> E{fu}; pg8::gemm_phase(L, g, S, E, wave);
        for (int u = G - 1 - bid; SKN(11) && u < 88; u += G) sgemm_unit((const bf16_t*)(ws + WS_X1B) + (size_t)TP * 1024, 1024, (const bf16_t*)(ws + WS_WT_GU), 1024, 1024, u >> 2, u & 3, fu, lane, wave);
    } SEAM(11);

    if (IN(12)) {
        pg8::Gemm g{(const bf16_t*)(ws + WS_MID), (const bf16_t*)(ws + WS_WT_DOWN), DFF, DFF, DFF, 0}; pg8::StaticOrder S; S.init(SKN(12) ? 64 : 65, 4, G, bid);
        bf16_t* const x1b = (bf16_t*)(ws + WS_X1B);
        const FResT<true> fr{x1b, x1b + (size_t)TP * 1024, a.out + O_YP, a.out + O_YS, nullptr, (float*)(ws + WS_SSQ3)};
        const bool fuse_norm = SKN(12) && G == 256 && (hi - lo > 1);
        if (fuse_norm) { const EpiFinal E{x1b, a.out + O_YP, (float*)(ws + WS_SSQ3), a.in[I_FING], &bar, wave}; pg8::gemm_phase(L, g, S, E, wave); }
        else { pg8::EpiRow<FResT<true>> E{fr}; pg8::gemm_phase(L, g, S, E, wave); }
        if (PROBE_SUB) { __syncthreads(); ts0 = __builtin_amdgcn_s_memrealtime(); }
        for (int u = bid; SKN(12) && u < 128; u += G) sgemm3_unit(L, (const bf16_t*)(ws + WS_MID) + (size_t)TP * DFF, DFF, (const bf16_t*)(ws + WS_WT_DOWN), DFF, DFF, u, fr, lane, wave);
        SUBSPIN(5);
    } SEAM(12);

    if (IN(13)) {
        const float* ssq = (const float*)(ws + WS_SSQ3); const float* fg = a.in[I_FING];
        const bool fused13 = SKN(12) && G == 256 && (hi - lo > 1);
        for (int row0 = fused13 ? TP + gw : gw; row0 < TP + TS; row0 += 4 * NGW) {
            f32x4 v[4][4]; float rs[4]; float* yp[4];
#pragma unroll
            for (int i = 0; i < 4; ++i) { const int row = row0 + i * NGW; const bool ok = row < TP + TS; const int rr = ok ? row : row0;
                yp[i] = (rr < TP ? a.out + O_YP + (size_t)rr * 1024 : a.out + O_YS + (size_t)(rr - TP) * 1024) + 4 * lane;
                rs[i] = rsqrtf(ssq[rr] * (1.f / 1024.f) + EPS);
#pragma unroll
                for (int j = 0; j < 4; ++j) v[i][j] = *(const f32x4*)(yp[i] + 256 * j); }
#pragma unroll
            for (int i = 0; i < 4; ++i) { const int row = row0 + i * NGW;
                if (row < TP + TS) {
#pragma unroll
                    for (int j = 0; j < 4; ++j) { const f32x4 gg = *(const f32x4*)(fg + 4 * lane + 256 * j); *(f32x4*)(yp[i] + 256 * j) = v[i][j] * rs[i] * gg; } } }
        }
    } SEAM(13);
#undef IN
#undef SEAM
#undef lane
#undef tid
#undef gt
}

extern "C" void kernel_launch(void* const* d_in, const int* in_sizes, int n_in, void* d_out, int out_size, void* d_ws, size_t ws_size, hipStream_t stream) {
    static int grid = 0;
    if (grid == 0) {
        if (n_in != 38 || ws_size < WS_END) { fprintf(stderr, "kernel_launch: unexpected n_in %d / ws %zu\n", n_in, ws_size); grid = -1; return; }
        int dev = 0, cus = 0, per_cu = 0;
        if (hipGetDevice(&dev) != hipSuccess || hipDeviceGetAttribute(&cus, hipDeviceAttributeMultiprocessorCount, dev) != hipSuccess) { grid = -1; return; }
        if (hipFuncSetAttribute((const void*)hymba_fwd, hipFuncAttributeMaxDynamicSharedMemorySize, LDS_BYTES) != hipSuccess) { fprintf(stderr, "kernel_launch: hipFuncSetAttribute failed\n"); grid = -1; return; }
        if (hipOccupancyMaxActiveBlocksPerMultiprocessor(&per_cu, (const void*)hymba_fwd, 512, LDS_BYTES) != hipSuccess || per_cu < 1) { fprintf(stderr, "kernel_launch: occupancy query says %d\n", per_cu); per_cu = 1; }
        (void)hipGetLastError();
        grid = cus;
    }
    if (grid < 0) return;
    (void)hipMemsetAsync((char*)d_ws + WS_BAR, 0, XCD_BAR_WORDS * 4, stream);
    Args a{};
    for (int i = 0; i < 38; ++i) a.in[i] = (const float*)d_in[i];
    a.out = (float*)d_out; a.ws = (unsigned char*)d_ws;
#if MK_MULTI
    for (int ph = 0; ph < NPH; ++ph) { a.ph_lo = ph; a.ph_hi = ph + 1; hipLaunchKernelGGL(hymba_fwd, dim3(grid), dim3(512), LDS_BYTES, stream, a); }
#else
    a.ph_lo = 0; a.ph_hi = NPH;
    void* args[] = {&a};
    hipError_t e = hipLaunchCooperativeKernel((const void*)hymba_fwd, dim3(grid), dim3(512), args, LDS_BYTES, stream);
    if (e != hipSuccess) fprintf(stderr, "kernel_launch: cooperative launch failed: %s (grid %d)\n", hipGetErrorString(e), grid);
#endif
}
```

```cpp
#include <hip/hip_runtime.h>
#include <hip/hip_cooperative_groups.h>
#include <cstdio>
#include <cstdint>
namespace cg = cooperative_groups;

#ifndef SK_MASK
#define SK_MASK 0x14E0
#endif
#define SKN(k) (((SK_MASK) >> (k)) & 1)
#ifndef MK_MULTI
#define MK_MULTI 0

#endif

#define DEVI __device__ __forceinline__
#define LAS __attribute__((address_space(3)))
typedef unsigned short bf16_t;
typedef short bf16x8 __attribute__((ext_vector_type(8)));
typedef float f32x4 __attribute__((ext_vector_type(4)));
typedef unsigned u32x4 __attribute__((ext_vector_type(4)));
typedef unsigned u32x2 __attribute__((ext_vector_type(2)));

constexpr int TP = 16384, TS = 128, TALL = 16640;
constexpr int DM = 1024, NPROJ = 3584, WIN_LD = 3600, DFF = 2816, CONVD = 1536;
constexpr float EPS = 1e-6f;
constexpr int S5LC = 256, S5NCH = 8;

constexpr size_t MiB = 1u << 20;
constexpr size_t WS_SSQ_SSD = 0, WS_SSQ1 = 128 * 1024, WS_SSQ2 = 256 * 1024, WS_SSQ3 = 384 * 1024, WS_LSUM = 512 * 1024, WS_ZERO_END = 896 * 1024;
constexpr size_t WS_DECAY = 896 * 1024;
constexpr size_t WS_BAR = 960 * 1024;
constexpr size_t WS_DTRAW = 1 * MiB;
constexpr size_t WS_WT_IN = 3 * MiB, WS_WT_GLU = 10 * MiB, WS_WT_OUT = 12 * MiB, WS_WT_XQ = 16 * MiB, WS_WT_KV = 18 * MiB, WS_WT_XO = 22 * MiB,
                 WS_WT_GU = 24 * MiB, WS_WT_DOWN = 35 * MiB;
constexpr size_t WS_KB = 41 * MiB, WS_VT = 45 * MiB, WS_MEMB = 49 * MiB, WS_S5END = 53 * MiB, WS_S5CAR = 61 * MiB;
constexpr size_t WS_PROJ = 70 * MiB, WS_MID = 70 * MiB;
constexpr size_t WS_HB = 184 * MiB, WS_X1B = 184 * MiB;
constexpr size_t WS_CS = 217 * MiB, WS_QB = 217 * MiB, WS_PB = 250 * MiB;
constexpr size_t WS_SIN = 281 * MiB, WS_OB = 283 * MiB;
constexpr size_t WS_CAT = 316 * MiB, WS_GB = 382 * MiB, WS_X1F = 415 * MiB, WS_END = 481 * MiB;

constexpr size_t O_YP = 0, O_YS = 16777216, O_CONVP = 16908288, O_SSMP = 16945152, O_S5RP = 17993728, O_S5IP = 18026496,
                 O_MEMK = 18059264, O_MEMV = 20156416, O_CONVS = 22253568, O_SSMS = 22843392, O_S5RS = 39620608, O_S5IS = 40144896;

constexpr int LDS_BYTES = 147456;
constexpr int MISC_OFF = 131072 + 8192;

struct Args { const float* in[38]; float* out; unsigned char* ws; int ph_lo, ph_hi; };
enum { I_XP = 0, I_XS, I_MEM, I_SCONV, I_SSSM, I_SS5R, I_SS5I, I_CK, I_CV, I_LN1, I_WIN, I_CONVW, I_CONVB, I_DTB, I_ALOG, I_DSSD, I_GN,
       I_LAMR, I_LAMI, I_LSTEP, I_BRE, I_BIM, I_CRE, I_CIM, I_DS5, I_WGLU, I_BGLU, I_WOUT, I_LN2, I_WXQ, I_WXK, I_WXV, I_WXO, I_LN3,
       I_WGATE, I_WUP, I_WDOWN, I_FING };

DEVI unsigned cvt_pk(float lo, float hi) { unsigned r; asm("v_cvt_pk_bf16_f32 %0, %1, %2" : "=v"(r) : "v"(lo), "v"(hi)); return r; }
DEVI bf16_t f2bf(float x) { return (bf16_t)(cvt_pk(x, 0.f) & 0xffffu); }
DEVI float bf2f(unsigned b) { return __uint_as_float(b << 16); }
DEVI float bflo(unsigned w) { return __uint_as_float(w << 16); }
DEVI float bfhi(unsigned w) { return __uint_as_float(w & 0xffff0000u); }
DEVI float rcp_(float x) { return __builtin_amdgcn_rcpf(x); }
DEVI float silu_(float x) { return x * rcp_(1.f + __expf(-x)); }
DEVI float sigmoid_(float x) { return rcp_(1.f + __expf(-x)); }
DEVI float gelu_(float x) { const float y = 0.7978845608f * (x + 0.044715f * x * x * x); const float t = 1.f - 2.f * rcp_(1.f + __expf(2.f * y)); return 0.5f * x * (1.f + t); }
DEVI float softplus_(float x) { return x > 20.f ? x : log1pf(expf(x)); }
DEVI int lane_id_() { int l = (int)__builtin_amdgcn_mbcnt_hi(~0u, __builtin_amdgcn_mbcnt_lo(~0u, 0u)); asm volatile("" : "+v"(l)); return l; }
DEVI float shfl_xor_(float v, int m) { return __builtin_bit_cast(float, __builtin_amdgcn_ds_bpermute((lane_id_() ^ m) << 2, __builtin_bit_cast(int, v))); }
DEVI float shfl_up_(float v, int o) { const int l = lane_id_(); return __builtin_bit_cast(float, __builtin_amdgcn_ds_bpermute((l >= o ? l - o : l) << 2, __builtin_bit_cast(int, v))); }
DEVI float shfl_(float v, int src) { return __builtin_bit_cast(float, __builtin_amdgcn_ds_bpermute(src << 2, __builtin_bit_cast(int, v))); }
DEVI float wave_sum(float v) {
    const int l = lane_id_();
#pragma unroll
    for (int o = 1; o < 64; o <<= 1) v += __builtin_bit_cast(float, __builtin_amdgcn_ds_bpermute((l ^ o) << 2, __builtin_bit_cast(int, v)));
    return v;
}
DEVI u32x4 pack8(const f32x4& a, const f32x4& b) { u32x4 w; w.x = cvt_pk(a[0], a[1]); w.y = cvt_pk(a[2], a[3]); w.z = cvt_pk(b[0], b[1]); w.w = cvt_pk(b[2], b[3]); return w; }
DEVI void unpack8(const u32x4& w, float* o) { o[0] = bflo(w.x); o[1] = bfhi(w.x); o[2] = bflo(w.y); o[3] = bfhi(w.y); o[4] = bflo(w.z); o[5] = bfhi(w.z); o[6] = bflo(w.w); o[7] = bfhi(w.w); }
#define LDS_WAIT() asm volatile("s_waitcnt lgkmcnt(0)" ::: "memory")

namespace pg8 {
constexpr int BM = 256, BK = 64, HALF = 128, HTB = HALF * BK * 2, STAGE_BYTES = 8 * HTB, NXCD = 8, WGM = 8;
DEVI int lds_byte(int r, int c) { const int st = (r >> 4) * 2 + (c >> 5), rr = r & 15, cc = c & 31, ob = rr * 64 + cc * 2; return st * 1024 + (ob ^ (((ob >> 9) & 1) << 5)); }
DEVI void stage_rc(int b, int& R, int& C) { const int st = b / 1024, sb = b % 1024, swz = sb ^ (((sb >> 9) & 1) << 5); R = (st >> 1) * 16 + swz / 64; C = (st & 1) * 32 + (swz % 64) / 2; }
DEVI int perm32(int rho) { const int n = rho >> 4, i = rho & 15; return 8 * (i >> 2) + 4 * n + (i & 3); }

struct Unit { int pm, pn; };
struct Gemm { const bf16_t* A; const bf16_t* Bt; int lda, ldb, K, mode; };
DEVI size_t a_off(const Gemm& g, const Unit& u) { size_t o = (size_t)u.pm * 256 * g.lda; if (g.mode) o += (size_t)u.pn * 256; return o * 2; }
DEVI size_t b_off(const Gemm& g, const Unit& u) {
    const size_t r = g.mode == 0 ? (size_t)u.pn : (g.mode == 1 ? (size_t)(u.pm >> 3) : (size_t)((u.pm >> 3) * 4 + u.pn));
    size_t o = r * 256 * g.ldb; if (g.mode == 1) o += (size_t)u.pn * 256; return o * 2;
}
struct StaticOrder {
    int nM, nN, nwg, G, c;
    DEVI void init(int nM_, int nN_, int G_, int c_) { nM = nM_; nN = nN_; nwg = nM * nN; G = G_; c = c_; }
    DEVI bool next(int i, Unit& u) const {
        const long L = (long)i * G + c; if (L >= nwg) return false;
        int wgid = (int)L; { const int q = nwg / NXCD, r = nwg % NXCD, xcd = wgid % NXCD, off = wgid / NXCD; wgid = (xcd < r ? xcd * (q + 1) : r * (q + 1) + (xcd - r) * q) + off; }
        const int nig = WGM * nN, gid = wgid / nig, fm = gid * WGM, gsz = (nM - fm) < WGM ? (nM - fm) : WGM;
        u.pm = fm + ((wgid % nig) % gsz); u.pn = (wgid % nig) / gsz; return true;
    }
};

template <class F> struct EpiRow {
    F f;
    DEVI void operator()(const f32x4 (&acc)[2][2][4][2], const Unit& u, int wr, int wc, int fr, int fq) const {
        const int c8 = wc * 32 + 8 * fq;
        typename F::UC uc; f.unit(u.pn, c8, uc);
#pragma unroll
        for (int ai = 0; ai < 2; ++ai) {
#pragma unroll
            for (int m0 = 0; m0 < 4; m0 += F::NB) {
                typename F::Pre p[F::NB];
#pragma unroll
                for (int m = 0; m < F::NB; ++m) f.load(u.pm * BM + ai * HALF + wr * 64 + (m0 + m) * 16 + fr, u.pn, c8, p[m]);
#pragma unroll
                for (int m = 0; m < F::NB; ++m) f.apply(u.pm * BM + ai * HALF + wr * 64 + (m0 + m) * 16 + fr, u.pn, c8, acc[ai][0][m0 + m][0], acc[ai][0][m0 + m][1], acc[ai][1][m0 + m][0], acc[ai][1][m0 + m][1], p[m], uc);
            }
        }
    }
};
template <class F> DEVI void epi_one(const F& f, int row, int pn, int c8, const f32x4& a0, const f32x4& a1, const f32x4& b0, const f32x4& b1) {
    typename F::UC uc; f.unit(pn, c8, uc); typename F::Pre p; f.load(row, pn, c8, p); f.apply(row, pn, c8, a0, a1, b0, b1, p, uc);
}

template <class Epi, class Sched>
DEVI void gemm_phase(LAS unsigned char* lds, const Gemm g, const Sched& S, const Epi& E, int wid, const float* hs = nullptr) {
    const int lane = lane_id_(), tid = wid * 64 + lane, wr = wid >> 2, wc = wid & 3, fr = lane & 15, fq = lane >> 4;
    const int K = g.K, nt = K / BK;
    unsigned voffA[2], voffB[2];
#pragma unroll
    for (int i = 0; i < 2; ++i) { int R, C; stage_rc(tid * 16 + i * 8192, R, C); const int Rb = (R & ~31) + perm32(R & 31);
        voffA[i] = (unsigned)(R * g.lda + C) * 2u; voffB[i] = (unsigned)(Rb * g.ldb + C) * 2u; }
    const size_t kstep = (size_t)(BK * 2);
    const size_t hsA = (size_t)HALF * g.lda * 2, hsB = (size_t)HALF * g.ldb * 2;
    const unsigned ldsw = (unsigned)wid * 1024u;
    const int aoff = lds_byte(wr * 64 + fr, fq * 8), boff = lds_byte(wc * 32 + fr, fq * 8);
#define PG8_SA(b, h) (((b) * 2 + (h)) * HTB)
#define PG8_SB(b, h) ((4 + (b) * 2 + (h)) * HTB)
#define PG8_STAGE(bufoff, gbase, voff) do { _Pragma("unroll") for (int _i = 0; _i < 2; ++_i) \
        __builtin_amdgcn_global_load_lds((const unsigned*)((const char*)(gbase) + (voff)[_i]), (LAS unsigned*)(lds + (bufoff) + ldsw + _i * 8192), 16, 0, 0); } while (0)
#define PG8_LDA(dst, b, h) do { _Pragma("unroll") for (int m = 0; m < 4; ++m) _Pragma("unroll") for (int k = 0; k < 2; ++k) dst[m][k] = *(const LAS bf16x8*)(lds + PG8_SA(b, h) + aoff + m * 2048 + k * 1024); } while (0)
#define PG8_LDB(dst, b, h) do { _Pragma("unroll") for (int n = 0; n < 2; ++n) _Pragma("unroll") for (int k = 0; k < 2; ++k) dst[n][k] = *(const LAS bf16x8*)(lds + PG8_SB(b, h) + boff + n * 2048 + k * 1024); } while (0)
#define PG8_MMA(ai, bj, At, Bt) do { __builtin_amdgcn_s_setprio(1); _Pragma("unroll") for (int m = 0; m < 4; ++m) _Pragma("unroll") for (int n = 0; n < 2; ++n) _Pragma("unroll") for (int k = 0; k < 2; ++k) \
        acc[ai][bj][m][n] = __builtin_amdgcn_mfma_f32_16x16x32_bf16(Bt[n][k], At[m][k], acc[ai][bj][m][n], 0, 0, 0); __builtin_amdgcn_s_setprio(0); } while (0)
#define PG8_WAIT_V(n) asm volatile("s_waitcnt vmcnt(" #n ")" ::: "memory")
#define PG8_WAIT_L(n) asm volatile("s_waitcnt lgkmcnt(" #n ")" ::: "memory")
#define PG8_BAR __builtin_amdgcn_s_barrier()
#define PG8_SCHED __builtin_amdgcn_sched_barrier(0)
    Unit cur, nxt; int ui = 0;
    if (!S.next(0, cur)) return;
    LAS float* const RS = (LAS float*)(lds + STAGE_BYTES);
    if (hs) { if (tid < 256) RS[tid] = rsqrtf(hs[cur.pm * BM + tid] * (1.f / 1024.f) + EPS); }
    f32x4 acc[2][2][4][2];
#pragma unroll
    for (int a = 0; a < 2; ++a)
#pragma unroll
        for (int b = 0; b < 2; ++b)
#pragma unroll
            for (int m = 0; m < 4; ++m)
#pragma unroll
                for (int n = 0; n < 2; ++n) acc[a][b][m][n] = (f32x4){0.f, 0.f, 0.f, 0.f};
    bf16x8 At[4][2], B0[2][2], B1[2][2];
    const char* cA = (const char*)g.A + a_off(g, cur); const char* cB = (const char*)g.Bt + b_off(g, cur);
    PG8_STAGE(PG8_SB(0, 0), cB, voffB); PG8_STAGE(PG8_SB(0, 1), cB + hsB, voffB); PG8_STAGE(PG8_SA(0, 0), cA, voffA); PG8_STAGE(PG8_SA(0, 1), cA + hsA, voffA);
    if (wr == 1) PG8_BAR;
    PG8_WAIT_V(2); PG8_BAR;
    PG8_STAGE(PG8_SB(1, 0), cB + kstep, voffB); PG8_STAGE(PG8_SA(1, 0), cA + kstep, voffA); PG8_STAGE(PG8_SB(1, 1), cB + hsB + kstep, voffB);
    PG8_WAIT_V(6); PG8_BAR;
    for (;;) {
        const bool has_next = S.next(ui + 1, nxt);
        const char* nA = has_next ? (const char*)g.A + a_off(g, nxt) : cA; const char* nB = has_next ? (const char*)g.Bt + b_off(g, nxt) : cB;
        for (int t = 0; t < nt; t += 2) {
            const bool last = (t == nt - 2);
            if (hs && t == (nt >> 1)) {
#pragma unroll
                for (int ai = 0; ai < 2; ++ai)
#pragma unroll
                    for (int m = 0; m < 4; ++m) { const float rs = RS[ai * HALF + wr * 64 + m * 16 + fr];
#pragma unroll
                        for (int bj = 0; bj < 2; ++bj)
#pragma unroll
                            for (int n = 0; n < 2; ++n) acc[ai][bj][m][n] = acc[ai][bj][m][n] * rs; }
            }
            const char* a1 = cA + (size_t)(t + 1) * kstep;
            const char* a2 = last ? nA : cA + (size_t)(t + 2) * kstep; const char* b2 = last ? nB : cB + (size_t)(t + 2) * kstep;
            const char* a3 = a2 + kstep; const char* b3 = b2 + kstep;
            PG8_LDB(B0, 0, 0); PG8_LDB(B1, 0, 1); PG8_SCHED; PG8_LDA(At, 0, 0); PG8_STAGE(PG8_SA(1, 1), a1 + hsA, voffA);
            PG8_WAIT_V(8); PG8_WAIT_L(0); PG8_BAR; PG8_MMA(0, 0, At, B0); PG8_MMA(0, 1, At, B1); PG8_BAR; PG8_SCHED;
            PG8_LDA(At, 0, 1); PG8_STAGE(PG8_SB(0, 0), b2, voffB); PG8_STAGE(PG8_SB(0, 1), b2 + hsB, voffB); PG8_STAGE(PG8_SA(0, 0), a2, voffA);
            PG8_WAIT_V(8); PG8_WAIT_L(0); PG8_BAR; PG8_MMA(1, 0, At, B0); PG8_MMA(1, 1, At, B1); PG8_BAR; PG8_SCHED;
            PG8_LDB(B0, 1, 0); PG8_LDB(B1, 1, 1); PG8_SCHED; PG8_LDA(At, 1, 0); PG8_STAGE(PG8_SA(0, 1), a2 + hsA, voffA);
            PG8_WAIT_V(8); PG8_WAIT_L(0); PG8_BAR; PG8_MMA(0, 0, At, B0); PG8_MMA(0, 1, At, B1); PG8_BAR; PG8_SCHED;
            PG8_LDA(At, 1, 1); PG8_STAGE(PG8_SB(1, 0), b3, voffB); PG8_STAGE(PG8_SB(1, 1), b3 + hsB, voffB); PG8_STAGE(PG8_SA(1, 0), a3, voffA);
            PG8_WAIT_V(8); PG8_WAIT_L(0); PG8_BAR; PG8_MMA(1, 0, At, B0); PG8_MMA(1, 1, At, B1); PG8_BAR; PG8_SCHED;
        }
        if (wr == 0) PG8_BAR;
        E(acc, cur, wr, wc, fr, fq);
        if (!has_next) break;
#pragma unroll
        for (int a = 0; a < 2; ++a)
#pragma unroll
            for (int b = 0; b < 2; ++b)
#pragma unroll
                for (int m = 0; m < 4; ++m)
#pragma unroll
                    for (int n = 0; n < 2; ++n) acc[a][b][m][n] = (f32x4){0.f, 0.f, 0.f, 0.f};
        cur = nxt; cA = nA; cB = nB; ++ui;
        if (wr == 1) PG8_BAR;
    }
    PG8_WAIT_V(0);
    PG8_BAR;
#undef PG8_SA
#undef PG8_SB
#undef PG8_STAGE
#undef PG8_LDA
#undef PG8_LDB
#undef PG8_MMA
#undef PG8_WAIT_V
#undef PG8_WAIT_L
#undef PG8_BAR
#undef PG8_SCHED
}
}

struct FIn {
    bf16_t* proj; float* convP; float* convS;
    static constexpr int NB = 4; struct UC {}; struct Pre {};
    DEVI void unit(int, int, UC&) const {} DEVI void load(int, int, int, Pre&) const {}
    DEVI void apply(int row, int pn, int c8, const f32x4& a0, const f32x4& a1, const f32x4& b0, const f32x4& b1, const Pre&, const UC&) const {
#pragma unroll
        for (int bj = 0; bj < 2; ++bj) {
            const int col = pn * 256 + bj * 128 + c8; const f32x4 v0 = bj ? b0 : a0, v1 = bj ? b1 : a1;
            *(u32x4*)(proj + (size_t)row * NPROJ + col) = pack8(v0, v1);
            if (col >= 1024 && col < 2560) {
                float* dst = nullptr;
                if (row < TP) { const int t = row & 2047; if (t >= 2045) dst = convP + ((size_t)(row >> 11) * 3 + (t - 2045)) * CONVD + (col - 1024); }
                else if (row < TP + TS) dst = convS + ((size_t)(row - TP) * 3 + 2) * CONVD + (col - 1024);
                if (dst) { *(f32x4*)dst = v0; *(f32x4*)(dst + 4) = v1; }
            }
        }
    }
};
struct FKV {
    float* outk; float* outv; bf16_t* kb; bf16_t* vt;
    static constexpr int NB = 4; struct UC {}; struct Pre {};
    DEVI void unit(int, int, UC&) const {} DEVI void load(int, int, int, Pre&) const {}
    DEVI void apply(int row, int pn, int c8, const f32x4& a0, const f32x4& a1, const f32x4& b0, const f32x4& b1, const Pre&, const UC&) const {
#pragma unroll
        for (int bj = 0; bj < 2; ++bj) {
            const int col = pn * 256 + bj * 128 + c8; const f32x4 v0 = bj ? b0 : a0, v1 = bj ? b1 : a1;
            if (col < 1024) {
                float* d = outk + (size_t)row * 1024 + col; *(f32x4*)d = v0; *(f32x4*)(d + 4) = v1;
                *(u32x4*)(kb + (size_t)row * 1024 + col) = pack8(v0, v1);
            } else {
                const int c = col - 1024; float* d = outv + (size_t)row * 1024 + c; *(f32x4*)d = v0; *(f32x4*)(d + 4) = v1;
                const int b = row >> 8, m = row & 255, h = c >> 8, dd = c & 255;
                bf16_t* t = vt + ((size_t)(b * 4 + h) * 256 + dd) * 256 + m;
#pragma unroll
                for (int j = 0; j < 4; ++j) { t[(size_t)j * 256] = f2bf(v0[j]); t[(size_t)(j + 4) * 256] = f2bf(v1[j]); }
            }
        }
    }
};
struct FGlu {
    const bf16_t* gb; const float* bglu; bf16_t* cat; const float* ssq;
    static constexpr int NB = 4; struct UC { f32x4 b[2][2]; }; struct Pre { u32x4 g[2]; };
    DEVI void unit(int pn, int c8, UC& uc) const {
#pragma unroll
        for (int bj = 0; bj < 2; ++bj) { const int col = pn * 256 + bj * 128 + c8; uc.b[bj][0] = *(const f32x4*)(bglu + col); uc.b[bj][1] = *(const f32x4*)(bglu + col + 4); } }
    DEVI void load(int row, int pn, int c8, Pre& p) const {
#pragma unroll
        for (int bj = 0; bj < 2; ++bj) p.g[bj] = *(const u32x4*)(gb + (size_t)row * 1024 + pn * 256 + bj * 128 + c8); }
    DEVI void apply(int row, int pn, int c8, const f32x4& a0, const f32x4& a1, const f32x4& b0, const f32x4& b1, const Pre& p, const UC& uc) const {
#pragma unroll
        for (int bj = 0; bj < 2; ++bj) {
            const int col = pn * 256 + bj * 128 + c8; const f32x4 v0 = bj ? b0 : a0, v1 = bj ? b1 : a1;
            float g[8]; unpack8(p.g[bj], g);
            f32x4 y0, y1;
#pragma unroll
            for (int j = 0; j < 4; ++j) { y0[j] = g[j] * sigmoid_(v0[j] + uc.b[bj][0][j]); y1[j] = g[4 + j] * sigmoid_(v1[j] + uc.b[bj][1][j]); }
            *(u32x4*)(cat + (size_t)row * 2048 + 1024 + col) = pack8(y0, y1);
        }
    }
};
template <bool BB>
struct FResT {
    const void* baseP; const void* baseS; float* outP; float* outS; bf16_t* outb; float* ssq;
    static constexpr int NB = 4; struct UC {}; struct Pre { f32x4 x[2][2]; };
    DEVI void unit(int, int, UC&) const {}
    DEVI void load(int row, int pn, int c8, Pre& p) const {
        const int rr = row < TP + TS ? row : 0;
#pragma unroll
        for (int bj = 0; bj < 2; ++bj) { const int col = pn * 256 + bj * 128 + c8;
            if (BB) { const bf16_t* base = rr < TP ? (const bf16_t*)baseP + (size_t)rr * 1024 : (const bf16_t*)baseS + (size_t)(rr - TP) * 1024;
                float f[8]; unpack8(*(const u32x4*)(base + col), f); p.x[bj][0] = (f32x4){f[0], f[1], f[2], f[3]}; p.x[bj][1] = (f32x4){f[4], f[5], f[6], f[7]}; }
            else { const float* base = rr < TP ? (const float*)baseP + (size_t)rr * 1024 : (const float*)baseS + (size_t)(rr - TP) * 1024;
                p.x[bj][0] = *(const f32x4*)(base + col); p.x[bj][1] = *(const f32x4*)(base + col + 4); } } }
    DEVI void apply(int row, int pn, int c8, const f32x4& a0, const f32x4& a1, const f32x4& b0, const f32x4& b1, const Pre& p, const UC&) const {
        const bool valid = row < TP + TS;
        float* out = outP ? (row < TP ? outP + (size_t)row * 1024 : outS + (size_t)(row - TP) * 1024) : nullptr;
        float ss = 0.f;
        if (valid) {
#pragma unroll
            for (int bj = 0; bj < 2; ++bj) {
                const int col = pn * 256 + bj * 128 + c8; const f32x4 v0 = bj ? b0 : a0, v1 = bj ? b1 : a1;
                const f32x4 x0 = p.x[bj][0] + v0, x1 = p.x[bj][1] + v1;
                if (out) { *(f32x4*)(out + col) = x0; *(f32x4*)(out + col + 4) = x1; }
                if (outb) *(u32x4*)(outb + (size_t)row * 1024 + col) = pack8(x0, x1);
                ss += (x0[0] * x0[0] + x0[1] * x0[1]) + (x0[2] * x0[2] + x0[3] * x0[3]) + (x1[0] * x1[0] + x1[1] * x1[1]) + (x1[2] * x1[2] + x1[3] * x1[3]);
            }
        }
        ss += shfl_xor_(ss, 16); ss += shfl_xor_(ss, 32);
        if (valid && ((c8 >> 3) & 3) == 0) atomicAdd(ssq + row, ss);
    }
};
struct FQ {
    bf16_t* qb; const float* ssq;
    static constexpr int NB = 4; struct UC {}; struct Pre { float ss; };
    DEVI void unit(int, int, UC&) const {} DEVI void load(int row, int, int, Pre& p) const { p.ss = ssq[row]; }
    DEVI void apply(int row, int pn, int c8, const f32x4& a0, const f32x4& a1, const f32x4& b0, const f32x4& b1, const Pre& p, const UC&) const {
        const float rs = rsqrtf(p.ss * (1.f / 1024.f) + EPS) * 0.0625f;
        *(u32x4*)(qb + (size_t)row * 1024 + pn * 256 + c8) = pack8(a0 * rs, a1 * rs);
        *(u32x4*)(qb + (size_t)row * 1024 + pn * 256 + 128 + c8) = pack8(b0 * rs, b1 * rs);
    }
};
struct FS {
    bf16_t* pb; float* lsum;
    static constexpr int NB = 4; struct UC {}; struct Pre {};
    DEVI void unit(int, int, UC&) const {} DEVI void load(int, int, int, Pre&) const {}
    DEVI void apply(int row, int pn, int c8, const f32x4& a0, const f32x4& a1, const f32x4& b0, const f32x4& b1, const Pre&, const UC&) const {
        float ls = 0.f;
#pragma unroll
        for (int bj = 0; bj < 2; ++bj) {
            const f32x4 v0 = bj ? b0 : a0, v1 = bj ? b1 : a1; f32x4 e0, e1;
#pragma unroll
            for (int j = 0; j < 4; ++j) { e0[j] = __expf(v0[j]); e1[j] = __expf(v1[j]); }
            const u32x4 w = pack8(e0, e1);
            *(u32x4*)(pb + (size_t)row * 1024 + pn * 256 + bj * 128 + c8) = w;
            ls += (bflo(w.x) + bfhi(w.x)) + (bflo(w.y) + bfhi(w.y)) + (bflo(w.z) + bfhi(w.z)) + (bflo(w.w) + bfhi(w.w));
        }
        ls += shfl_xor_(ls, 16); ls += shfl_xor_(ls, 32);
        if (((c8 >> 3) & 3) == 0) atomicAdd(lsum + (size_t)row * 4 + pn, ls);
    }
};
struct FPV {
    bf16_t* ob; const float* lsum;
    static constexpr int NB = 4; struct UC {}; struct Pre { float l; };
    DEVI void unit(int, int, UC&) const {} DEVI void load(int row, int pn, int, Pre& p) const { p.l = __hip_atomic_load(lsum + (size_t)row * 4 + pn, __ATOMIC_RELAXED, __HIP_MEMORY_SCOPE_AGENT); }
    DEVI void apply(int row, int pn, int c8, const f32x4& a0, const f32x4& a1, const f32x4& b0, const f32x4& b1, const Pre& p, const UC&) const {
        const float inv = 1.f / p.l;
        *(u32x4*)(ob + (size_t)row * 1024 + pn * 256 + c8) = pack8(a0 * inv, a1 * inv);
        *(u32x4*)(ob + (size_t)row * 1024 + pn * 256 + 128 + c8) = pack8(b0 * inv, b1 * inv);
    }
};
struct FUp {
    bf16_t* mid; const float* ssq;
    static constexpr int NB = 4; struct UC {}; struct Pre { float ss; };
    DEVI void unit(int, int, UC&) const {} DEVI void load(int row, int, int, Pre& p) const { p.ss = ssq[row]; }
    DEVI void apply(int row, int pn, int c8, const f32x4& a0, const f32x4& a1, const f32x4& b0, const f32x4& b1, const Pre& p, const UC&) const {
        const float rs = rsqrtf(p.ss * (1.f / 1024.f) + EPS);
        f32x4 y0, y1;
#pragma unroll
        for (int j = 0; j < 4; ++j) { y0[j] = silu_(a0[j] * rs) * (b0[j] * rs); y1[j] = silu_(a1[j] * rs) * (b1[j] * rs); }
        *(u32x4*)(mid + (size_t)row * DFF + pn * 128 + c8) = pack8(y0, y1);
    }
};

template <class F>
DEVI void sgemm_unit(const bf16_t* A, int lda, const bf16_t* Wt, int ldb, int K, int pn, int wc, const F& f, int lane_, int wave) {
    int lane = lane_; asm volatile("" : "+v"(lane));
    const int r = lane & 15, q = lane >> 4;
    const bf16_t* ap = A + (size_t)(16 * wave + r) * lda + 8 * q;
    const bf16_t* wp[4];
#pragma unroll
    for (int t = 0; t < 4; ++t) wp[t] = Wt + (size_t)(256 * pn + 128 * (t >> 1) + 32 * wc + 8 * (r >> 2) + 4 * (t & 1) + (r & 3)) * ldb + 8 * q;
    f32x4 acc[4];
#pragma unroll
    for (int t = 0; t < 4; ++t) acc[t] = (f32x4){0.f, 0.f, 0.f, 0.f};
    for (int k0 = 0; k0 < K; k0 += 128) {
        bf16x8 fa[4], fw[4][4];
#pragma unroll
        for (int u = 0; u < 4; ++u) { fa[u] = *(const bf16x8*)(ap + k0 + 32 * u);
#pragma unroll
            for (int t = 0; t < 4; ++t) fw[u][t] = *(const bf16x8*)(wp[t] + k0 + 32 * u); }
#pragma unroll
        for (int u = 0; u < 4; ++u)
#pragma unroll
            for (int t = 0; t < 4; ++t) acc[t] = __builtin_amdgcn_mfma_f32_16x16x32_bf16(fw[u][t], fa[u], acc[t], 0, 0, 0);
    }
    pg8::epi_one(f, TP + 16 * wave + r, pn, 32 * wc + 8 * q, acc[0], acc[1], acc[2], acc[3]);
}

template <class F>
DEVI void sgemm2_unit(LAS unsigned char* L, const bf16_t* A, int lda, const bf16_t* Wt, int ldb, int K, int unit, const F& f, int lane_, int wave) {
    int lane = lane_; asm volatile("" : "+v"(lane));
    const int tq = unit & 3, wc = (unit >> 2) & 3, pn = unit >> 4;
    const int r = lane & 15, q = lane >> 4, tg = wave & 1, kq = wave >> 1;
    const int NK = K >> 5, per = (((NK >> 2) + 7) >> 3) << 3, ksb = kq * per, cnt = (NK - ksb) < per ? (NK - ksb) : per;
    const bf16_t* ap = A + (size_t)(32 * tq + 16 * tg + r) * lda + 8 * q + 32 * ksb;
    const bf16_t* wp[4];
#pragma unroll
    for (int t = 0; t < 4; ++t) wp[t] = Wt + (size_t)(256 * pn + 128 * (t >> 1) + 32 * wc + 8 * (r >> 2) + 4 * (t & 1) + (r & 3)) * ldb + 8 * q + 32 * ksb;
    f32x4 acc[4];
#pragma unroll
    for (int t = 0; t < 4; ++t) acc[t] = (f32x4){0.f, 0.f, 0.f, 0.f};
    for (int c0 = 0; c0 < cnt; c0 += 8) {
        bf16x8 fa[8], fw[8][4];
#pragma unroll
        for (int u = 0; u < 8; ++u) { fa[u] = *(const bf16x8*)(ap + (c0 + u) * 32);
#pragma unroll
            for (int t = 0; t < 4; ++t) fw[u][t] = *(const bf16x8*)(wp[t] + (c0 + u) * 32); }
#pragma unroll
        for (int u = 0; u < 8; ++u)
#pragma unroll
            for (int t = 0; t < 4; ++t) acc[t] = __builtin_amdgcn_mfma_f32_16x16x32_bf16(fw[u][t], fa[u], acc[t], 0, 0, 0);
    }
    LAS f32x4* red = (LAS f32x4*)L;
#pragma unroll
    for (int t = 0; t < 4; ++t) red[(wave * 4 + t) * 64 + lane] = acc[t];
    __syncthreads();
    if (kq == 0) {
#pragma unroll
        for (int t = 0; t < 4; ++t) acc[t] = (red[(tg * 4 + t) * 64 + lane] + red[((tg + 2) * 4 + t) * 64 + lane]) + (red[((tg + 4) * 4 + t) * 64 + lane] + red[((tg + 6) * 4 + t) * 64 + lane]);
        pg8::epi_one(f, TP + 32 * tq + 16 * tg + r, pn, 32 * wc + 8 * q, acc[0], acc[1], acc[2], acc[3]);
    }
    __syncthreads();
}

template <class F>
DEVI void sgemm3_unit(LAS unsigned char* L, const bf16_t* A, int lda, const bf16_t* Wt, int ldb, int K, int unit, const F& f, int lane_, int wave, const float* hs = nullptr) {
    int lane = lane_; asm volatile("" : "+v"(lane));
    const int tg = unit & 7, wc = (unit >> 3) & 3, pn = unit >> 5;
    const int r = lane & 15, q = lane >> 4;
    const int NK = K >> 5, per = (((NK >> 3) + 3) >> 2) << 2, ksb = wave * per; int cnt = NK - ksb; cnt = cnt < 0 ? 0 : (cnt < per ? cnt : per);
    const bf16_t* ap = A + (size_t)(16 * tg + r) * lda + 8 * q + 32 * ksb;
    const bf16_t* wp[4];
#pragma unroll
    for (int t = 0; t < 4; ++t) wp[t] = Wt + (size_t)(256 * pn + 128 * (t >> 1) + 32 * wc + 8 * (r >> 2) + 4 * (t & 1) + (r & 3)) * ldb + 8 * q + 32 * ksb;
    f32x4 acc[4];
#pragma unroll
    for (int t = 0; t < 4; ++t) acc[t] = (f32x4){0.f, 0.f, 0.f, 0.f};
    typename F::UC euc; typename F::Pre epre;
    if (wave == 0) { f.unit(pn, 32 * wc + 8 * q, euc); f.load(TP + 16 * tg + r, pn, 32 * wc + 8 * q, epre); }
    for (int c0 = 0; c0 < cnt; c0 += 4) {
        bf16x8 fa[4], fw[4][4];
#pragma unroll
        for (int u = 0; u < 4; ++u) { fa[u] = *(const bf16x8*)(ap + (c0 + u) * 32);
#pragma unroll
            for (int t = 0; t < 4; ++t) fw[u][t] = *(const bf16x8*)(wp[t] + (c0 + u) * 32); }
#pragma unroll
        for (int u = 0; u < 4; ++u)
#pragma unroll
            for (int t = 0; t < 4; ++t) acc[t] = __builtin_amdgcn_mfma_f32_16x16x32_bf16(fw[u][t], fa[u], acc[t], 0, 0, 0);
    }
    LAS f32x4* red = (LAS f32x4*)L;
#pragma unroll
    for (int t = 0; t < 4; ++t) red[(wave * 4 + t) * 64 + lane] = acc[t];
    __syncthreads();
    if (wave == 0) {
        const float hrs = hs ? rsqrtf(hs[TP + 16 * tg + r] * (1.f / 1024.f) + EPS) : 1.f;
#pragma unroll
        for (int t = 0; t < 4; ++t) { f32x4 v = red[t * 64 + lane];
#pragma unroll
            for (int w = 1; w < 4; ++w) v += red[(w * 4 + t) * 64 + lane];
            v = v * hrs;
#pragma unroll
            for (int w = 4; w < 8; ++w) v += red[(w * 4 + t) * 64 + lane];
            acc[t] = v; }
        f.apply(TP + 16 * tg + r, pn, 32 * wc + 8 * q, acc[0], acc[1], acc[2], acc[3], epre, euc);
    }
    __syncthreads();
}

#define XB_TMO      128
#define XB_XCNT(j)  (256  + 64 * (j))
#define XB_XSUB(j)  (1280 + 64 * (j))
#define XB_XGEN(j)  (2304 + 64 * (j))
#define XB_TOP      3328
#define XB_TOPGEN   3392
#define XCD_BAR_WORDS 3456
#define XB_SPIN_CAP (1u << 22)
DEVI unsigned xb_ld(unsigned* p)              { return __hip_atomic_load(p, __ATOMIC_RELAXED, __HIP_MEMORY_SCOPE_AGENT); }
DEVI unsigned xb_add(unsigned* p, unsigned v) { return __hip_atomic_fetch_add(p, v, __ATOMIC_RELAXED, __HIP_MEMORY_SCOPE_AGENT); }
DEVI unsigned xb_xcc_id() { return (unsigned)__builtin_amdgcn_s_getreg((3 << 11) | 20) & 0xFu; }
#define XB_SPIN(cond, bar) do { unsigned _sp = 0; while (cond) { __builtin_amdgcn_s_sleep(1); \
    if ((++_sp & 255u) == 0u) { if (xb_ld(&(bar)[XB_TMO])) break; if (_sp > XB_SPIN_CAP) { atomicAdd(&(bar)[XB_TMO], 1u); break; } } } } while (0)
struct XcdBarrier { unsigned* bar; unsigned x; volatile LAS unsigned* st; };
DEVI XcdBarrier xcd_barrier_post(unsigned* bar, volatile LAS unsigned* st, bool t0) {
    XcdBarrier b; b.bar = bar; b.x = xb_xcc_id(); b.st = st;
    if (t0) (void)xb_add(&bar[XB_XCNT(b.x)], 1u);
    return b;
}
DEVI void xcd_barrier_complete(unsigned* bar, unsigned x, unsigned& nloc, unsigned& nx) {
    const unsigned G = gridDim.x * gridDim.y * gridDim.z;
    unsigned sum, cnt, mine, sp = 0u;
    for (;;) {
        sum = 0u; cnt = 0u; mine = 0u;
#pragma unroll
        for (unsigned j = 0; j < 16; ++j) { const unsigned c = xb_ld(&bar[XB_XCNT(j)]); sum += c; cnt += (c > 0u) ? 1u : 0u; mine = (j == x) ? c : mine; }
        if (sum == G) break;
        __builtin_amdgcn_s_sleep(1);
        if ((++sp & 255u) == 0u) { if (xb_ld(&bar[XB_TMO])) break; if (sp > XB_SPIN_CAP) { atomicAdd(&bar[XB_TMO], 1u); break; } }
    }
    nloc = mine > 0u ? mine : 1u; nx = cnt > 0u ? cnt : 1u;
}
DEVI void xcd_barrier(const XcdBarrier& b, int wave) {
    asm volatile("s_waitcnt vmcnt(0)" ::: "memory");
    __syncthreads();
    if (wave == 0 && lane_id_() == 0) {
        unsigned* bar = b.bar;
        __builtin_amdgcn_s_waitcnt(0);
        unsigned nloc = b.st[0], nx = b.st[1];
        if (nloc == 0u) { xcd_barrier_complete(bar, b.x, nloc, nx); b.st[0] = nloc; b.st[1] = nx; }
        const unsigned old = xb_add(&bar[XB_XSUB(b.x)], 1u);
        const unsigned gen = old / nloc;
        if (old + 1u == (gen + 1u) * nloc) {
            __builtin_amdgcn_fence(__ATOMIC_RELEASE, "agent");
            asm volatile("s_waitcnt vmcnt(0)" ::: "memory");
            const unsigned og = xb_add(&bar[XB_TOP], 1u);
            const unsigned tg = og / nx;
            if (og + 1u == (tg + 1u) * nx) xb_add(&bar[XB_TOPGEN], 1u);
            else XB_SPIN(xb_ld(&bar[XB_TOPGEN]) == tg, bar);
            __builtin_amdgcn_fence(__ATOMIC_ACQUIRE, "agent");
            xb_add(&bar[XB_XGEN(b.x)], 1u);
            asm volatile("s_waitcnt vmcnt(0)" ::: "memory");
        } else {
            XB_SPIN(xb_ld(&bar[XB_XGEN(b.x)]) == gen, bar);
            __builtin_amdgcn_fence(__ATOMIC_ACQUIRE, "agent");
            asm volatile("s_waitcnt vmcnt(0)" ::: "memory");
        }
    }
    __syncthreads();
}

struct EpiFinal {
    const bf16_t* base; float* out; float* ssq; const float* fing; const XcdBarrier* bar; int wave;
    DEVI void operator()(f32x4 (&acc)[2][2][4][2], const pg8::Unit& u, int wr, int wc, int fr, int fq) const {
        const int c8 = wc * 32 + 8 * fq;
#pragma unroll
        for (int ai = 0; ai < 2; ++ai)
#pragma unroll
            for (int m0 = 0; m0 < 4; m0 += 2) {
                f32x4 x[2][2][2];
#pragma unroll
                for (int m = 0; m < 2; ++m) { const int row = u.pm * 256 + ai * 128 + wr * 64 + (m0 + m) * 16 + fr;
#pragma unroll
                    for (int bj = 0; bj < 2; ++bj) { float f[8]; unpack8(*(const u32x4*)(base + (size_t)row * 1024 + u.pn * 256 + bj * 128 + c8), f);
                        x[m][bj][0] = (f32x4){f[0], f[1], f[2], f[3]}; x[m][bj][1] = (f32x4){f[4], f[5], f[6], f[7]}; } }
#pragma unroll
                for (int m = 0; m < 2; ++m) { const int row = u.pm * 256 + ai * 128 + wr * 64 + (m0 + m) * 16 + fr; float ss = 0.f;
#pragma unroll
                    for (int bj = 0; bj < 2; ++bj)
#pragma unroll
                        for (int n = 0; n < 2; ++n) { f32x4 v = acc[ai][bj][m0 + m][n] + x[m][bj][n]; acc[ai][bj][m0 + m][n] = v; ss += (v[0] * v[0] + v[1] * v[1]) + (v[2] * v[2] + v[3] * v[3]); }
                    ss += shfl_xor_(ss, 16); ss += shfl_xor_(ss, 32);
                    if (fq == 0) atomicAdd(ssq + row, ss); }
            }
        xcd_barrier(*bar, wave);
        f32x4 gg[2][2];
#pragma unroll
        for (int bj = 0; bj < 2; ++bj) { const float* gp = fing + u.pn * 256 + bj * 128 + c8; gg[bj][0] = *(const f32x4*)gp; gg[bj][1] = *(const f32x4*)(gp + 4); }
#pragma unroll
        for (int ai = 0; ai < 2; ++ai)
#pragma unroll
            for (int m = 0; m < 4; ++m) { const int row = u.pm * 256 + ai * 128 + wr * 64 + m * 16 + fr;
                const float rs = rsqrtf(__hip_atomic_load(ssq + row, __ATOMIC_RELAXED, __HIP_MEMORY_SCOPE_AGENT) * (1.f / 1024.f) + EPS);
#pragma unroll
                for (int bj = 0; bj < 2; ++bj) { float* op = out + (size_t)row * 1024 + u.pn * 256 + bj * 128 + c8;
                    *(f32x4*)op = acc[ai][bj][m][0] * rs * gg[bj][0]; *(f32x4*)(op + 4) = acc[ai][bj][m][1] * rs * gg[bj][1]; } }
    }
};

DEVI void tr_item(const float* W, int ldw, int K, bf16_t* WT, int dst_row, const float* scale, int slim, LAS float* scr, int k0, int n_src0, int lane) {
    float wv[32];
#pragma unroll
    for (int i = 0; i < 32; ++i) wv[i] = W[(size_t)(k0 + 2 * i + (lane >> 5)) * ldw + n_src0 + (lane & 31)];
    if (scale) {
#pragma unroll
        for (int i = 0; i < 32; ++i) { const int k = k0 + 2 * i + (lane >> 5); const float sv = scale[k < slim ? k : slim - 1]; wv[i] *= (k < slim) ? sv : 1.f; }
    }
#pragma unroll
    for (int i = 0; i < 32; ++i) scr[(2 * i + (lane >> 5)) * 33 + (lane & 31)] = wv[i];
    LDS_WAIT();
    const int c = lane & 7;
#pragma unroll
    for (int j = 0; j < 4; ++j) { const int n = (lane >> 3) + 8 * j; const LAS float* s = scr + (8 * c) * 33 + n;
        u32x4 o; o.x = cvt_pk(s[0 * 33], s[1 * 33]); o.y = cvt_pk(s[2 * 33], s[3 * 33]); o.z = cvt_pk(s[4 * 33], s[5 * 33]); o.w = cvt_pk(s[6 * 33], s[7 * 33]);
        *(u32x4*)(WT + (size_t)(dst_row + n) * K + k0 + 8 * c) = o; }
    LDS_WAIT();
}
DEVI void p0_prologue(const Args& a, LAS unsigned char* L, int tid, int lane, int wave) {
    unsigned char* ws = a.ws;
    const int G = gridDim.x, gw = blockIdx.x * 8 + wave, NGW = G * 8, gt = blockIdx.x * 512 + tid, NT = G * 512;
    for (int i = gt; i < (int)(WS_ZERO_END / 16); i += NT) ((u32x4*)ws)[i] = (u32x4){0u, 0u, 0u, 0u};
    LAS float* scr = (LAS float*)(L + wave * 8448);
    constexpr int J0 = 16 * 80, J1 = 16 * 32, J5 = 512, J6 = 512;
    for (int it = gw; it < J0 + J1 + J5 + J6; it += NGW) {
        int r = it;
        if (r < J0) { tr_item(a.in[I_WIN], WIN_LD, 1024, (bf16_t*)(ws + WS_WT_IN), (r % 80) * 32, nullptr, 0, scr, (r / 80) * 64, (r % 80) * 32, lane); continue; } r -= J0;
        if (r < J1) { tr_item(a.in[I_WIN], WIN_LD, 1024, (bf16_t*)(ws + WS_WT_IN), 2560 + (r % 32) * 32, nullptr, 0, scr, (r / 32) * 64, 2576 + (r % 32) * 32, lane); continue; } r -= J1;
        if (r < J5) { tr_item(a.in[I_WXK], 1024, 1024, (bf16_t*)(ws + WS_WT_KV), (r % 32) * 32, nullptr, 0, scr, (r / 32) * 64, (r % 32) * 32, lane); continue; } r -= J5;
        tr_item(a.in[I_WXV], 1024, 1024, (bf16_t*)(ws + WS_WT_KV), 1024 + (r % 32) * 32, nullptr, 0, scr, (r / 32) * 64, (r % 32) * 32, lane);
    }
    { const float* mp = a.in[I_MEM]; bf16_t* mb = (bf16_t*)(ws + WS_MEMB);
      for (int i = gt; i < 2048 * 1024 / 8; i += NT) { const f32x4 v0 = *(const f32x4*)(mp + (size_t)i * 8), v1 = *(const f32x4*)(mp + (size_t)i * 8 + 4); *(u32x4*)(mb + (size_t)i * 8) = pack8(v0, v1); } }
    { const float* sc = a.in[I_SCONV]; float* cs = a.out + O_CONVS;
      for (int i = gt; i < TS * 2 * CONVD / 4; i += NT) { const int e = i * 4, b = e / (2 * CONVD), rem = e % (2 * CONVD), r = rem / CONVD, c = rem % CONVD;
          *(f32x4*)(cs + ((size_t)b * 3 + r) * CONVD + c) = *(const f32x4*)(sc + ((size_t)b * 3 + r + 1) * CONVD + c); } }
    __syncthreads();
    LAS float* slab = (LAS float*)L;
    for (int i = tid; i < 1024 * 4; i += 512) { const int k = i >> 2, c4 = (i & 3) * 4; *(LAS f32x4*)(slab + k * 20 + c4) = *(const f32x4*)(a.in[I_WIN] + (size_t)k * WIN_LD + 2560 + c4); }
    __syncthreads();
    bf16_t* hb = (bf16_t*)(ws + WS_HB); float* dtraw = (float*)(ws + WS_DTRAW);
    float g1[16];
#pragma unroll
    for (int j = 0; j < 16; ++j) g1[j] = a.in[I_LN1][lane + 64 * j];
    float xn[16];
#pragma unroll
    for (int j = 0; j < 16; ++j) xn[j] = 0.f;
    if (gw < TP + TS) { const float* src = gw < TP ? a.in[I_XP] + (size_t)gw * 1024 : a.in[I_XS] + (size_t)(gw - TP) * 1024;
#pragma unroll
        for (int j = 0; j < 16; ++j) xn[j] = src[lane + 64 * j]; }
    for (int row = gw; row < TALL; row += NGW) {
        if (row >= TP + TS) {
#pragma unroll
            for (int j = 0; j < 16; ++j) hb[(size_t)row * 1024 + lane + 64 * j] = 0;
            if (lane < 16) dtraw[(size_t)row * 16 + lane] = 0.f;
            continue;
        }
        float x[16]; float ss = 0.f;
#pragma unroll
        for (int j = 0; j < 16; ++j) { x[j] = xn[j]; ss += x[j] * x[j]; }
        { const int nr = row + NGW;
          if (nr < TP + TS) { const float* src = nr < TP ? a.in[I_XP] + (size_t)nr * 1024 : a.in[I_XS] + (size_t)(nr - TP) * 1024;
#pragma unroll
              for (int j = 0; j < 16; ++j) xn[j] = src[lane + 64 * j]; } }
        const float rstd = rsqrtf(wave_sum(ss) * (1.f / 1024.f) + EPS);
        float acc[16];
#pragma unroll
        for (int e = 0; e < 16; ++e) acc[e] = 0.f;
#pragma unroll
        for (int j = 0; j < 16; ++j) {
            const float h = x[j] * rstd * g1[j];
            hb[(size_t)row * 1024 + lane + 64 * j] = f2bf(h);
            const LAS float* wrow = slab + (lane + 64 * j) * 20;
#pragma unroll
            for (int q = 0; q < 4; ++q) { const f32x4 w = *(const LAS f32x4*)(wrow + 4 * q);
                acc[4 * q] += h * w[0]; acc[4 * q + 1] += h * w[1]; acc[4 * q + 2] += h * w[2]; acc[4 * q + 3] += h * w[3]; }
        }
        float outv = 0.f;
#pragma unroll
        for (int e = 0; e < 16; ++e) { const float s = wave_sum(acc[e]); if (lane == e) outv = s; }
        if (lane < 16) dtraw[(size_t)row * 16 + lane] = outv;
    }
}

DEVI void p3_weights(const Args& a, LAS unsigned char* L, int lane, int wave) {
    unsigned char* ws = a.ws; const int gw = blockIdx.x * 8 + wave, NGW = gridDim.x * 8;
    LAS float* scr = (LAS float*)(L + wave * 8448);
    constexpr int J2 = 512, J3 = 32 * 32, J4 = 512, J7 = 512, J8 = 16 * 88, J9 = 16 * 88, J10 = 44 * 32;
    for (int it = gw; it < J2 + J3 + J4 + J7 + J8 + J9 + J10; it += NGW) {
        int r = it;
        if (r < J2) { tr_item(a.in[I_WGLU], 1024, 1024, (bf16_t*)(ws + WS_WT_GLU), (r % 32) * 32, nullptr, 0, scr, (r / 32) * 64, (r % 32) * 32, lane); continue; } r -= J2;
        if (r < J3) { tr_item(a.in[I_WOUT], 1024, 2048, (bf16_t*)(ws + WS_WT_OUT), (r % 32) * 32, a.in[I_GN], 1024, scr, (r / 32) * 64, (r % 32) * 32, lane); continue; } r -= J3;
        if (r < J4) { tr_item(a.in[I_WXQ], 1024, 1024, (bf16_t*)(ws + WS_WT_XQ), (r % 32) * 32, a.in[I_LN2], 1024, scr, (r / 32) * 64, (r % 32) * 32, lane); continue; } r -= J4;
        if (r < J7) { tr_item(a.in[I_WXO], 1024, 1024, (bf16_t*)(ws + WS_WT_XO), (r % 32) * 32, nullptr, 0, scr, (r / 32) * 64, (r % 32) * 32, lane); continue; } r -= J7;
        if (r < J8) { const int n0 = (r % 88) * 32; tr_item(a.in[I_WGATE], DFF, 1024, (bf16_t*)(ws + WS_WT_GU), (n0 >> 7) * 256 + (n0 & 127), a.in[I_LN3], 1024, scr, (r / 88) * 64, n0, lane); continue; } r -= J8;
        if (r < J9) { const int n0 = (r % 88) * 32; tr_item(a.in[I_WUP], DFF, 1024, (bf16_t*)(ws + WS_WT_GU), (n0 >> 7) * 256 + 128 + (n0 & 127), a.in[I_LN3], 1024, scr, (r / 88) * 64, n0, lane); continue; } r -= J9;
        tr_item(a.in[I_WDOWN], 1024, DFF, (bf16_t*)(ws + WS_WT_DOWN), (r % 32) * 32, nullptr, 0, scr, (r / 32) * 64, (r % 32) * 32, lane);
    }
}

struct ConvW { float w[4][8]; float b[8]; };
DEVI void convw_load(ConvW& cw, const float* conv_w, const float* conv_b, int ch) {
#pragma unroll
    for (int w = 0; w < 4; ++w) { const f32x4 p = *(const f32x4*)(conv_w + w * CONVD + ch), q = *(const f32x4*)(conv_w + w * CONVD + ch + 4);
#pragma unroll
        for (int j = 0; j < 4; ++j) { cw.w[w][j] = p[j]; cw.w[w][4 + j] = q[j]; } }
    const f32x4 p = *(const f32x4*)(conv_b + ch), q = *(const f32x4*)(conv_b + ch + 4);
#pragma unroll
    for (int j = 0; j < 4; ++j) { cw.b[j] = p[j]; cw.b[4 + j] = q[j]; }
}
DEVI void conv8_prompt(const ConvW& cw, const bf16_t* proj, int row, int t, int ch, float* o) {
    u32x4 raw[4];
#pragma unroll
    for (int w = 0; w < 4; ++w) { const int d = (t - 3 + w >= 0) ? (3 - w) : 0;
        raw[w] = *(const u32x4*)(proj + (size_t)(row - d) * NPROJ + 1024 + ch); }
#pragma unroll
    for (int j = 0; j < 8; ++j) o[j] = cw.b[j];
#pragma unroll
    for (int w = 0; w < 4; ++w) { float x[8]; unpack8(raw[w], x); const float m = (t - 3 + w >= 0) ? 1.f : 0.f;
#pragma unroll
        for (int j = 0; j < 8; ++j) o[j] += (x[j] * m) * cw.w[w][j]; }
#pragma unroll
    for (int j = 0; j < 8; ++j) o[j] = silu_(o[j]);
}
DEVI void ssd_dt_acum(const Args& a, LAS float* acum, LAS float* dtv, int row0, int g, int wave, int lane) {
    const int h = g * 8 + wave; const float* dtraw = (const float*)(a.ws + WS_DTRAW);
    const float A = -expf(a.in[I_ALOG][h]), bias = a.in[I_DTB][h];
    const float d0 = softplus_(dtraw[(size_t)(row0 + 2 * lane) * 16 + h] + bias), d1 = softplus_(dtraw[(size_t)(row0 + 2 * lane + 1) * 16 + h] + bias);
    const float v0 = d0 * A, v1 = v0 + d1 * A;
    float s = v1;
#pragma unroll
    for (int o = 1; o < 64; o <<= 1) { const float t = shfl_up_(s, o); if (lane >= o) s += t; }
    const float ex = s - v1;
    acum[wave * 128 + 2 * lane] = ex + v0; acum[wave * 128 + 2 * lane + 1] = ex + v1;
    dtv[wave * 128 + 2 * lane] = d0; dtv[wave * 128 + 2 * lane + 1] = d1;
}
constexpr int TLD = 136;
DEVI int swz(int r, int j) { return r * TLD + (j ^ (((r >> 3) & 15) << 3)); }
DEVI int swzb(int r, int kb) { return r * TLD + ((kb ^ ((r >> 3) & 15)) << 3); }

DEVI void ssd_pass1(const Args& a, LAS unsigned char* L, int unit, int tid, int lane, int wave) {
    const int g = unit & 1, c = (unit >> 1) & 15, b = unit >> 5, row0 = b * 2048 + c * 128, t0 = c * 128;
    LAS float* acum = (LAS float*)L; LAS float* dtv = (LAS float*)(L + 4096);
    LAS bf16_t* BT = (LAS bf16_t*)(L + 8192); LAS bf16_t* XW = (LAS bf16_t*)(L + 8192 + 128 * TLD * 2 + wave * (32 * TLD * 2));
    const bf16_t* proj = (const bf16_t*)(a.ws + WS_PROJ); float* cs = (float*)(a.ws + WS_CS);
    ssd_dt_acum(a, acum, dtv, row0, g, wave, lane);
    { const int cgi = tid >> 5, tl = tid & 31, n0 = 8 * cgi; ConvW cw; convw_load(cw, a.in[I_CONVW], a.in[I_CONVB], 1024 + g * 128 + n0);
#pragma unroll
      for (int i = 0; i < 4; ++i) { const int j = tl + 32 * i; float v[8]; conv8_prompt(cw, proj, row0 + j, t0 + j, 1024 + g * 128 + n0, v);
#pragma unroll
          for (int q = 0; q < 8; ++q) BT[swz(n0 + q, j)] = f2bf(v[q]); } }
    __syncthreads();
    const int r = lane & 15, q4 = lane >> 4, e = wave, h = g * 8 + e;
    const float aend = acum[e * 128 + 127];
    float* dst = cs + ((size_t)((b * 16 + c) * 16 + h) * 64) * 128;
    for (int half = 0; half < 2; ++half) {
        { const int cgi = lane & 3, tl = lane >> 2, p0 = 32 * half + 8 * cgi; ConvW cw; convw_load(cw, a.in[I_CONVW], a.in[I_CONVB], h * 64 + p0);
#pragma unroll 4
          for (int tb = 0; tb < 8; ++tb) { const int j = 16 * tb + tl; float v[8]; conv8_prompt(cw, proj, row0 + j, t0 + j, h * 64 + p0, v);
              const float sc = dtv[e * 128 + j] * __expf(aend - acum[e * 128 + j]);
#pragma unroll
              for (int q = 0; q < 8; ++q) XW[swz(8 * cgi + q, j)] = f2bf(v[q] * sc); } }
        LDS_WAIT();
        f32x4 acc[2][8];
#pragma unroll
        for (int pt = 0; pt < 2; ++pt)
#pragma unroll
            for (int t = 0; t < 8; ++t) acc[pt][t] = (f32x4){0.f, 0.f, 0.f, 0.f};
#pragma unroll
        for (int ks = 0; ks < 4; ++ks) {
            const bf16x8 fa0 = *(const LAS bf16x8*)(XW + swzb(r, 4 * ks + q4)), fa1 = *(const LAS bf16x8*)(XW + swzb(16 + r, 4 * ks + q4));
#pragma unroll
            for (int t = 0; t < 8; ++t) { const bf16x8 fb = *(const LAS bf16x8*)(BT + swzb(16 * t + r, 4 * ks + q4));
                acc[0][t] = __builtin_amdgcn_mfma_f32_16x16x32_bf16(fa0, fb, acc[0][t], 0, 0, 0);
                acc[1][t] = __builtin_amdgcn_mfma_f32_16x16x32_bf16(fa1, fb, acc[1][t], 0, 0, 0); }
        }
#pragma unroll
        for (int pt = 0; pt < 2; ++pt)
#pragma unroll
            for (int t = 0; t < 8; ++t)
#pragma unroll
                for (int k = 0; k < 4; ++k) dst[(size_t)(32 * half + 16 * pt + 4 * q4 + k) * 128 + 16 * t + r] = acc[pt][t][k];
        LDS_WAIT();
    }
    if (lane == 0) ((float*)(a.ws + WS_DECAY))[(b * 16 + c) * 16 + h] = __expf(aend);
    __syncthreads();
}

DEVI void ssd_pass3(const Args& a, LAS unsigned char* L, int unit, int tid, int lane, int wave) {
    const int g = unit & 1, c = (unit >> 1) & 15, b = unit >> 5, row0 = b * 2048 + c * 128, t0 = c * 128;
    LAS float* acum = (LAS float*)L; LAS float* dtv = (LAS float*)(L + 4096);
    LAS bf16_t* CT = (LAS bf16_t*)(L + 8192); LAS bf16_t* BMt = (LAS bf16_t*)(L + 8192 + 34816); LAS bf16_t* XT = (LAS bf16_t*)(L + 8192 + 2 * 34816);
    LAS float* cwL = (LAS float*)(L + 8192 + 2 * 34816 + 17408);
    LAS bf16_t* MW = CT + wave * 16 * TLD;
    const bf16_t* proj = (const bf16_t*)(a.ws + WS_PROJ); const bf16_t* sin_ = (const bf16_t*)(a.ws + WS_SIN);
    bf16_t* cat = (bf16_t*)(a.ws + WS_CAT); float* ssq = (float*)(a.ws + WS_SSQ_SSD);
    const int xcg = tid >> 6, xtl = tid & 63, p0 = 8 * xcg;
    u32x4 rx[2][4], rz[2];
#define P3_LOAD_RAW(hh) do { _Pragma("unroll") for (int i_ = 0; i_ < 2; ++i_) { const int j_ = xtl + 64 * i_; \
        _Pragma("unroll") for (int w_ = 0; w_ < 4; ++w_) { const int d_ = (t0 + j_ - 3 + w_ >= 0) ? (3 - w_) : 0; \
            rx[i_][w_] = *(const u32x4*)(proj + (size_t)(row0 + j_ - d_) * NPROJ + 1024 + (hh) * 64 + p0); } \
        rz[i_] = *(const u32x4*)(proj + (size_t)(row0 + j_) * NPROJ + (hh) * 64 + p0); } } while (0)
    ssd_dt_acum(a, acum, dtv, row0, g, wave, lane);
    for (int i = tid; i < 640; i += 512) { const int w = i >> 7, c4 = (i & 127) * 4;
        *(LAS f32x4*)(cwL + w * 512 + c4) = *(const f32x4*)((w < 4 ? a.in[I_CONVW] + w * CONVD : a.in[I_CONVB]) + g * 512 + c4); }
    { const int cgi = tid & 15, tl = tid >> 4, n0 = 8 * cgi;
#pragma unroll
      for (int mat = 0; mat < 2; ++mat) { const int ch = 1024 + mat * 256 + g * 128 + n0; ConvW cw; convw_load(cw, a.in[I_CONVW], a.in[I_CONVB], ch);
          LAS bf16_t* dstm = mat ? CT : BMt;
#pragma unroll
          for (int i = 0; i < 4; ++i) { const int j = tl + 32 * i; float v[8]; conv8_prompt(cw, proj, row0 + j, t0 + j, ch, v);
              u32x4 w; w.x = cvt_pk(v[0], v[1]); w.y = cvt_pk(v[2], v[3]); w.z = cvt_pk(v[4], v[5]); w.w = cvt_pk(v[6], v[7]);
              *(LAS u32x4*)(dstm + j * TLD + n0) = w; } } }
    __syncthreads();
    const int r = lane & 15, q4 = lane >> 4;
    bf16x8 aC[4]; f32x4 cb[8];
#pragma unroll
    for (int ks = 0; ks < 4; ++ks) aC[ks] = *(const LAS bf16x8*)(CT + (16 * wave + r) * TLD + 32 * ks + 8 * q4);
#pragma unroll
    for (int t = 0; t < 8; ++t) { cb[t] = (f32x4){0.f, 0.f, 0.f, 0.f};
#pragma unroll
        for (int ks = 0; ks < 4; ++ks) { const bf16x8 fb = *(const LAS bf16x8*)(BMt + (16 * t + r) * TLD + 32 * ks + 8 * q4);
            cb[t] = __builtin_amdgcn_mfma_f32_16x16x32_bf16(aC[ks], fb, cb[t], 0, 0, 0); } }
    float ssacc[4] = {0.f, 0.f, 0.f, 0.f};
    __syncthreads();
    LAS bf16_t* const XT0 = XT; LAS bf16_t* const XT1 = (LAS bf16_t*)(L + 105472);
    LAS bf16_t* const ZT0 = BMt; LAS bf16_t* const ZT1 = (LAS bf16_t*)(L + 122880);
    P3_LOAD_RAW(g * 8);
    for (int e = 0; e < 8; ++e) {
        const int h = g * 8 + e;
        XT = (e & 1) ? XT1 : XT0; LAS bf16_t* const ZT = (e & 1) ? ZT1 : ZT0;
        {
            f32x4 wl[4][2];
#pragma unroll
            for (int w = 0; w < 4; ++w) { wl[w][0] = *(const LAS f32x4*)(cwL + w * 512 + e * 64 + p0); wl[w][1] = *(const LAS f32x4*)(cwL + w * 512 + e * 64 + p0 + 4); }
            const f32x4 bl0 = *(const LAS f32x4*)(cwL + 2048 + e * 64 + p0), bl1 = *(const LAS f32x4*)(cwL + 2048 + e * 64 + p0 + 4);
#pragma unroll
            for (int i = 0; i < 2; ++i) { const int j = xtl + 64 * i; float o[8];
#pragma unroll
                for (int q = 0; q < 4; ++q) { o[q] = bl0[q]; o[4 + q] = bl1[q]; }
#pragma unroll
                for (int w = 0; w < 4; ++w) { float x[8]; unpack8(rx[i][w], x); const float m = (t0 + j - 3 + w >= 0) ? 1.f : 0.f;
#pragma unroll
                    for (int q = 0; q < 4; ++q) { o[q] += (x[q] * m) * wl[w][0][q]; o[4 + q] += (x[4 + q] * m) * wl[w][1][q]; } }
                *(LAS u32x4*)(ZT + j * 64 + p0) = rz[i];
#pragma unroll
                for (int q = 0; q < 8; ++q) XT[swz(p0 + q, j)] = f2bf(silu_(o[q])); }
        }
        if (e < 7) P3_LOAD_RAW(h + 1);
        __syncthreads();
        float ai[4];
#pragma unroll
        for (int k = 0; k < 4; ++k) ai[k] = acum[e * 128 + 16 * wave + 4 * q4 + k];
#pragma unroll
        for (int t = 0; t < 8; ++t) { const int j = 16 * t + r; const float aj = acum[e * 128 + j], dj = dtv[e * 128 + j];
#pragma unroll
            for (int k = 0; k < 4; ++k) { const int i = 16 * wave + 4 * q4 + k; const float m = (j <= i) ? cb[t][k] * __expf(ai[k] - aj) * dj : 0.f;
                MW[(4 * q4 + k) * TLD + j] = f2bf(m); } }
        LDS_WAIT();
        f32x4 acc[4], acc2[4];
#pragma unroll
        for (int pt = 0; pt < 4; ++pt) { acc[pt] = (f32x4){0.f, 0.f, 0.f, 0.f}; acc2[pt] = (f32x4){0.f, 0.f, 0.f, 0.f}; }
        if (c > 0) {
            const bf16_t* sp = sin_ + ((size_t)((b * 16 + c) * 16 + h) * 64) * 128;
#pragma unroll
            for (int ks = 0; ks < 4; ++ks)
#pragma unroll
                for (int pt = 0; pt < 4; ++pt) { const bf16x8 fs = *(const bf16x8*)(sp + (size_t)(16 * pt + r) * 128 + 32 * ks + 8 * q4);
                    acc2[pt] = __builtin_amdgcn_mfma_f32_16x16x32_bf16(aC[ks], fs, acc2[pt], 0, 0, 0); }
        }
#pragma unroll
        for (int ks = 0; ks < 4; ++ks) {
            const bf16x8 fm = *(const LAS bf16x8*)(MW + r * TLD + 32 * ks + 8 * q4);
#pragma unroll
            for (int pt = 0; pt < 4; ++pt) { const bf16x8 fx = *(const LAS bf16x8*)(XT + swzb(16 * pt + r, 4 * ks + q4));
                acc[pt] = __builtin_amdgcn_mfma_f32_16x16x32_bf16(fm, fx, acc[pt], 0, 0, 0); }
        }
        const float Dh = a.in[I_DSSD][h];
#pragma unroll
        for (int k = 0; k < 4; ++k) {
            const int i = 16 * wave + 4 * q4 + k; const float ea = __expf(ai[k]);
#pragma unroll
            for (int pt = 0; pt < 4; ++pt) {
                const int p = 16 * pt + r;
                const float xv = bf2f(XT[swz(p, i)]);
                const float y = acc[pt][k] + ea * acc2[pt][k] + Dh * xv;
                const float z = bf2f(ZT[i * 64 + p]);
                const float yz = y * silu_(z);
                cat[(size_t)(row0 + i) * 2048 + h * 64 + p] = f2bf(yz);
                ssacc[k] += yz * yz;
            }
        }
    }
#undef P3_LOAD_RAW
#pragma unroll
    for (int k = 0; k < 4; ++k) { float s = ssacc[k]; s += shfl_xor_(s, 1); s += shfl_xor_(s, 2); s += shfl_xor_(s, 4); s += shfl_xor_(s, 8);
        if (r == 0) atomicAdd(ssq + row0 + 16 * wave + 4 * q4 + k, s); }
    __syncthreads();
}

DEVI void ssd_step(const Args& a, LAS unsigned char* L, int unit, int tid, int lane) {
    const int g = unit & 1, b = unit >> 1, row = TP + b;
    LAS float* xs = (LAS float*)L; LAS float* Bv = xs + 512; LAS float* Cv = Bv + 128; LAS float* zs = Cv + 128; LAS float* sc = zs + 512;
    const bf16_t* proj = (const bf16_t*)(a.ws + WS_PROJ);
    const int n4 = (tid & 31) * 4, pr = tid >> 5;
    const float* s0p = a.in[I_SSSM] + ((size_t)(b * 16 + g * 8) * 64) * 128; float* s1p = a.out + O_SSMS + ((size_t)(b * 16 + g * 8) * 64) * 128;
    f32x4 s0[4];
#pragma unroll
    for (int it = 0; it < 4; ++it) s0[it] = __builtin_nontemporal_load((const f32x4*)(s0p + (size_t)(it * 16 + pr) * 128 + n4));
    zs[tid] = bf2f(proj[(size_t)row * NPROJ + g * 512 + tid]);
    if (tid < 96) {
        int ch; LAS float* dst;
        if (tid < 64) { ch = g * 512 + 8 * tid; dst = xs + 8 * tid; } else if (tid < 80) { ch = 1024 + g * 128 + 8 * (tid - 64); dst = Bv + 8 * (tid - 64); } else { ch = 1280 + g * 128 + 8 * (tid - 80); dst = Cv + 8 * (tid - 80); }
        ConvW cw; convw_load(cw, a.in[I_CONVW], a.in[I_CONVB], ch);
        float o[8]; float xn[8]; unpack8(*(const u32x4*)(proj + (size_t)row * NPROJ + 1024 + ch), xn);
#pragma unroll
        for (int j = 0; j < 8; ++j) o[j] = cw.b[j] + xn[j] * cw.w[3][j];
#pragma unroll
        for (int w = 0; w < 3; ++w) { const float* sp = a.in[I_SCONV] + ((size_t)b * 3 + w) * CONVD + ch; const f32x4 p = *(const f32x4*)sp, q = *(const f32x4*)(sp + 4);
#pragma unroll
            for (int j = 0; j < 4; ++j) { o[j] += p[j] * cw.w[w][j]; o[4 + j] += q[j] * cw.w[w][4 + j]; } }
#pragma unroll
        for (int j = 0; j < 8; ++j) dst[j] = silu_(o[j]);
    }
    if (tid >= 128 && tid < 136) { const int h = g * 8 + tid - 128; const float dt = softplus_(((const float*)(a.ws + WS_DTRAW))[(size_t)row * 16 + h] + a.in[I_DTB][h]);
        sc[tid - 128] = dt; sc[8 + tid - 128] = expf(-expf(a.in[I_ALOG][h]) * dt); }
    __syncthreads();
    const f32x4 bv = *(const LAS f32x4*)(Bv + n4), cv = *(const LAS f32x4*)(Cv + n4);
    bf16_t* cat = (bf16_t*)(a.ws + WS_CAT); float* ssq = (float*)(a.ws + WS_SSQ_SSD);
    float ssl = 0.f;
    for (int e = 0; e < 8; ++e) {
        const int h = g * 8 + e; const float dt = sc[e], dA = sc[8 + e], Dh = a.in[I_DSSD][h];
        f32x4 sn[4];
#pragma unroll
        for (int it = 0; it < 4; ++it) sn[it] = s0[it] * dA + bv * (dt * xs[e * 64 + it * 16 + pr]);
        if (e < 7) {
#pragma unroll
            for (int it = 0; it < 4; ++it) s0[it] = __builtin_nontemporal_load((const f32x4*)(s0p + (size_t)((e + 1) * 64 + it * 16 + pr) * 128 + n4));
        }
#pragma unroll
        for (int it = 0; it < 4; ++it) {
            const int p = it * 16 + pr;
            __builtin_nontemporal_store(sn[it], (f32x4*)(s1p + (size_t)(e * 64 + p) * 128 + n4));
            float part = (cv[0] * sn[it][0] + cv[1] * sn[it][1]) + (cv[2] * sn[it][2] + cv[3] * sn[it][3]);
            part += shfl_xor_(part, 1); part += shfl_xor_(part, 2); part += shfl_xor_(part, 4); part += shfl_xor_(part, 8); part += shfl_xor_(part, 16);
            if ((tid & 31) == 0) {
                const float y = part + Dh * xs[e * 64 + p]; const float yz = y * silu_(zs[e * 64 + p]);
                cat[(size_t)row * 2048 + h * 64 + p] = f2bf(yz); ssl += yz * yz;
            }
        }
    }
    if ((tid & 31) == 0) sc[16 + pr] = ssl;
    __syncthreads();
    if (tid == 0) { float t = 0.f;
#pragma unroll
        for (int i = 0; i < 16; ++i) t += sc[16 + i];
        atomicAdd(ssq + row, t); }
    __syncthreads();
}

struct S5Setup { float lbr, lbi; bf16x8 fB[8], bC[4], fD; };
template <bool WRITE_Y>
DEVI void s5_setup(const Args& a, S5Setup& st, int g, int lane) {
    const int p = lane, gp = g * 64 + p, r = lane & 15, q4 = lane >> 4;
    const float lr = a.in[I_LAMR][gp], li = a.in[I_LAMI][gp], step = expf(a.in[I_LSTEP][g]);
    const float mag = expf(lr * step); float sn, cs; sincosf(li * step, &sn, &cs);
    const float lbr = mag * cs, lbi = mag * sn; st.lbr = lbr; st.lbi = lbi; const float den = lr * lr + li * li;
    const float kre = ((lbr - 1.f) * lr + lbi * li) / den, kim = (lbi * lr - (lbr - 1.f) * li) / den;
#pragma unroll
    for (int jt = 0; jt < 4; ++jt) {
        const int pp = 16 * jt + r; const float kr = shfl_(kre, pp), ki = shfl_(kim, pp);
        const float* bp = a.in[I_BRE] + (size_t)(g * 64 + pp) * 16 + 8 * (q4 & 1); const float* bq = a.in[I_BIM] + (size_t)(g * 64 + pp) * 16 + 8 * (q4 & 1);
        const f32x4 br0 = *(const f32x4*)bp, br1 = *(const f32x4*)(bp + 4), bi0 = *(const f32x4*)bq, bi1 = *(const f32x4*)(bq + 4);
        u32x4 wr = pack8(br0 * kr - bi0 * ki, br1 * kr - bi1 * ki), wi = pack8(bi0 * kr + br0 * ki, bi1 * kr + br1 * ki);
        if (q4 >= 2) { wr = (u32x4){0u, 0u, 0u, 0u}; wi = (u32x4){0u, 0u, 0u, 0u}; }
        st.fB[jt] = *(const bf16x8*)&wr; st.fB[4 + jt] = *(const bf16x8*)&wi;
    }
    if (WRITE_Y) {
#pragma unroll
        for (int ks = 0; ks < 4; ++ks) { const float* src = (ks < 2 ? a.in[I_CRE] : a.in[I_CIM]) + (size_t)(g * 16 + r) * 64 + 32 * (ks & 1) + 8 * q4;
            f32x4 v0 = *(const f32x4*)src, v1 = *(const f32x4*)(src + 4); if (ks >= 2) { v0 = -v0; v1 = -v1; }
            const u32x4 w = pack8(v0, v1); st.bC[ks] = *(const bf16x8*)&w; }
        const float dv = a.in[I_DS5][g * 16 + r]; f32x4 d0, d1;
#pragma unroll
        for (int j = 0; j < 4; ++j) { d0[j] = (q4 < 2 && 8 * q4 + j == r) ? dv : 0.f; d1[j] = (q4 < 2 && 8 * q4 + 4 + j == r) ? dv : 0.f; }
        const u32x4 w = pack8(d0, d1); st.fD = *(const bf16x8*)&w;
    }
}
template <bool WRITE_Y>
DEVI void s5_unit(const Args& a, const S5Setup& st, LAS unsigned char* Lw, int g, int row0_, int ntok, const float* cin_re_, const float* cin_im_, float* out_re_, float* out_im_, int lane, int nseq, int seq_rows, int seq_state) {
    LAS float* BU = (LAS float*)Lw; LAS bf16_t* SX = (LAS bf16_t*)(Lw + 10240);
    const bf16_t* proj = (const bf16_t*)(a.ws + WS_PROJ); bf16_t* gb = (bf16_t*)(a.ws + WS_GB);
    const int p = lane, r = lane & 15, q4 = lane >> 4;
    const float lbr = st.lbr, lbi = st.lbi;
  for (int sq = 0; sq < nseq; ++sq) {
    const int row0 = row0_ + sq * seq_rows;
    const float* cin_re = cin_re_ ? cin_re_ + (size_t)sq * seq_state : nullptr; const float* cin_im = cin_im_ ? cin_im_ + (size_t)sq * seq_state : nullptr;
    float* out_re = out_re_ ? out_re_ + (size_t)sq * seq_state : nullptr; float* out_im = out_im_ ? out_im_ + (size_t)sq * seq_state : nullptr;
    float sre = cin_re ? cin_re[p] : 0.f, sim = cin_im ? cin_im[p] : 0.f;
    const bf16_t* up = proj + (size_t)(row0 + r) * NPROJ + 2560 + g * 16 + 8 * (q4 & 1);
    u32x4 un = (u32x4){0u, 0u, 0u, 0u};
    if (q4 < 2 && r < ntok) un = *(const u32x4*)up;
    for (int tb = 0; tb < ntok; tb += 16) {
        const int nt = (ntok - tb) < 16 ? (ntok - tb) : 16;
        const u32x4 uc = un; const bf16x8 fu = *(const bf16x8*)&uc;
        un = (u32x4){0u, 0u, 0u, 0u};
        if (q4 < 2 && tb + 16 + r < ntok) un = *(const u32x4*)(up + (size_t)(tb + 16) * NPROJ);
#pragma unroll
        for (int j = 0; j < 8; ++j) { const f32x4 d = __builtin_amdgcn_mfma_f32_16x16x32_bf16(fu, st.fB[j], (f32x4){0.f, 0.f, 0.f, 0.f}, 0, 0, 0);
            *(LAS f32x4*)(BU + (64 * (j >> 2) + 16 * (j & 3) + r) * 20 + 4 * q4) = d; }
        LDS_WAIT();
        float bur[16], bui[16];
#pragma unroll
        for (int i = 0; i < 4; ++i) { const f32x4 vr = *(const LAS f32x4*)(BU + p * 20 + 4 * i), vi = *(const LAS f32x4*)(BU + (64 + p) * 20 + 4 * i);
#pragma unroll
            for (int k = 0; k < 4; ++k) { bur[4 * i + k] = vr[k]; bui[4 * i + k] = vi[k]; } }
#pragma unroll
        for (int tl = 0; tl < 16; ++tl) {
            if (tl < nt) {
                const float nr = lbr * sre - lbi * sim + bur[tl], ni = lbr * sim + lbi * sre + bui[tl];
                sre = nr; sim = ni;
                if (WRITE_Y) { SX[tl * TLD + p] = f2bf(sre); SX[tl * TLD + 64 + p] = f2bf(sim); }
            }
        }
        if (WRITE_Y) {
            LDS_WAIT();
            f32x4 acc = __builtin_amdgcn_mfma_f32_16x16x32_bf16(fu, st.fD, (f32x4){0.f, 0.f, 0.f, 0.f}, 0, 0, 0);
#pragma unroll
            for (int ks = 0; ks < 4; ++ks) { const bf16x8 fa = *(const LAS bf16x8*)(SX + r * TLD + 32 * ks + 8 * q4); acc = __builtin_amdgcn_mfma_f32_16x16x32_bf16(fa, st.bC[ks], acc, 0, 0, 0); }
#pragma unroll
            for (int k = 0; k < 4; ++k) { const int tl = 4 * q4 + k;
                if (tl < nt) gb[(size_t)(row0 + tb + tl) * 1024 + g * 16 + r] = f2bf(gelu_(acc[k])); }
        }
        LDS_WAIT();
    }
    if (out_re) { out_re[p] = sre; out_im[p] = sim; }
  }
}

DEVI void attn_sample(const Args& a, LAS unsigned char* L, int unit, int tid, int lane, int wave) {
    const int h = unit & 3, b = unit >> 2, row = TP + b;
    LAS float* qs = (LAS float*)L; LAS float* sc = qs + 256; LAS float* red = sc + 256;
    const bf16_t* qb = (const bf16_t*)(a.ws + WS_QB); bf16_t* ob = (bf16_t*)(a.ws + WS_OB);
    const float* kp = a.in[I_CK] + ((size_t)(b * 256 + wave * 32) * 4 + h) * 256 + 4 * lane;
    const float* vp = a.in[I_CV] + ((size_t)(b * 256 + wave * 32) * 4 + h) * 256 + 4 * lane;
    f32x4 kv[32];
#pragma unroll
    for (int i = 0; i < 32; ++i) kv[i] = __builtin_nontemporal_load((const f32x4*)(kp + (size_t)i * 1024));
    if (tid < 256) qs[tid] = bf2f(qb[(size_t)row * 1024 + h * 256 + tid]);
    __syncthreads();
    const f32x4 q = *(const LAS f32x4*)(qs + 4 * lane);
    float myd = 0.f;
#pragma unroll
    for (int i = 0; i < 32; ++i) { const float d = wave_sum((kv[i][0] * q[0] + kv[i][1] * q[1]) + (kv[i][2] * q[2] + kv[i][3] * q[3])); if (lane == i) myd = d; }
    if (lane < 32) sc[wave * 32 + lane] = myd;
#pragma unroll
    for (int i = 0; i < 32; ++i) kv[i] = __builtin_nontemporal_load((const f32x4*)(vp + (size_t)i * 1024));
    __syncthreads();
    const f32x4 s4 = *(const LAS f32x4*)(sc + 4 * lane);
    float mx = fmaxf(fmaxf(s4[0], s4[1]), fmaxf(s4[2], s4[3]));
#pragma unroll
    for (int o = 1; o < 64; o <<= 1) mx = fmaxf(mx, shfl_xor_(mx, o));
    const float inv = 1.f / wave_sum((__expf(s4[0] - mx) + __expf(s4[1] - mx)) + (__expf(s4[2] - mx) + __expf(s4[3] - mx)));
    f32x4 acc = (f32x4){0.f, 0.f, 0.f, 0.f};
#pragma unroll
    for (int i = 0; i < 32; ++i) { const float pm = __expf(sc[wave * 32 + i] - mx) * inv; acc += kv[i] * pm; }
    *(LAS f32x4*)(red + wave * 256 + 4 * lane) = acc;
    __syncthreads();
    if (tid < 256) { float o = 0.f;
#pragma unroll
        for (int w = 0; w < 8; ++w) o += red[w * 256 + tid];
        ob[(size_t)row * 1024 + h * 256 + tid] = f2bf(o); }
    __syncthreads();
}

constexpr int NPH = 14;
__global__ void __launch_bounds__(512, 2) hymba_fwd(Args a) {
    extern __shared__ __attribute__((aligned(16))) unsigned char lds_raw[];
    LAS unsigned char* L = (LAS unsigned char*)lds_raw;
    const int wave = __builtin_amdgcn_readfirstlane((int)threadIdx.x >> 6);
#define lane (lane_id_())
#define tid (wave * 64 + lane_id_())
    const int G = gridDim.x, bid = blockIdx.x, gw = bid * 8 + wave, NGW = G * 8, NT = G * 512;
#define gt (bid * 512 + tid)
    unsigned char* ws = a.ws;
    volatile LAS unsigned* MISC = (volatile LAS unsigned*)(L + MISC_OFF);
    if (tid < 32) MISC[tid] = 0u;
    __syncthreads();
    XcdBarrier bar; bar.bar = (unsigned*)(ws + WS_BAR); bar.x = 0; bar.st = nullptr;
    if (a.ph_hi - a.ph_lo > 1) bar = xcd_barrier_post((unsigned*)(ws + WS_BAR), MISC + 8, wave == 0 && lane_id_() == 0);
    if (a.ph_lo < 0) cg::this_grid().sync();
    const int lo = a.ph_lo, hi = a.ph_hi;
#define IN(k) (lo <= (k) && (k) < hi)
#ifndef PROBE_BAR2
#define PROBE_BAR2 0
#endif
#ifndef PROBE_MASK
#define PROBE_MASK 0
#endif
    unsigned long long tph = PROBE_MASK ? __builtin_amdgcn_s_memrealtime() : 0ull;
#ifndef PROBE_SUB
#define PROBE_SUB 0
#endif
    unsigned long long ts0 = 0ull;
#define SUBSPIN(id) do { if (PROBE_SUB == (id)) { __syncthreads(); const unsigned long long t1_ = __builtin_amdgcn_s_memrealtime(), d_ = t1_ - ts0; while (__builtin_amdgcn_s_memrealtime() - t1_ < d_) __builtin_amdgcn_s_sleep(8); } if (PROBE_SUB) ts0 = __builtin_amdgcn_s_memrealtime(); } while (0)
#define SEAM(k) do { if (((PROBE_MASK) >> (k)) & 1) { __syncthreads(); const unsigned long long t1_ = __builtin_amdgcn_s_memrealtime(), d_ = t1_ - tph; \
        while (__builtin_amdgcn_s_memrealtime() - t1_ < d_) __builtin_amdgcn_s_sleep(8); } \
    if (IN(k) && IN((k) + 1)) { xcd_barrier(bar, wave); if (PROBE_BAR2) xcd_barrier(bar, wave); } if (PROBE_MASK) tph = __builtin_amdgcn_s_memrealtime(); } while (0)
    bf16_t* const proj = (bf16_t*)(ws + WS_PROJ);
    float* const x1f = (float*)(ws + WS_X1F);

    if (IN(0)) { p0_prologue(a, L, tid, lane, wave); __syncthreads(); } SEAM(0);

    if (IN(1)) {
        { pg8::Gemm g{(const bf16_t*)(ws + WS_HB), (const bf16_t*)(ws + WS_WT_IN), 1024, 1024, 1024, 0}; pg8::StaticOrder S; S.init(SKN(1) ? 64 : 65, 14, G, bid);
          const FIn fin{proj, a.out + O_CONVP, a.out + O_CONVS}; pg8::EpiRow<FIn> E{fin}; pg8::gemm_phase(L, g, S, E, wave);
          for (int u = G - 1 - bid - 64; SKN(1) && u >= 0 && u < 56; u += G) sgemm_unit((const bf16_t*)(ws + WS_HB) + (size_t)TP * 1024, 1024, (const bf16_t*)(ws + WS_WT_IN), 1024, 1024, u >> 2, u & 3, fin, lane, wave); }
        { pg8::Gemm g{(const bf16_t*)(ws + WS_MEMB), (const bf16_t*)(ws + WS_WT_KV), 1024, 1024, 1024, 0}; pg8::StaticOrder S; S.init(8, 8, G, G - 1 - bid);
          pg8::EpiRow<FKV> E{FKV{a.out + O_MEMK, a.out + O_MEMV, (bf16_t*)(ws + WS_KB), (bf16_t*)(ws + WS_VT)}}; pg8::gemm_phase(L, g, S, E, wave); }
    } SEAM(1);

    if (IN(2)) {
        if (PROBE_SUB) ts0 = __builtin_amdgcn_s_memrealtime();
        for (int u = bid; u < 256; u += G) ssd_pass1(a, L, u, tid, lane, wave);
        SUBSPIN(1);
        for (int u = bid; u < 256; u += G) ssd_step(a, L, u, tid, lane);
        SUBSPIN(2);
        float* er = (float*)(ws + WS_S5END); float* ei = er + 8 * 64 * S5NCH * 64;
        { S5Setup st; int gc = -1;
          for (int u = gw; u < 8 * 64 * S5NCH; u += NGW) { const int g = (u & 7) | (((u >> 6) & 7) << 3), k = (u >> 3) & 7, b = u >> 9;
            const size_t ix = (size_t)((b * 64 + g) * S5NCH + k) * 64;
            if (g != gc) { s5_setup<false>(a, st, g, lane); gc = g; }
            s5_unit<false>(a, st, L + wave * 14592, g, b * 2048 + k * S5LC, S5LC, nullptr, nullptr, er + ix, ei + ix, lane, 1, 0, 0); } }
    } SEAM(2);

    if (IN(3)) {
        p3_weights(a, L, lane, wave);
        const float* cs = (const float*)(ws + WS_CS); const float* dec = (const float*)(ws + WS_DECAY); bf16_t* sin_ = (bf16_t*)(ws + WS_SIN); float* sout = a.out + O_SSMP;
        for (int i = gt; i < 8 * 16 * 64 * 32; i += NT) {
            const int n4 = (i & 31) * 4, p = (i >> 5) & 63, h = (i >> 11) & 15, b = i >> 15;
            f32x4 S = (f32x4){0.f, 0.f, 0.f, 0.f};
            f32x4 cv[16]; float dv[16];
#pragma unroll
            for (int c = 0; c < 16; ++c) { cv[c] = __builtin_nontemporal_load((const f32x4*)(cs + ((size_t)((b * 16 + c) * 16 + h) * 64 + p) * 128 + n4)); dv[c] = dec[(b * 16 + c) * 16 + h]; }
#pragma unroll
            for (int c = 0; c < 16; ++c) { const size_t off = ((size_t)((b * 16 + c) * 16 + h) * 64 + p) * 128 + n4;
                u32x2 w; w.x = cvt_pk(S[0], S[1]); w.y = cvt_pk(S[2], S[3]); *(u32x2*)(sin_ + off) = w;
                S = S * dv[c] + cv[c]; }
            *(f32x4*)(sout + ((size_t)(b * 16 + h) * 64 + p) * 128 + n4) = S;
        }
        const float* er = (const float*)(ws + WS_S5END); const float* ei = er + 8 * 64 * S5NCH * 64; float* cr = (float*)(ws + WS_S5CAR); float* ci = cr + 8 * 64 * S5NCH * 64;
        for (int i = gt; i < 8 * 64 * 64; i += NT) {
            const int p = i & 63, g = (i >> 6) & 63, b = i >> 12, gp = g * 64 + p;
            const float lr = a.in[I_LAMR][gp], li = a.in[I_LAMI][gp], step = expf(a.in[I_LSTEP][g]);
            const float mag = expf(lr * step); float sn, cs_; sincosf(li * step, &sn, &cs_);
            float pr = mag * cs_, pi = mag * sn;
#pragma unroll
            for (int s = 0; s < 8; ++s) { const float nr = pr * pr - pi * pi, ni = 2.f * pr * pi; pr = nr; pi = ni; }
            float c_r = 0.f, c_i = 0.f; float evr[S5NCH], evi[S5NCH];
#pragma unroll
            for (int k = 0; k < S5NCH; ++k) { const size_t off = ((size_t)((b * 64 + g) * S5NCH + k)) * 64 + p; evr[k] = er[off]; evi[k] = ei[off]; }
#pragma unroll
            for (int k = 0; k < S5NCH; ++k) { const size_t off = ((size_t)((b * 64 + g) * S5NCH + k)) * 64 + p;
                cr[off] = c_r; ci[off] = c_i;
                const float nr = pr * c_r - pi * c_i + evr[k], ni = pr * c_i + pi * c_r + evi[k]; c_r = nr; c_i = ni; }
            a.out[O_S5RP + (size_t)(b * 64 + g) * 64 + p] = c_r; a.out[O_S5IP + (size_t)(b * 64 + g) * 64 + p] = c_i;
        }
    } SEAM(3);

    if (IN(4)) {
        if (PROBE_SUB) ts0 = __builtin_amdgcn_s_memrealtime();
        for (int u = bid; u < 256; u += G) ssd_pass3(a, L, u, tid, lane, wave);
        SUBSPIN(4);
        const float* cr = (const float*)(ws + WS_S5CAR); const float* ci = cr + 8 * 64 * S5NCH * 64;
        { S5Setup st; int gc = -1;
          for (int u = gw; u < 8 * 64 * S5NCH + 2048; u += NGW) {
            if (u < 8 * 64 * S5NCH) { const int g = (u & 7) | (((u >> 6) & 7) << 3), k = (u >> 3) & 7, b = u >> 9;
                const size_t ix = (size_t)((b * 64 + g) * S5NCH + k) * 64;
                if (g != gc) { s5_setup<true>(a, st, g, lane); gc = g; }
                s5_unit<true>(a, st, L + wave * 14592, g, b * 2048 + k * S5LC, S5LC, cr + ix, ci + ix, nullptr, nullptr, lane, 1, 0, 0); }
            else { const int v = u - 8 * 64 * S5NCH, g = (v & 7) | (((v >> 6) & 7) << 3), b4 = (((v >> 3) & 7) | ((v >> 9) << 3)) * 4; const size_t so = (size_t)(b4 * 64 + g) * 64;
                if (g != gc) { s5_setup<true>(a, st, g, lane); gc = g; }
                s5_unit<true>(a, st, L + wave * 14592, g, TP + b4, 1, a.in[I_SS5R] + so, a.in[I_SS5I] + so, a.out + O_S5RS + so, a.out + O_S5IS + so, lane, 4, 1, 64 * 64); }
          } }
        __syncthreads();
    } SEAM(4);

    if (IN(5)) {
        pg8::Gemm g{(const bf16_t*)(ws + WS_GB), (const bf16_t*)(ws + WS_WT_GLU), 1024, 1024, 1024, 0}; pg8::StaticOrder S; S.init(SKN(5) ? 64 : 65, 4, G, bid);
        const FGlu fg{(const bf16_t*)(ws + WS_GB), a.in[I_BGLU], (bf16_t*)(ws + WS_CAT), (const float*)(ws + WS_SSQ_SSD)}; pg8::EpiRow<FGlu> E{fg}; pg8::gemm_phase(L, g, S, E, wave);
        if (PROBE_SUB) { __syncthreads(); ts0 = __builtin_amdgcn_s_memrealtime(); }
        for (int u = bid; SKN(5) && u < 128; u += G) sgemm3_unit(L, (const bf16_t*)(ws + WS_GB) + (size_t)TP * 1024, 1024, (const bf16_t*)(ws + WS_WT_GLU), 1024, 1024, u, fg, lane, wave);
        SUBSPIN(5);
    } SEAM(5);

    if (IN(6)) {
        pg8::Gemm g{(const bf16_t*)(ws + WS_CAT), (const bf16_t*)(ws + WS_WT_OUT), 2048, 2048, 2048, 0}; pg8::StaticOrder S; S.init(SKN(6) ? 64 : 65, 4, G, bid);
        const FResT<false> fr{a.in[I_XP], a.in[I_XS], nullptr, nullptr, (bf16_t*)(ws + WS_X1B), (float*)(ws + WS_SSQ1)}; pg8::EpiRow<FResT<false>> E{fr}; pg8::gemm_phase(L, g, S, E, wave, (const float*)(ws + WS_SSQ_SSD));
        if (PROBE_SUB) { __syncthreads(); ts0 = __builtin_amdgcn_s_memrealtime(); }
        for (int u = bid; SKN(6) && u < 128; u += G) sgemm3_unit(L, (const bf16_t*)(ws + WS_CAT) + (size_t)TP * 2048, 2048, (const bf16_t*)(ws + WS_WT_OUT), 2048, 2048, u, fr, lane, wave, (const float*)(ws + WS_SSQ_SSD));
        SUBSPIN(5);
    } SEAM(6);

    if (IN(7)) {
        pg8::Gemm g{(const bf16_t*)(ws + WS_X1B), (const bf16_t*)(ws + WS_WT_XQ), 1024, 1024, 1024, 0}; pg8::StaticOrder S; S.init(SKN(7) ? 64 : 65, 4, G, bid);
        const FQ fq_{(bf16_t*)(ws + WS_QB), (const float*)(ws + WS_SSQ1)}; pg8::EpiRow<FQ> E{fq_}; pg8::gemm_phase(L, g, S, E, wave);
        if (PROBE_SUB) { __syncthreads(); ts0 = __builtin_amdgcn_s_memrealtime(); }
        for (int u = bid; SKN(7) && u < 128; u += G) sgemm3_unit(L, (const bf16_t*)(ws + WS_X1B) + (size_t)TP * 1024, 1024, (const bf16_t*)(ws + WS_WT_XQ), 1024, 1024, u, fq_, lane, wave);
        SUBSPIN(5);
    } SEAM(7);

    if (IN(8)) {
        { pg8::Gemm g{(const bf16_t*)(ws + WS_QB), (const bf16_t*)(ws + WS_KB), 1024, 1024, 256, 1}; pg8::StaticOrder S; S.init(64, 4, G, bid);
          pg8::EpiRow<FS> E{FS{(bf16_t*)(ws + WS_PB), (float*)(ws + WS_LSUM)}}; pg8::gemm_phase(L, g, S, E, wave); }
        for (int u = bid; u < TS * 4; u += G) attn_sample(a, L, u, tid, lane, wave);
    }

    if (IN(9)) {
        pg8::Gemm g{(const bf16_t*)(ws + WS_PB), (const bf16_t*)(ws + WS_VT), 1024, 256, 256, 2}; pg8::StaticOrder S; S.init(64, 4, G, bid);
        pg8::EpiRow<FPV> E{FPV{(bf16_t*)(ws + WS_OB), (const float*)(ws + WS_LSUM)}}; pg8::gemm_phase(L, g, S, E, wave);
    } SEAM(9);

    if (IN(10)) {
        pg8::Gemm g{(const bf16_t*)(ws + WS_OB), (const bf16_t*)(ws + WS_WT_XO), 1024, 1024, 1024, 0}; pg8::StaticOrder S; S.init(SKN(10) ? 64 : 65, 4, G, bid);
        bf16_t* const x1b = (bf16_t*)(ws + WS_X1B);
        const FResT<true> fr{x1b, x1b + (size_t)TP * 1024, nullptr, nullptr, x1b, (float*)(ws + WS_SSQ2)}; pg8::EpiRow<FResT<true>> E{fr}; pg8::gemm_phase(L, g, S, E, wave);
        if (PROBE_SUB) { __syncthreads(); ts0 = __builtin_amdgcn_s_memrealtime(); }
        for (int u = bid; SKN(10) && u < 128; u += G) sgemm3_unit(L, (const bf16_t*)(ws + WS_OB) + (size_t)TP * 1024, 1024, (const bf16_t*)(ws + WS_WT_XO), 1024, 1024, u, fr, lane, wave);
        SUBSPIN(5);
    } SEAM(10);

    if (IN(11)) {
        pg8::Gemm g{(const bf16_t*)(ws + WS_X1B), (const bf16_t*)(ws + WS_WT_GU), 1024, 1024, 1024, 0}; pg8::StaticOrder S; S.init(SKN(11) ? 64 : 65, 22, G, bid);
        const FUp fu{(bf16_t*)(ws + WS_MID), (const float*)(ws + WS_SSQ2)}; pg8::EpiRow<FUp> E{fu}; pg8::gemm_phase(L, g, S, E, wave);
        for (int u = G - 1 - bid; SKN(11) && u < 88; u += G) sgemm_unit((const bf16_t*)(ws + WS_X1B) + (size_t)TP * 1024, 1024, (const bf16_t*)(ws + WS_WT_GU), 1024, 1024, u >> 2, u & 3, fu, lane, wave);
    } SEAM(11);

    if (IN(12)) {
        pg8::Gemm g{(const bf16_t*)(ws + WS_MID), (const bf16_t*)(ws + WS_WT_DOWN), DFF, DFF, DFF, 0}; pg8::StaticOrder S; S.init(SKN(12) ? 64 : 65, 4, G, bid);
        bf16_t* const x1b = (bf16_t*)(ws + WS_X1B);
        const FResT<true> fr{x1b, x1b + (size_t)TP * 1024, a.out + O_YP, a.out + O_YS, nullptr, (float*)(ws + WS_SSQ3)};
        const bool fuse_norm = SKN(12) && G == 256 && (hi - lo > 1);
        if (fuse_norm) { const EpiFinal E{x1b, a.out + O_YP, (float*)(ws + WS_SSQ3), a.in[I_FING], &bar, wave}; pg8::gemm_phase(L, g, S, E, wave); }
        else { pg8::EpiRow<FResT<true>> E{fr}; pg8::gemm_phase(L, g, S, E, wave); }
        if (PROBE_SUB) { __syncthreads(); ts0 = __builtin_amdgcn_s_memrealtime(); }
        for (int u = bid; SKN(12) && u < 128; u += G) sgemm3_unit(L, (const bf16_t*)(ws + WS_MID) + (size_t)TP * DFF, DFF, (const bf16_t*)(ws + WS_WT_DOWN), DFF, DFF, u, fr, lane, wave);
        SUBSPIN(5);
    } SEAM(12);

    if (IN(13)) {
        const float* ssq = (const float*)(ws + WS_SSQ3); const float* fg = a.in[I_FING];
        const bool fused13 = SKN(12) && G == 256 && (hi - lo > 1);
        for (int row0 = fused13 ? TP + gw : gw; row0 < TP + TS; row0 += 4 * NGW) {
            f32x4 v[4][4]; float rs[4]; float* yp[4];
#pragma unroll
            for (int i = 0; i < 4; ++i) { const int row = row0 + i * NGW; const bool ok = row < TP + TS; const int rr = ok ? row : row0;
                yp[i] = (rr < TP ? a.out + O_YP + (size_t)rr * 1024 : a.out + O_YS + (size_t)(rr - TP) * 1024) + 4 * lane;
                rs[i] = rsqrtf(ssq[rr] * (1.f / 1024.f) + EPS);
#pragma unroll
                for (int j = 0; j < 4; ++j) v[i][j] = *(const f32x4*)(yp[i] + 256 * j); }
#pragma unroll
            for (int i = 0; i < 4; ++i) { const int row = row0 + i * NGW;
                if (row < TP + TS) {
#pragma unroll
                    for (int j = 0; j < 4; ++j) { const f32x4 gg = *(const f32x4*)(fg + 4 * lane + 256 * j); *(f32x4*)(yp[i] + 256 * j) = v[i][j] * rs[i] * gg; } } }
        }
    } SEAM(13);
#undef IN
#undef SEAM
#undef lane
#undef tid
#undef gt
}

extern "C" void kernel_launch(void* const* d_in, const int* in_sizes, int n_in, void* d_out, int out_size, void* d_ws, size_t ws_size, hipStream_t stream) {
    static int grid = 0;
    if (grid == 0) {
        if (n_in != 38 || ws_size < WS_END) { fprintf(stderr, "kernel_launch: unexpected n_in %d / ws %zu\n", n_in, ws_size); grid = -1; return; }
        int dev = 0, cus = 0, per_cu = 0;
        if (hipGetDevice(&dev) != hipSuccess || hipDeviceGetAttribute(&cus, hipDeviceAttributeMultiprocessorCount, dev) != hipSuccess) { grid = -1; return; }
        if (hipFuncSetAttribute((const void*)hymba_fwd, hipFuncAttributeMaxDynamicSharedMemorySize, LDS_BYTES) != hipSuccess) { fprintf(stderr, "kernel_launch: hipFuncSetAttribute failed\n"); grid = -1; return; }
        if (hipOccupancyMaxActiveBlocksPerMultiprocessor(&per_cu, (const void*)hymba_fwd, 512, LDS_BYTES) != hipSuccess || per_cu < 1) { fprintf(stderr, "kernel_launch: occupancy query says %d\n", per_cu); per_cu = 1; }
        (void)hipGetLastError();
        grid = cus;
    }
    if (grid < 0) return;
    (void)hipMemsetAsync((char*)d_ws + WS_BAR, 0, XCD_BAR_WORDS * 4, stream);
    Args a{};
    for (int i = 0; i < 38; ++i) a.in[i] = (const float*)d_in[i];
    a.out = (float*)d_out; a.ws = (unsigned char*)d_ws;
#if MK_MULTI
    for (int ph = 0; ph < NPH; ++ph) { a.ph_lo = ph; a.ph_hi = ph + 1; hipLaunchKernelGGL(hymba_fwd, dim3(grid), dim3(512), LDS_BYTES, stream, a); }
#else
    a.ph_lo = 0; a.ph_hi = NPH;
    void* args[] = {&a};
    hipError_t e = hipLaunchCooperativeKernel((const void*)hymba_fwd, dim3(grid), dim3(512), args, LDS_BYTES, stream);
    if (e != hipSuccess) fprintf(stderr, "kernel_launch: cooperative launch failed: %s (grid %d)\n", hipGetErrorString(e), grid);
#endif
}
```

```cpp
#include <hip/hip_runtime.h>
#include <hip/hip_cooperative_groups.h>
#include <cstdio>
#include <cstdint>
namespace cg = cooperative_groups;

#ifndef SK_MASK
#define SK_MASK 0x14E0
#endif
#define SKN(k) (((SK_MASK) >> (k)) & 1)
#ifndef MK_MULTI
#define MK_MULTI 0

#endif

#define DEVI __device__ __forceinline__
#define LAS __attribute__((address_space(3)))
typedef unsigned short bf16_t;
typedef short bf16x8 __attribute__((ext_vector_type(8)));
typedef float f32x4 __attribute__((ext_vector_type(4)));
typedef unsigned u32x4 __attribute__((ext_vector_type(4)));
typedef unsigned u32x2 __attribute__((ext_vector_type(2)));

constexpr int TP = 16384, TS = 128, TALL = 16640;
constexpr int DM = 1024, NPROJ = 3584, WIN_LD = 3600, DFF = 2816, CONVD = 1536;
constexpr float EPS = 1e-6f;
constexpr int S5LC = 256, S5NCH = 8;

constexpr size_t MiB = 1u << 20;
constexpr size_t WS_SSQ_SSD = 0, WS_SSQ1 = 128 * 1024, WS_SSQ2 = 256 * 1024, WS_SSQ3 = 384 * 1024, WS_LSUM = 512 * 1024, WS_ZERO_END = 896 * 1024;
constexpr size_t WS_DECAY = 896 * 1024;
constexpr size_t WS_BAR = 960 * 1024;
constexpr size_t WS_DTRAW = 1 * MiB;
constexpr size_t WS_WT_IN = 3 * MiB, WS_WT_GLU = 10 * MiB, WS_WT_OUT = 12 * MiB, WS_WT_XQ = 16 * MiB, WS_WT_KV = 18 * MiB, WS_WT_XO = 22 * MiB,
                 WS_WT_GU = 24 * MiB, WS_WT_DOWN = 35 * MiB;
constexpr size_t WS_KB = 41 * MiB, WS_VT = 45 * MiB, WS_MEMB = 49 * MiB, WS_S5END = 53 * MiB, WS_S5CAR = 61 * MiB;
constexpr size_t WS_PROJ = 70 * MiB, WS_MID = 70 * MiB;
constexpr size_t WS_HB = 184 * MiB, WS_X1B = 184 * MiB;
constexpr size_t WS_CS = 217 * MiB, WS_QB = 217 * MiB, WS_PB = 250 * MiB;
constexpr size_t WS_SIN = 281 * MiB, WS_OB = 283 * MiB;
constexpr size_t WS_CAT = 316 * MiB, WS_GB = 382 * MiB, WS_X1F = 415 * MiB, WS_END = 481 * MiB;

constexpr size_t O_YP = 0, O_YS = 16777216, O_CONVP = 16908288, O_SSMP = 16945152, O_S5RP = 17993728, O_S5IP = 18026496,
                 O_MEMK = 18059264, O_MEMV = 20156416, O_CONVS = 22253568, O_SSMS = 22843392, O_S5RS = 39620608, O_S5IS = 40144896;

constexpr int LDS_BYTES = 147456;
constexpr int MISC_OFF = 131072 + 8192;

struct Args { const float* in[38]; float* out; unsigned char* ws; int ph_lo, ph_hi; };
enum { I_XP = 0, I_XS, I_MEM, I_SCONV, I_SSSM, I_SS5R, I_SS5I, I_CK, I_CV, I_LN1, I_WIN, I_CONVW, I_CONVB, I_DTB, I_ALOG, I_DSSD, I_GN,
       I_LAMR, I_LAMI, I_LSTEP, I_BRE, I_BIM, I_CRE, I_CIM, I_DS5, I_WGLU, I_BGLU, I_WOUT, I_LN2, I_WXQ, I_WXK, I_WXV, I_WXO, I_LN3,
       I_WGATE, I_WUP, I_WDOWN, I_FING };

DEVI unsigned cvt_pk(float lo, float hi) { unsigned r; asm("v_cvt_pk_bf16_f32 %0, %1, %2" : "=v"(r) : "v"(lo), "v"(hi)); return r; }
DEVI bf16_t f2bf(float x) { return (bf16_t)(cvt_pk(x, 0.f) & 0xffffu); }
DEVI float bf2f(unsigned b) { return __uint_as_float(b << 16); }
DEVI float bflo(unsigned w) { return __uint_as_float(w << 16); }
DEVI float bfhi(unsigned w) { return __uint_as_float(w & 0xffff0000u); }
DEVI float rcp_(float x) { return __builtin_amdgcn_rcpf(x); }
DEVI float silu_(float x) { return x * rcp_(1.f + __expf(-x)); }
DEVI float sigmoid_(float x) { return rcp_(1.f + __expf(-x)); }
DEVI float gelu_(float x) { const float y = 0.7978845608f * (x + 0.044715f * x * x * x); const float t = 1.f - 2.f * rcp_(1.f + __expf(2.f * y)); return 0.5f * x * (1.f + t); }
DEVI float softplus_(float x) { return x > 20.f ? x : log1pf(expf(x)); }
DEVI int lane_id_() { int l = (int)__builtin_amdgcn_mbcnt_hi(~0u, __builtin_amdgcn_mbcnt_lo(~0u, 0u)); asm volatile("" : "+v"(l)); return l; }
DEVI float shfl_xor_(float v, int m) { return __builtin_bit_cast(float, __builtin_amdgcn_ds_bpermute((lane_id_() ^ m) << 2, __builtin_bit_cast(int, v))); }
DEVI float shfl_up_(float v, int o) { const int l = lane_id_(); return __builtin_bit_cast(float, __builtin_amdgcn_ds_bpermute((l >= o ? l - o : l) << 2, __builtin_bit_cast(int, v))); }
DEVI float shfl_(float v, int src) { return __builtin_bit_cast(float, __builtin_amdgcn_ds_bpermute(src << 2, __builtin_bit_cast(int, v))); }
DEVI float wave_sum(float v) {
    const int l = lane_id_();
#pragma unroll
    for (int o = 1; o < 64; o <<= 1) v += __builtin_bit_cast(float, __builtin_amdgcn_ds_bpermute((l ^ o) << 2, __builtin_bit_cast(int, v)));
    return v;
}
DEVI u32x4 pack8(const f32x4& a, const f32x4& b) { u32x4 w; w.x = cvt_pk(a[0], a[1]); w.y = cvt_pk(a[2], a[3]); w.z = cvt_pk(b[0], b[1]); w.w = cvt_pk(b[2], b[3]); return w; }
DEVI void unpack8(const u32x4& w, float* o) { o[0] = bflo(w.x); o[1] = bfhi(w.x); o[2] = bflo(w.y); o[3] = bfhi(w.y); o[4] = bflo(w.z); o[5] = bfhi(w.z); o[6] = bflo(w.w); o[7] = bfhi(w.w); }
#define LDS_WAIT() asm volatile("s_waitcnt lgkmcnt(0)" ::: "memory")

namespace pg8 {
constexpr int BM = 256, BK = 64, HALF = 128, HTB = HALF * BK * 2, STAGE_BYTES = 8 * HTB, NXCD = 8, WGM = 8;
DEVI int lds_byte(int r, int c) { const int st = (r >> 4) * 2 + (c >> 5), rr = r & 15, cc = c & 31, ob = rr * 64 + cc * 2; return st * 1024 + (ob ^ (((ob >> 9) & 1) << 5)); }
DEVI void stage_rc(int b, int& R, int& C) { const int st = b / 1024, sb = b % 1024, swz = sb ^ (((sb >> 9) & 1) << 5); R = (st >> 1) * 16 + swz / 64; C = (st & 1) * 32 + (swz % 64) / 2; }
DEVI int perm32(int rho) { const int n = rho >> 4, i = rho & 15; return 8 * (i >> 2) + 4 * n + (i & 3); }

struct Unit { int pm, pn; };
struct Gemm { const bf16_t* A; const bf16_t* Bt; int lda, ldb, K, mode; };
DEVI size_t a_off(const Gemm& g, const Unit& u) { size_t o = (size_t)u.pm * 256 * g.lda; if (g.mode) o += (size_t)u.pn * 256; return o * 2; }
DEVI size_t b_off(const Gemm& g, const Unit& u) {
    const size_t r = g.mode == 0 ? (size_t)u.pn : (g.mode == 1 ? (size_t)(u.pm >> 3) : (size_t)((u.pm >> 3) * 4 + u.pn));
    size_t o = r * 256 * g.ldb; if (g.mode == 1) o += (size_t)u.pn * 256; return o * 2;
}
struct StaticOrder {
    int nM, nN, nwg, G, c;
    DEVI void init(int nM_, int nN_, int G_, int c_) { nM = nM_; nN = nN_; nwg = nM * nN; G = G_; c = c_; }
    DEVI bool next(int i, Unit& u) const {
        const long L = (long)i * G + c; if (L >= nwg) return false;
        int wgid = (int)L; { const int q = nwg / NXCD, r = nwg % NXCD, xcd = wgid % NXCD, off = wgid / NXCD; wgid = (xcd < r ? xcd * (q + 1) : r * (q + 1) + (xcd - r) * q) + off; }
        const int nig = WGM * nN, gid = wgid / nig, fm = gid * WGM, gsz = (nM - fm) < WGM ? (nM - fm) : WGM;
        u.pm = fm + ((wgid % nig) % gsz); u.pn = (wgid % nig) / gsz; return true;
    }
};

template <class F> struct EpiRow {
    F f;
    DEVI void operator()(const f32x4 (&acc)[2][2][4][2], const Unit& u, int wr, int wc, int fr, int fq) const {
        const int c8 = wc * 32 + 8 * fq;
        typename F::UC uc; f.unit(u.pn, c8, uc);
#pragma unroll
        for (int ai = 0; ai < 2; ++ai) {
#pragma unroll
            for (int m0 = 0; m0 < 4; m0 += F::NB) {
                typename F::Pre p[F::NB];
#pragma unroll
                for (int m = 0; m < F::NB; ++m) f.load(u.pm * BM + ai * HALF + wr * 64 + (m0 + m) * 16 + fr, u.pn, c8, p[m]);
#pragma unroll
                for (int m = 0; m < F::NB; ++m) f.apply(u.pm * BM + ai * HALF + wr * 64 + (m0 + m) * 16 + fr, u.pn, c8, acc[ai][0][m0 + m][0], acc[ai][0][m0 + m][1], acc[ai][1][m0 + m][0], acc[ai][1][m0 + m][1], p[m], uc);
            }
        }
    }
};
template <class F> DEVI void epi_one(const F& f, int row, int pn, int c8, const f32x4& a0, const f32x4& a1, const f32x4& b0, const f32x4& b1) {
    typename F::UC uc; f.unit(pn, c8, uc); typename F::Pre p; f.load(row, pn, c8, p); f.apply(row, pn, c8, a0, a1, b0, b1, p, uc);
}

template <class Epi, class Sched>
DEVI void gemm_phase(LAS unsigned char* lds, const Gemm g, const Sched& S, const Epi& E, int wid, const float* hs = nullptr) {
    const int lane = lane_id_(), tid = wid * 64 + lane, wr = wid >> 2, wc = wid & 3, fr = lane & 15, fq = lane >> 4;
    const int K = g.K, nt = K / BK;
    unsigned voffA[2], voffB[2];
#pragma unroll
    for (int i = 0; i < 2; ++i) { int R, C; stage_rc(tid * 16 + i * 8192, R, C); const int Rb = (R & ~31) + perm32(R & 31);
        voffA[i] = (unsigned)(R * g.lda + C) * 2u; voffB[i] = (unsigned)(Rb * g.ldb + C) * 2u; }
    const size_t kstep = (size_t)(BK * 2);
    const size_t hsA = (size_t)HALF * g.lda * 2, hsB = (size_t)HALF * g.ldb * 2;
    const unsigned ldsw = (unsigned)wid * 1024u;
    const int aoff = lds_byte(wr * 64 + fr, fq * 8), boff = lds_byte(wc * 32 + fr, fq * 8);
#define PG8_SA(b, h) (((b) * 2 + (h)) * HTB)
#define PG8_SB(b, h) ((4 + (b) * 2 + (h)) * HTB)
#define PG8_STAGE(bufoff, gbase, voff) do { _Pragma("unroll") for (int _i = 0; _i < 2; ++_i) \
        __builtin_amdgcn_global_load_lds((const unsigned*)((const char*)(gbase) + (voff)[_i]), (LAS unsigned*)(lds + (bufoff) + ldsw + _i * 8192), 16, 0, 0); } while (0)
#define PG8_LDA(dst, b, h) do { _Pragma("unroll") for (int m = 0; m < 4; ++m) _Pragma("unroll") for (int k = 0; k < 2; ++k) dst[m][k] = *(const LAS bf16x8*)(lds + PG8_SA(b, h) + aoff + m * 2048 + k * 1024); } while (0)
#define PG8_LDB(dst, b, h) do { _Pragma("unroll") for (int n = 0; n < 2; ++n) _Pragma("unroll") for (int k = 0; k < 2; ++k) dst[n][k] = *(const LAS bf16x8*)(lds + PG8_SB(b, h) + boff + n * 2048 + k * 1024); } while (0)
#define PG8_MMA(ai, bj, At, Bt) do { __builtin_amdgcn_s_setprio(1); _Pragma("unroll") for (int m = 0; m < 4; ++m) _Pragma("unroll") for (int n = 0; n < 2; ++n) _Pragma("unroll") for (int k = 0; k < 2; ++k) \
        acc[ai][bj][m][n] = __builtin_amdgcn_mfma_f32_16x16x32_bf16(Bt[n][k], At[m][k], acc[ai][bj][m][n], 0, 0, 0); __builtin_amdgcn_s_setprio(0); } while (0)
#define PG8_WAIT_V(n) asm volatile("s_waitcnt vmcnt(" #n ")" ::: "memory")
#define PG8_WAIT_L(n) asm volatile("s_waitcnt lgkmcnt(" #n ")" ::: "memory")
#define PG8_BAR __builtin_amdgcn_s_barrier()
#define PG8_SCHED __builtin_amdgcn_sched_barrier(0)
    Unit cur, nxt; int ui = 0;
    if (!S.next(0, cur)) return;
    LAS float* const RS = (LAS float*)(lds + STAGE_BYTES);
    if (hs) { if (tid < 256) RS[tid] = rsqrtf(hs[cur.pm * BM + tid] * (1.f / 1024.f) + EPS); }
    f32x4 acc[2][2][4][2];
#pragma unroll
    for (int a = 0; a < 2; ++a)
#pragma unroll
        for (int b = 0; b < 2; ++b)
#pragma unroll
            for (int m = 0; m < 4; ++m)
#pragma unroll
                for (int n = 0; n < 2; ++n) acc[a][b][m][n] = (f32x4){0.f, 0.f, 0.f, 0.f};
    bf16x8 At[4][2], B0[2][2], B1[2][2];
    const char* cA = (const char*)g.A + a_off(g, cur); const char* cB = (const char*)g.Bt + b_off(g, cur);
    PG8_STAGE(PG8_SB(0, 0), cB, voffB); PG8_STAGE(PG8_SB(0, 1), cB + hsB, voffB); PG8_STAGE(PG8_SA(0, 0), cA, voffA); PG8_STAGE(PG8_SA(0, 1), cA + hsA, voffA);
    if (wr == 1) PG8_BAR;
    PG8_WAIT_V(2); PG8_BAR;
    PG8_STAGE(PG8_SB(1, 0), cB + kstep, voffB); PG8_STAGE(PG8_SA(1, 0), cA + kstep, voffA); PG8_STAGE(PG8_SB(1, 1), cB + hsB + kstep, voffB);
    PG8_WAIT_V(6); PG8_BAR;
    for (;;) {
        const bool has_next = S.next(ui + 1, nxt);
        const char* nA = has_next ? (const char*)g.A + a_off(g, nxt) : cA; const char* nB = has_next ? (const char*)g.Bt + b_off(g, nxt) : cB;
        for (int t = 0; t < nt; t += 2) {
            const bool last = (t == nt - 2);
            if (hs && t == (nt >> 1)) {
#pragma unroll
                for (int ai = 0; ai < 2; ++ai)
#pragma unroll
                    for (int m = 0; m < 4; ++m) { const float rs = RS[ai * HALF + wr * 64 + m * 16 + fr];
#pragma unroll
                        for (int bj = 0; bj < 2; ++bj)
#pragma unroll
                            for (int n = 0; n < 2; ++n) acc[ai][bj][m][n] = acc[ai][bj][m][n] * rs; }
            }
            const char* a1 = cA + (size_t)(t + 1) * kstep;
            const char* a2 = last ? nA : cA + (size_t)(t + 2) * kstep; const char* b2 = last ? nB : cB + (size_t)(t + 2) * kstep;
            const char* a3 = a2 + kstep; const char* b3 = b2 + kstep;
            PG8_LDB(B0, 0, 0); PG8_LDB(B1, 0, 1); PG8_SCHED; PG8_LDA(At, 0, 0); PG8_STAGE(PG8_SA(1, 1), a1 + hsA, voffA);
            PG8_WAIT_V(8); PG8_WAIT_L(0); PG8_BAR; PG8_MMA(0, 0, At, B0); PG8_MMA(0, 1, At, B1); PG8_BAR; PG8_SCHED;
            PG8_LDA(At, 0, 1); PG8_STAGE(PG8_SB(0, 0), b2, voffB); PG8_STAGE(PG8_SB(0, 1), b2 + hsB, voffB); PG8_STAGE(PG8_SA(0, 0), a2, voffA);
            PG8_WAIT_V(8); PG8_WAIT_L(0); PG8_BAR; PG8_MMA(1, 0, At, B0); PG8_MMA(1, 1, At, B1); PG8_BAR; PG8_SCHED;
            PG8_LDB(B0, 1, 0); PG8_LDB(B1, 1, 1); PG8_SCHED; PG8_LDA(At, 1, 0); PG8_STAGE(PG8_SA(0, 1), a2 + hsA, voffA);
            PG8_WAIT_V(8); PG8_WAIT_L(0); PG8_BAR; PG8_MMA(0, 0, At, B0); PG8_MMA(0, 1, At, B1); PG8_BAR; PG8_SCHED;
            PG8_LDA(At, 1, 1); PG8_STAGE(PG8_SB(1, 0), b3, voffB); PG8_STAGE(PG8_SB(1, 1), b3 + hsB, voffB); PG8_STAGE(PG8_SA(1, 0), a3, voffA);
            PG8_WAIT_V(8); PG8_WAIT_L(0); PG8_BAR; PG8_MMA(1, 0, At, B0); PG8_MMA(1, 1, At, B1); PG8_BAR; PG8_SCHED;
        }
        if (wr == 0) PG8_BAR;
        E(acc, cur, wr, wc, fr, fq);
        if (!has_next) break;
#pragma unroll
        for (int a = 0; a < 2; ++a)
#pragma unroll
            for (int b = 0; b < 2; ++b)
#pragma unroll
                for (int m = 0; m < 4; ++m)
#pragma unroll
                    for (int n = 0; n < 2; ++n) acc[a][b][m][n] = (f32x4){0.f, 0.f, 0.f, 0.f};
        cur = nxt; cA = nA; cB = nB; ++ui;
        if (wr == 1) PG8_BAR;
    }
    PG8_WAIT_V(0);
    PG8_BAR;
#undef PG8_SA
#undef PG8_SB
#undef PG8_STAGE
#undef PG8_LDA
#undef PG8_LDB
#undef PG8_MMA
#undef PG8_WAIT_V
#undef PG8_WAIT_L
#undef PG8_BAR
#undef PG8_SCHED
}
}

struct FIn {
    bf16_t* proj; float* convP; float* convS;
    static constexpr int NB = 4; struct UC {}; struct Pre {};
    DEVI void unit(int, int, UC&) const {} DEVI void load(int, int, int, Pre&) const {}
    DEVI void apply(int row, int pn, int c8, const f32x4& a0, const f32x4& a1, const f32x4& b0, const f32x4& b1, const Pre&, const UC&) const {
#pragma unroll
        for (int bj = 0; bj < 2; ++bj) {
            const int col = pn * 256 + bj * 128 + c8; const f32x4 v0 = bj ? b0 : a0, v1 = bj ? b1 : a1;
            *(u32x4*)(proj + (size_t)row * NPROJ + col) = pack8(v0, v1);
            if (col >= 1024 && col < 2560) {
                float* dst = nullptr;
                if (row < TP) { const int t = row & 2047; if (t >= 2045) dst = convP + ((size_t)(row >> 11) * 3 + (t - 2045)) * CONVD + (col - 1024); }
                else if (row < TP + TS) dst = convS + ((size_t)(row - TP) * 3 + 2) * CONVD + (col - 1024);
                if (dst) { *(f32x4*)dst = v0; *(f32x4*)(dst + 4) = v1; }
            }
        }
    }
};
struct FKV {
    float* outk; float* outv; bf16_t* kb; bf16_t* vt;
    static constexpr int NB = 4; struct UC {}; struct Pre {};
    DEVI void unit(int, int, UC&) const {} DEVI void load(int, int, int, Pre&) const {}
    DEVI void apply(int row, int pn, int c8, const f32x4& a0, const f32x4& a1, const f32x4& b0, const f32x4& b1, const Pre&, const UC&) const {
#pragma unroll
        for (int bj = 0; bj < 2; ++bj) {
            const int col = pn * 256 + bj * 128 + c8; const f32x4 v0 = bj ? b0 : a0, v1 = bj ? b1 : a1;
            if (col < 1024) {
                float* d = outk + (size_t)row * 1024 + col; *(f32x4*)d = v0; *(f32x4*)(d + 4) = v1;
                *(u32x4*)(kb + (size_t)row * 1024 + col) = pack8(v0, v1);
            } else {
                const int c = col - 1024; float* d = outv + (size_t)row * 1024 + c; *(f32x4*)d = v0; *(f32x4*)(d + 4) = v1;
                const int b = row >> 8, m = row & 255, h = c >> 8, dd = c & 255;
                bf16_t* t = vt + ((size_t)(b * 4 + h) * 256 + dd) * 256 + m;
#pragma unroll
                for (int j = 0; j < 4; ++j) { t[(size_t)j * 256] = f2bf(v0[j]); t[(size_t)(j + 4) * 256] = f2bf(v1[j]); }
            }
        }
    }
};
struct FGlu {
    const bf16_t* gb; const float* bglu; bf16_t* cat; const float* ssq;
    static constexpr int NB = 4; struct UC { f32x4 b[2][2]; }; struct Pre { u32x4 g[2]; };
    DEVI void unit(int pn, int c8, UC& uc) const {
#pragma unroll
        for (int bj = 0; bj < 2; ++bj) { const int col = pn * 256 + bj * 128 + c8; uc.b[bj][0] = *(const f32x4*)(bglu + col); uc.b[bj][1] = *(const f32x4*)(bglu + col + 4); } }
    DEVI void load(int row, int pn, int c8, Pre& p) const {
#pragma unroll
        for (int bj = 0; bj < 2; ++bj) p.g[bj] = *(const u32x4*)(gb + (size_t)row * 1024 + pn * 256 + bj * 128 + c8); }
    DEVI void apply(int row, int pn, int c8, const f32x4& a0, const f32x4& a1, const f32x4& b0, const f32x4& b1, const Pre& p, const UC& uc) const {
#pragma unroll
        for (int bj = 0; bj < 2; ++bj) {
            const int col = pn * 256 + bj * 128 + c8; const f32x4 v0 = bj ? b0 : a0, v1 = bj ? b1 : a1;
            float g[8]; unpack8(p.g[bj], g);
            f32x4 y0, y1;
#pragma unroll
            for (int j = 0; j < 4; ++j) { y0[j] = g[j] * sigmoid_(v0[j] + uc.b[bj][0][j]); y1[j] = g[4 + j] * sigmoid_(v1[j] + uc.b[bj][1][j]); }
            *(u32x4*)(cat + (size_t)row * 2048 + 1024 + col) = pack8(y0, y1);
        }
    }
};
template <bool BB>
struct FResT {
    const void* baseP; const void* baseS; float* outP; float* outS; bf16_t* outb; float* ssq;
    static constexpr int NB = 4; struct UC {}; struct Pre { f32x4 x[2][2]; };
    DEVI void unit(int, int, UC&) const {}
    DEVI void load(int row, int pn, int c8, Pre& p) const {
        const int rr = row < TP + TS ? row : 0;
#pragma unroll
        for (int bj = 0; bj < 2; ++bj) { const int col = pn * 256 + bj * 128 + c8;
            if (BB) { const bf16_t* base = rr < TP ? (const bf16_t*)baseP + (size_t)rr * 1024 : (const bf16_t*)baseS + (size_t)(rr - TP) * 1024;
                float f[8]; unpack8(*(const u32x4*)(base + col), f); p.x[bj][0] = (f32x4){f[0], f[1], f[2], f[3]}; p.x[bj][1] = (f32x4){f[4], f[5], f[6], f[7]}; }
            else { const float* base = rr < TP ? (const float*)baseP + (size_t)rr * 1024 : (const float*)baseS + (size_t)(rr - TP) * 1024;
                p.x[bj][0] = *(const f32x4*)(base + col); p.x[bj][1] = *(const f32x4*)(base + col + 4); } } }
    DEVI void apply(int row, int pn, int c8, const f32x4& a0, const f32x4& a1, const f32x4& b0, const f32x4& b1, const Pre& p, const UC&) const {
        const bool valid = row < TP + TS;
        float* out = outP ? (row < TP ? outP + (size_t)row * 1024 : outS + (size_t)(row - TP) * 1024) : nullptr;
        float ss = 0.f;
        if (valid) {
#pragma unroll
            for (int bj = 0; bj < 2; ++bj) {
                const int col = pn * 256 + bj * 128 + c8; const f32x4 v0 = bj ? b0 : a0, v1 = bj ? b1 : a1;
                const f32x4 x0 = p.x[bj][0] + v0, x1 = p.x[bj][1] + v1;
                if (out) { *(f32x4*)(out + col) = x0; *(f32x4*)(out + col + 4) = x1; }
                if (outb) *(u32x4*)(outb + (size_t)row * 1024 + col) = pack8(x0, x1);
                ss += (x0[0] * x0[0] + x0[1] * x0[1]) + (x0[2] * x0[2] + x0[3] * x0[3]) + (x1[0] * x1[0] + x1[1] * x1[1]) + (x1[2] * x1[2] + x1[3] * x1[3]);
            }
        }
        ss += shfl_xor_(ss, 16); ss += shfl_xor_(ss, 32);
        if (valid && ((c8 >> 3) & 3) == 0) atomicAdd(ssq + row, ss);
    }
};
struct FQ {
    bf16_t* qb; const float* ssq;
    static constexpr int NB = 4; struct UC {}; struct Pre { float ss; };
    DEVI void unit(int, int, UC&) const {} DEVI void load(int row, int, int, Pre& p) const { p.ss = ssq[row]; }
    DEVI void apply(int row, int pn, int c8, const f32x4& a0, const f32x4& a1, const f32x4& b0, const f32x4& b1, const Pre& p, const UC&) const {
        const float rs = rsqrtf(p.ss * (1.f / 1024.f) + EPS) * 0.0625f;
        *(u32x4*)(qb + (size_t)row * 1024 + pn * 256 + c8) = pack8(a0 * rs, a1 * rs);
        *(u32x4*)(qb + (size_t)row * 1024 + pn * 256 + 128 + c8) = pack8(b0 * rs, b1 * rs);
    }
};
struct FS {
    bf16_t* pb; float* lsum;
    static constexpr int NB = 4; struct UC {}; struct Pre {};
    DEVI void unit(int, int, UC&) const {} DEVI void load(int, int, int, Pre&) const {}
    DEVI void apply(int row, int pn, int c8, const f32x4& a0, const f32x4& a1, const f32x4& b0, const f32x4& b1, const Pre&, const UC&) const {
        float ls = 0.f;
#pragma unroll
        for (int bj = 0; bj < 2; ++bj) {
            const f32x4 v0 = bj ? b0 : a0, v1 = bj ? b1 : a1; f32x4 e0, e1;
#pragma unroll
            for (int j = 0; j < 4; ++j) { e0[j] = __expf(v0[j]); e1[j] = __expf(v1[j]); }
            const u32x4 w = pack8(e0, e1);
            *(u32x4*)(pb + (size_t)row * 1024 + pn * 256 + bj * 128 + c8) = w;
            ls += (bflo(w.x) + bfhi(w.x)) + (bflo(w.y) + bfhi(w.y)) + (bflo(w.z) + bfhi(w.z)) + (bflo(w.w) + bfhi(w.w));
        }
        ls += shfl_xor_(ls, 16); ls += shfl_xor_(ls, 32);
        if (((c8 >> 3) & 3) == 0) atomicAdd(lsum + (size_t)row * 4 + pn, ls);
    }
};
struct FPV {
    bf16_t* ob; const float* lsum;
    static constexpr int NB = 4; struct UC {}; struct Pre { float l; };
    DEVI void unit(int, int, UC&) const {} DEVI void load(int row, int pn, int, Pre& p) const { p.l = __hip_atomic_load(lsum + (size_t)row * 4 + pn, __ATOMIC_RELAXED, __HIP_MEMORY_SCOPE_AGENT); }
    DEVI void apply(int row, int pn, int c8, const f32x4& a0, const f32x4& a1, const f32x4& b0, const f32x4& b1, const Pre& p, const UC&) const {
        const float inv = 1.f / p.l;
        *(u32x4*)(ob + (size_t)row * 1024 + pn * 256 + c8) = pack8(a0 * inv, a1 * inv);
        *(u32x4*)(ob + (size_t)row * 1024 + pn * 256 + 128 + c8) = pack8(b0 * inv, b1 * inv);
    }
};
struct FUp {
    bf16_t* mid; const float* ssq;
    static constexpr int NB = 4; struct UC {}; struct Pre { float ss; };
    DEVI void unit(int, int, UC&) const {} DEVI void load(int row, int, int, Pre& p) const { p.ss = ssq[row]; }
    DEVI void apply(int row, int pn, int c8, const f32x4& a0, const f32x4& a1, const f32x4& b0, const f32x4& b1, const Pre& p, const UC&) const {
        const float rs = rsqrtf(p.ss * (1.f / 1024.f) + EPS);
        f32x4 y0, y1;
#pragma unroll
        for (int j = 0; j < 4; ++j) { y0[j] = silu_(a0[j] * rs) * (b0[j] * rs); y1[j] = silu_(a1[j] * rs) * (b1[j] * rs); }
        *(u32x4*)(mid + (size_t)row * DFF + pn * 128 + c8) = pack8(y0, y1);
    }
};

template <class F>
DEVI void sgemm_unit(const bf16_t* A, int lda, const bf16_t* Wt, int ldb, int K, int pn, int wc, const F& f, int lane_, int wave) {
    int lane = lane_; asm volatile("" : "+v"(lane));
    const int r = lane & 15, q = lane >> 4;
    const bf16_t* ap = A + (size_t)(16 * wave + r) * lda + 8 * q;
    const bf16_t* wp[4];
#pragma unroll
    for (int t = 0; t < 4; ++t) wp[t] = Wt + (size_t)(256 * pn + 128 * (t >> 1) + 32 * wc + 8 * (r >> 2) + 4 * (t & 1) + (r & 3)) * ldb + 8 * q;
    f32x4 acc[4];
#pragma unroll
    for (int t = 0; t < 4; ++t) acc[t] = (f32x4){0.f, 0.f, 0.f, 0.f};
    for (int k0 = 0; k0 < K; k0 += 128) {
        bf16x8 fa[4], fw[4][4];
#pragma unroll
        for (int u = 0; u < 4; ++u) { fa[u] = *(const bf16x8*)(ap + k0 + 32 * u);
#pragma unroll
            for (int t = 0; t < 4; ++t) fw[u][t] = *(const bf16x8*)(wp[t] + k0 + 32 * u); }
#pragma unroll
        for (int u = 0; u < 4; ++u)
#pragma unroll
            for (int t = 0; t < 4; ++t) acc[t] = __builtin_amdgcn_mfma_f32_16x16x32_bf16(fw[u][t], fa[u], acc[t], 0, 0, 0);
    }
    pg8::epi_one(f, TP + 16 * wave + r, pn, 32 * wc + 8 * q, acc[0], acc[1], acc[2], acc[3]);
}

template <class F>
DEVI void sgemm2_unit(LAS unsigned char* L, const bf16_t* A, int lda, const bf16_t* Wt, int ldb, int K, int unit, const F& f, int lane_, int wave) {
    int lane = lane_; asm volatile("" : "+v"(lane));
    const int tq = unit & 3, wc = (unit >> 2) & 3, pn = unit >> 4;
    const int r = lane & 15, q = lane >> 4, tg = wave & 1, kq = wave >> 1;
    const int NK = K >> 5, per = (((NK >> 2) + 7) >> 3) << 3, ksb = kq * per, cnt = (NK - ksb) < per ? (NK - ksb) : per;
    const bf16_t* ap = A + (size_t)(32 * tq + 16 * tg + r) * lda + 8 * q + 32 * ksb;
    const bf16_t* wp[4];
#pragma unroll
    for (int t = 0; t < 4; ++t) wp[t] = Wt + (size_t)(256 * pn + 128 * (t >> 1) + 32 * wc + 8 * (r >> 2) + 4 * (t & 1) + (r & 3)) * ldb + 8 * q + 32 * ksb;
    f32x4 acc[4];
#pragma unroll
    for (int t = 0; t < 4; ++t) acc[t] = (f32x4){0.f, 0.f, 0.f, 0.f};
    for (int c0 = 0; c0 < cnt; c0 += 8) {
        bf16x8 fa[8], fw[8][4];
#pragma unroll
        for (int u = 0; u < 8; ++u) { fa[u] = *(const bf16x8*)(ap + (c0 + u) * 32);
#pragma unroll
            for (int t = 0; t < 4; ++t) fw[u][t] = *(const bf16x8*)(wp[t] + (c0 + u) * 32); }
#pragma unroll
        for (int u = 0; u < 8; ++u)
#pragma unroll
            for (int t = 0; t < 4; ++t) acc[t] = __builtin_amdgcn_mfma_f32_16x16x32_bf16(fw[u][t], fa[u], acc[t], 0, 0, 0);
    }
    LAS f32x4* red = (LAS f32x4*)L;
#pragma unroll
    for (int t = 0; t < 4; ++t) red[(wave * 4 + t) * 64 + lane] = acc[t];
    __syncthreads();
    if (kq == 0) {
#pragma unroll
        for (int t = 0; t < 4; ++t) acc[t] = (red[(tg * 4 + t) * 64 + lane] + red[((tg + 2) * 4 + t) * 64 + lane]) + (red[((tg + 4) * 4 + t) * 64 + lane] + red[((tg + 6) * 4 + t) * 64 + lane]);
        pg8::epi_one(f, TP + 32 * tq + 16 * tg + r, pn, 32 * wc + 8 * q, acc[0], acc[1], acc[2], acc[3]);
    }
    __syncthreads();
}

template <class F>
DEVI void sgemm3_unit(LAS unsigned char* L, const bf16_t* A, int lda, const bf16_t* Wt, int ldb, int K, int unit, const F& f, int lane_, int wave, const float* hs = nullptr) {
    int lane = lane_; asm volatile("" : "+v"(lane));
    const int tg = unit & 7, wc = (unit >> 3) & 3, pn = unit >> 5;
    const int r = lane & 15, q = lane >> 4;
    const int NK = K >> 5, per = (((NK >> 3) + 3) >> 2) << 2, ksb = wave * per; int cnt = NK - ksb; cnt = cnt < 0 ? 0 : (cnt < per ? cnt : per);
    const bf16_t* ap = A + (size_t)(16 * tg + r) * lda + 8 * q + 32 * ksb;
    const bf16_t* wp[4];
#pragma unroll
    for (int t = 0; t < 4; ++t) wp[t] = Wt + (size_t)(256 * pn + 128 * (t >> 1) + 32 * wc + 8 * (r >> 2) + 4 * (t & 1) + (r & 3)) * ldb + 8 * q + 32 * ksb;
    f32x4 acc[4];
#pragma unroll
    for (int t = 0; t < 4; ++t) acc[t] = (f32x4){0.f, 0.f, 0.f, 0.f};
    typename F::UC euc; typename F::Pre epre;
    if (wave == 0) { f.unit(pn, 32 * wc + 8 * q, euc); f.load(TP + 16 * tg + r, pn, 32 * wc + 8 * q, epre); }
    for (int c0 = 0; c0 < cnt; c0 += 4) {
        bf16x8 fa[4], fw[4][4];
#pragma unroll
        for (int u = 0; u < 4; ++u) { fa[u] = *(const bf16x8*)(ap + (c0 + u) * 32);
#pragma unroll
            for (int t = 0; t < 4; ++t) fw[u][t] = *(const bf16x8*)(wp[t] + (c0 + u) * 32); }
#pragma unroll
        for (int u = 0; u < 4; ++u)
#pragma unroll
            for (int t = 0; t < 4; ++t) acc[t] = __builtin_amdgcn_mfma_f32_16x16x32_bf16(fw[u][t], fa[u], acc[t], 0, 0, 0);
    }
    LAS f32x4* red = (LAS f32x4*)L;
#pragma unroll
    for (int t = 0; t < 4; ++t) red[(wave * 4 + t) * 64 + lane] = acc[t];
    __syncthreads();
    if (wave == 0) {
        const float hrs = hs ? rsqrtf(hs[TP + 16 * tg + r] * (1.f / 1024.f) + EPS) : 1.f;
#pragma unroll
        for (int t = 0; t < 4; ++t) { f32x4 v = red[t * 64 + lane];
#pragma unroll
            for (int w = 1; w < 4; ++w) v += red[(w * 4 + t) * 64 + lane];
            v = v * hrs;
#pragma unroll
            for (int w = 4; w < 8; ++w) v += red[(w * 4 + t) * 64 + lane];
            acc[t] = v; }
        f.apply(TP + 16 * tg + r, pn, 32 * wc + 8 * q, acc[0], acc[1], acc[2], acc[3], epre, euc);
    }
    __syncthreads();
}

#define XB_TMO      128
#define XB_XCNT(j)  (256  + 64 * (j))
#define XB_XSUB(j)  (1280 + 64 * (j))
#define XB_XGEN(j)  (2304 + 64 * (j))
#define XB_TOP      3328
#define XB_TOPGEN   3392
#define XCD_BAR_WORDS 3456
#define XB_SPIN_CAP (1u << 22)
DEVI unsigned xb_ld(unsigned* p)              { return __hip_atomic_load(p, __ATOMIC_RELAXED, __HIP_MEMORY_SCOPE_AGENT); }
DEVI unsigned xb_add(unsigned* p, unsigned v) { return __hip_atomic_fetch_add(p, v, __ATOMIC_RELAXED, __HIP_MEMORY_SCOPE_AGENT); }
DEVI unsigned xb_xcc_id() { return (unsigned)__builtin_amdgcn_s_getreg((3 << 11) | 20) & 0xFu; }
#define XB_SPIN(cond, bar) do { unsigned _sp = 0; while (cond) { __builtin_amdgcn_s_sleep(1); \
    if ((++_sp & 255u) == 0u) { if (xb_ld(&(bar)[XB_TMO])) break; if (_sp > XB_SPIN_CAP) { atomicAdd(&(bar)[XB_TMO], 1u); break; } } } } while (0)
struct XcdBarrier { unsigned* bar; unsigned x; volatile LAS unsigned* st; };
DEVI XcdBarrier xcd_barrier_post(unsigned* bar, volatile LAS unsigned* st, bool t0) {
    XcdBarrier b; b.bar = bar; b.x = xb_xcc_id(); b.st = st;
    if (t0) (void)xb_add(&bar[XB_XCNT(b.x)], 1u);
    return b;
}
DEVI void xcd_barrier_complete(unsigned* bar, unsigned x, unsigned& nloc, unsigned& nx) {
    const unsigned G = gridDim.x * gridDim.y * gridDim.z;
    unsigned sum, cnt, mine, sp = 0u;
    for (;;) {
        sum = 0u; cnt = 0u; mine = 0u;
#pragma unroll
        for (unsigned j = 0; j < 16; ++j) { const unsigned c = xb_ld(&bar[XB_XCNT(j)]); sum += c; cnt += (c > 0u) ? 1u : 0u; mine = (j == x) ? c : mine; }
        if (sum == G) break;
        __builtin_amdgcn_s_sleep(1);
        if ((++sp & 255u) == 0u) { if (xb_ld(&bar[XB_TMO])) break; if (sp > XB_SPIN_CAP) { atomicAdd(&bar[XB_TMO], 1u); break; } }
    }
    nloc = mine > 0u ? mine : 1u; nx = cnt > 0u ? cnt : 1u;
}
DEVI void xcd_barrier(const XcdBarrier& b, int wave) {
    asm volatile("s_waitcnt vmcnt(0)" ::: "memory");
    __syncthreads();
    if (wave == 0 && lane_id_() == 0) {
        unsigned* bar = b.bar;
        __builtin_amdgcn_s_waitcnt(0);
        unsigned nloc = b.st[0], nx = b.st[1];
        if (nloc == 0u) { xcd_barrier_complete(bar, b.x, nloc, nx); b.st[0] = nloc; b.st[1] = nx; }
        const unsigned old = xb_add(&bar[XB_XSUB(b.x)], 1u);
        const unsigned gen = old / nloc;
        if (old + 1u == (gen + 1u) * nloc) {
            __builtin_amdgcn_fence(__ATOMIC_RELEASE, "agent");
            asm volatile("s_waitcnt vmcnt(0)" ::: "memory");
            const unsigned og = xb_add(&bar[XB_TOP], 1u);
            const unsigned tg = og / nx;
            if (og + 1u == (tg + 1u) * nx) xb_add(&bar[XB_TOPGEN], 1u);
            else XB_SPIN(xb_ld(&bar[XB_TOPGEN]) == tg, bar);
            __builtin_amdgcn_fence(__ATOMIC_ACQUIRE, "agent");
            xb_add(&bar[XB_XGEN(b.x)], 1u);
            asm volatile("s_waitcnt vmcnt(0)" ::: "memory");
        } else {
            XB_SPIN(xb_ld(&bar[XB_XGEN(b.x)]) == gen, bar);
            __builtin_amdgcn_fence(__ATOMIC_ACQUIRE, "agent");
            asm volatile("s_waitcnt vmcnt(0)" ::: "memory");
        }
    }
    __syncthreads();
}

struct EpiFinal {
    const bf16_t* base; float* out; float* ssq; const float* fing; const XcdBarrier* bar; int wave;
    DEVI void operator()(f32x4 (&acc)[2][2][4][2], const pg8::Unit& u, int wr, int wc, int fr, int fq) const {
        const int c8 = wc * 32 + 8 * fq;
#pragma unroll
        for (int ai = 0; ai < 2; ++ai)
#pragma unroll
            for (int m0 = 0; m0 < 4; m0 += 2) {
                f32x4 x[2][2][2];
#pragma unroll
                for (int m = 0; m < 2; ++m) { const int row = u.pm * 256 + ai * 128 + wr * 64 + (m0 + m) * 16 + fr;
#pragma unroll
                    for (int bj = 0; bj < 2; ++bj) { float f[8]; unpack8(*(const u32x4*)(base + (size_t)row * 1024 + u.pn * 256 + bj * 128 + c8), f);
                        x[m][bj][0] = (f32x4){f[0], f[1], f[2], f[3]}; x[m][bj][1] = (f32x4){f[4], f[5], f[6], f[7]}; } }
#pragma unroll
                for (int m = 0; m < 2; ++m) { const int row = u.pm * 256 + ai * 128 + wr * 64 + (m0 + m) * 16 + fr; float ss = 0.f;
#pragma unroll
                    for (int bj = 0; bj < 2; ++bj)
#pragma unroll
                        for (int n = 0; n < 2; ++n) { f32x4 v = acc[ai][bj][m0 + m][n] + x[m][bj][n]; acc[ai][bj][m0 + m][n] = v; ss += (v[0] * v[0] + v[1] * v[1]) + (v[2] * v[2] + v[3] * v[3]); }
                    ss += shfl_xor_(ss, 16); ss += shfl_xor_(ss, 32);
                    if (fq == 0) atomicAdd(ssq + row, ss); }
            }
        xcd_barrier(*bar, wave);
        f32x4 gg[2][2];
#pragma unroll
        for (int bj = 0; bj < 2; ++bj) { const float* gp = fing + u.pn * 256 + bj * 128 + c8; gg[bj][0] = *(const f32x4*)gp; gg[bj][1] = *(const f32x4*)(gp + 4); }
#pragma unroll
        for (int ai = 0; ai < 2; ++ai)
#pragma unroll
            for (int m = 0; m < 4; ++m) { const int row = u.pm * 256 + ai * 128 + wr * 64 + m * 16 + fr;
                const float rs = rsqrtf(__hip_atomic_load(ssq + row, __ATOMIC_RELAXED, __HIP_MEMORY_SCOPE_AGENT) * (1.f / 1024.f) + EPS);
#pragma unroll
                for (int bj = 0; bj < 2; ++bj) { float* op = out + (size_t)row * 1024 + u.pn * 256 + bj * 128 + c8;
                    *(f32x4*)op = acc[ai][bj][m][0] * rs * gg[bj][0]; *(f32x4*)(op + 4) = acc[ai][bj][m][1] * rs * gg[bj][1]; } }
    }
};

DEVI void tr_item(const float* W, int ldw, int K, bf16_t* WT, int dst_row, const float* scale, int slim, LAS float* scr, int k0, int n_src0, int lane) {
    float wv[32];
#pragma unroll
    for (int i = 0; i < 32; ++i) wv[i] = W[(size_t)(k0 + 2 * i + (lane >> 5)) * ldw + n_src0 + (lane & 31)];
    if (scale) {
#pragma unroll
        for (int i = 0; i < 32; ++i) { const int k = k0 + 2 * i + (lane >> 5); const float sv = scale[k < slim ? k : slim - 1]; wv[i] *= (k < slim) ? sv : 1.f; }
    }
#pragma unroll
    for (int i = 0; i < 32; ++i) scr[(2 * i + (lane >> 5)) * 33 + (lane & 31)] = wv[i];
    LDS_WAIT();
    const int c = lane & 7;
#pragma unroll
    for (int j = 0; j < 4; ++j) { const int n = (lane >> 3) + 8 * j; const LAS float* s = scr + (8 * c) * 33 + n;
        u32x4 o; o.x = cvt_pk(s[0 * 33], s[1 * 33]); o.y = cvt_pk(s[2 * 33], s[3 * 33]); o.z = cvt_pk(s[4 * 33], s[5 * 33]); o.w = cvt_pk(s[6 * 33], s[7 * 33]);
        *(u32x4*)(WT + (size_t)(dst_row + n) * K + k0 + 8 * c) = o; }
    LDS_WAIT();
}
DEVI void p0_prologue(const Args& a, LAS unsigned char* L, int tid, int lane, int wave) {
    unsigned char* ws = a.ws;
    const int G = gridDim.x, gw = blockIdx.x * 8 + wave, NGW = G * 8, gt = blockIdx.x * 512 + tid, NT = G * 512;
    for (int i = gt; i < (int)(WS_ZERO_END / 16); i += NT) ((u32x4*)ws)[i] = (u32x4){0u, 0u, 0u, 0u};
    LAS float* scr = (LAS float*)(L + wave * 8448);
    constexpr int J0 = 16 * 80, J1 = 16 * 32, J5 = 512, J6 = 512;
    for (int it = gw; it < J0 + J1 + J5 + J6; it += NGW) {
        int r = it;
        if (r < J0) { tr_item(a.in[I_WIN], WIN_LD, 1024, (bf16_t*)(ws + WS_WT_IN), (r % 80) * 32, nullptr, 0, scr, (r / 80) * 64, (r % 80) * 32, lane); continue; } r -= J0;
        if (r < J1) { tr_item(a.in[I_WIN], WIN_LD, 1024, (bf16_t*)(ws + WS_WT_IN), 2560 + (r % 32) * 32, nullptr, 0, scr, (r / 32) * 64, 2576 + (r % 32) * 32, lane); continue; } r -= J1;
        if (r < J5) { tr_item(a.in[I_WXK], 1024, 1024, (bf16_t*)(ws + WS_WT_KV), (r % 32) * 32, nullptr, 0, scr, (r / 32) * 64, (r % 32) * 32, lane); continue; } r -= J5;
        tr_item(a.in[I_WXV], 1024, 1024, (bf16_t*)(ws + WS_WT_KV), 1024 + (r % 32) * 32, nullptr, 0, scr, (r / 32) * 64, (r % 32) * 32, lane);
    }
    { const float* mp = a.in[I_MEM]; bf16_t* mb = (bf16_t*)(ws + WS_MEMB);
      for (int i = gt; i < 2048 * 1024 / 8; i += NT) { const f32x4 v0 = *(const f32x4*)(mp + (size_t)i * 8), v1 = *(const f32x4*)(mp + (size_t)i * 8 + 4); *(u32x4*)(mb + (size_t)i * 8) = pack8(v0, v1); } }
    { const float* sc = a.in[I_SCONV]; float* cs = a.out + O_CONVS;
      for (int i = gt; i < TS * 2 * CONVD / 4; i += NT) { const int e = i * 4, b = e / (2 * CONVD), rem = e % (2 * CONVD), r = rem / CONVD, c = rem % CONVD;
          *(f32x4*)(cs + ((size_t)b * 3 + r) * CONVD + c) = *(const f32x4*)(sc + ((size_t)b * 3 + r + 1) * CONVD + c); } }
    __syncthreads();
    LAS float* slab = (LAS float*)L;
    for (int i = tid; i < 1024 * 4; i += 512) { const int k = i >> 2, c4 = (i & 3) * 4; *(LAS f32x4*)(slab + k * 20 + c4) = *(const f32x4*)(a.in[I_WIN] + (size_t)k * WIN_LD + 2560 + c4); }
    __syncthreads();
    bf16_t* hb = (bf16_t*)(ws + WS_HB); float* dtraw = (float*)(ws + WS_DTRAW);
    float g1[16];
#pragma unroll
    for (int j = 0; j < 16; ++j) g1[j] = a.in[I_LN1][lane + 64 * j];
    float xn[16];
#pragma unroll
    for (int j = 0; j < 16; ++j) xn[j] = 0.f;
    if (gw < TP + TS) { const float* src = gw < TP ? a.in[I_XP] + (size_t)gw * 1024 : a.in[I_XS] + (size_t)(gw - TP) * 1024;
#pragma unroll
        for (int j = 0; j < 16; ++j) xn[j] = src[lane + 64 * j]; }
    for (int row = gw; row < TALL; row += NGW) {
        if (row >= TP + TS) {
#pragma unroll
            for (int j = 0; j < 16; ++j) hb[(size_t)row * 1024 + lane + 64 * j] = 0;
            if (lane < 16) dtraw[(size_t)row * 16 + lane] = 0.f;
            continue;
        }
        float x[16]; float ss = 0.f;
#pragma unroll
        for (int j = 0; j < 16; ++j) { x[j] = xn[j]; ss += x[j] * x[j]; }
        { const int nr = row + NGW;
          if (nr < TP + TS) { const float* src = nr < TP ? a.in[I_XP] + (size_t)nr * 1024 : a.in[I_XS] + (size_t)(nr - TP) * 1024;
#pragma unroll
              for (int j = 0; j < 16; ++j) xn[j] = src[lane + 64 * j]; } }
        const float rstd = rsqrtf(wave_sum(ss) * (1.f / 1024.f) + EPS);
        float acc[16];
#pragma unroll
        for (int e = 0; e < 16; ++e) acc[e] = 0.f;
#pragma unroll
        for (int j = 0; j < 16; ++j) {
            const float h = x[j] * rstd * g1[j];
            hb[(size_t)row * 1024 + lane + 64 * j] = f2bf(h);
            const LAS float* wrow = slab + (lane + 64 * j) * 20;
#pragma unroll
            for (int q = 0; q < 4; ++q) { const f32x4 w = *(const LAS f32x4*)(wrow + 4 * q);
                acc[4 * q] += h * w[0]; acc[4 * q + 1] += h * w[1]; acc[4 * q + 2] += h * w[2]; acc[4 * q + 3] += h * w[3]; }
        }
        float outv = 0.f;
#pragma unroll
        for (int e = 0; e < 16; ++e) { const float s = wave_sum(acc[e]); if (lane == e) outv = s; }
        if (lane < 16) dtraw[(size_t)row * 16 + lane] = outv;
    }
}

DEVI void p3_weights(const Args& a, LAS unsigned char* L, int lane, int wave) {
    unsigned char* ws = a.ws; const int gw = blockIdx.x * 8 + wave, NGW = gridDim.x * 8;
    LAS float* scr = (LAS float*)(L + wave * 8448);
    constexpr int J2 = 512, J3 = 32 * 32, J4 = 512, J7 = 512, J8 = 16 * 88, J9 = 16 * 88, J10 = 44 * 32;
    for (int it = gw; it < J2 + J3 + J4 + J7 + J8 + J9 + J10; it += NGW) {
        int r = it;
        if (r < J2) { tr_item(a.in[I_WGLU], 1024, 1024, (bf16_t*)(ws + WS_WT_GLU), (r % 32) * 32, nullptr, 0, scr, (r / 32) * 64, (r % 32) * 32, lane); continue; } r -= J2;
        if (r < J3) { tr_item(a.in[I_WOUT], 1024, 2048, (bf16_t*)(ws + WS_WT_OUT), (r % 32) * 32, a.in[I_GN], 1024, scr, (r / 32) * 64, (r % 32) * 32, lane); continue; } r -= J3;
        if (r < J4) { tr_item(a.in[I_WXQ], 1024, 1024, (bf16_t*)(ws + WS_WT_XQ), (r % 32) * 32, a.in[I_LN2], 1024, scr, (r / 32) * 64, (r % 32) * 32, lane); continue; } r -= J4;
        if (r < J7) { tr_item(a.in[I_WXO], 1024, 1024, (bf16_t*)(ws + WS_WT_XO), (r % 32) * 32, nullptr, 0, scr, (r / 32) * 64, (r % 32) * 32, lane); continue; } r -= J7;
        if (r < J8) { const int n0 = (r % 88) * 32; tr_item(a.in[I_WGATE], DFF, 1024, (bf16_t*)(ws + WS_WT_GU), (n0 >> 7) * 256 + (n0 & 127), a.in[I_LN3], 1024, scr, (r / 88) * 64, n0, lane); continue; } r -= J8;
        if (r < J9) { const int n0 = (r % 88) * 32; tr_item(a.in[I_WUP], DFF, 1024, (bf16_t*)(ws + WS_WT_GU), (n0 >> 7) * 256 + 128 + (n0 & 127), a.in[I_LN3], 1024, scr, (r / 88) * 64, n0, lane); continue; } r -= J9;
        tr_item(a.in[I_WDOWN], 1024, DFF, (bf16_t*)(ws + WS_WT_DOWN), (r % 32) * 32, nullptr, 0, scr, (r / 32) * 64, (r % 32) * 32, lane);
    }
}

struct ConvW { float w[4][8]; float b[8]; };
DEVI void convw_load(ConvW& cw, const float* conv_w, const float* conv_b, int ch) {
#pragma unroll
    for (int w = 0; w < 4; ++w) { const f32x4 p = *(const f32x4*)(conv_w + w * CONVD + ch), q = *(const f32x4*)(conv_w + w * CONVD + ch + 4);
#pragma unroll
        for (int j = 0; j < 4; ++j) { cw.w[w][j] = p[j]; cw.w[w][4 + j] = q[j]; } }
    const f32x4 p = *(const f32x4*)(conv_b + ch), q = *(const f32x4*)(conv_b + ch + 4);
#pragma unroll
    for (int j = 0; j < 4; ++j) { cw.b[j] = p[j]; cw.b[4 + j] = q[j]; }
}
DEVI void conv8_prompt(const ConvW& cw, const bf16_t* proj, int row, int t, int ch, float* o) {
    u32x4 raw[4];
#pragma unroll
    for (int w = 0; w < 4; ++w) { const int d = (t - 3 + w >= 0) ? (3 - w) : 0;
        raw[w] = *(const u32x4*)(proj + (size_t)(row - d) * NPROJ + 1024 + ch); }
#pragma unroll
    for (int j = 0; j < 8; ++j) o[j] = cw.b[j];
#pragma unroll
    for (int w = 0; w < 4; ++w) { float x[8]; unpack8(raw[w], x); const float m = (t - 3 + w >= 0) ? 1.f : 0.f;
#pragma unroll
        for (int j = 0; j < 8; ++j) o[j] += (x[j] * m) * cw.w[w][j]; }
#pragma unroll
    for (int j = 0; j < 8; ++j) o[j] = silu_(o[j]);
}
DEVI void ssd_dt_acum(const Args& a, LAS float* acum, LAS float* dtv, int row0, int g, int wave, int lane) {
    const int h = g * 8 + wave; const float* dtraw = (const float*)(a.ws + WS_DTRAW);
    const float A = -expf(a.in[I_ALOG][h]), bias = a.in[I_DTB][h];
    const float d0 = softplus_(dtraw[(size_t)(row0 + 2 * lane) * 16 + h] + bias), d1 = softplus_(dtraw[(size_t)(row0 + 2 * lane + 1) * 16 + h] + bias);
    const float v0 = d0 * A, v1 = v0 + d1 * A;
    float s = v1;
#pragma unroll
    for (int o = 1; o < 64; o <<= 1) { const float t = shfl_up_(s, o); if (lane >= o) s += t; }
    const float ex = s - v1;
    acum[wave * 128 + 2 * lane] = ex + v0; acum[wave * 128 + 2 * lane + 1] = ex + v1;
    dtv[wave * 128 + 2 * lane] = d0; dtv[wave * 128 + 2 * lane + 1] = d1;
}
constexpr int TLD = 136;
DEVI int swz(int r, int j) { return r * TLD + (j ^ (((r >> 3) & 15) << 3)); }
DEVI int swzb(int r, int kb) { return r * TLD + ((kb ^ ((r >> 3) & 15)) << 3); }

DEVI void ssd_pass1(const Args& a, LAS unsigned char* L, int unit, int tid, int lane, int wave) {
    const int g = unit & 1, c = (unit >> 1) & 15, b = unit >> 5, row0 = b * 2048 + c * 128, t0 = c * 128;
    LAS float* acum = (LAS float*)L; LAS float* dtv = (LAS float*)(L + 4096);
    LAS bf16_t* BT = (LAS bf16_t*)(L + 8192); LAS bf16_t* XW = (LAS bf16_t*)(L + 8192 + 128 * TLD * 2 + wave * (32 * TLD * 2));
    const bf16_t* proj = (const bf16_t*)(a.ws + WS_PROJ); float* cs = (float*)(a.ws + WS_CS);
    ssd_dt_acum(a, acum, dtv, row0, g, wave, lane);
    { const int cgi = tid >> 5, tl = tid & 31, n0 = 8 * cgi; ConvW cw; convw_load(cw, a.in[I_CONVW], a.in[I_CONVB], 1024 + g * 128 + n0);
#pragma unroll
      for (int i = 0; i < 4; ++i) { const int j = tl + 32 * i; float v[8]; conv8_prompt(cw, proj, row0 + j, t0 + j, 1024 + g * 128 + n0, v);
#pragma unroll
          for (int q = 0; q < 8; ++q) BT[swz(n0 + q, j)] = f2bf(v[q]); } }
    __syncthreads();
    const int r = lane & 15, q4 = lane >> 4, e = wave, h = g * 8 + e;
    const float aend = acum[e * 128 + 127];
    float* dst = cs + ((size_t)((b * 16 + c) * 16 + h) * 64) * 128;
    for (int half = 0; half < 2; ++half) {
        { const int cgi = lane & 3, tl = lane >> 2, p0 = 32 * half + 8 * cgi; ConvW cw; convw_load(cw, a.in[I_CONVW], a.in[I_CONVB], h * 64 + p0);
#pragma unroll 4
          for (int tb = 0; tb < 8; ++tb) { const int j = 16 * tb + tl; float v[8]; conv8_prompt(cw, proj, row0 + j, t0 + j, h * 64 + p0, v);
              const float sc = dtv[e * 128 + j] * __expf(aend - acum[e * 128 + j]);
#pragma unroll
              for (int q = 0; q < 8; ++q) XW[swz(8 * cgi + q, j)] = f2bf(v[q] * sc); } }
        LDS_WAIT();
        f32x4 acc[2][8];
#pragma unroll
        for (int pt = 0; pt < 2; ++pt)
#pragma unroll
            for (int t = 0; t < 8; ++t) acc[pt][t] = (f32x4){0.f, 0.f, 0.f, 0.f};
#pragma unroll
        for (int ks = 0; ks < 4; ++ks) {
            const bf16x8 fa0 = *(const LAS bf16x8*)(XW + swzb(r, 4 * ks + q4)), fa1 = *(const LAS bf16x8*)(XW + swzb(16 + r, 4 * ks + q4));
#pragma unroll
            for (int t = 0; t < 8; ++t) { const bf16x8 fb = *(const LAS bf16x8*)(BT + swzb(16 * t + r, 4 * ks + q4));
                acc[0][t] = __builtin_amdgcn_mfma_f32_16x16x32_bf16(fa0, fb, acc[0][t], 0, 0, 0);
                acc[1][t] = __builtin_amdgcn_mfma_f32_16x16x32_bf16(fa1, fb, acc[1][t], 0, 0, 0); }
        }
#pragma unroll
        for (int pt = 0; pt < 2; ++pt)
#pragma unroll
            for (int t = 0; t < 8; ++t)
#pragma unroll
                for (int k = 0; k < 4; ++k) dst[(size_t)(32 * half + 16 * pt + 4 * q4 + k) * 128 + 16 * t + r] = acc[pt][t][k];
        LDS_WAIT();
    }
    if (lane == 0) ((float*)(a.ws + WS_DECAY))[(b * 16 + c) * 16 + h] = __expf(aend);
    __syncthreads();
}

DEVI void ssd_pass3(const Args& a, LAS unsigned char* L, int unit, int tid, int lane, int wave) {
    const int g = unit & 1, c = (unit >> 1) & 15, b = unit >> 5, row0 = b * 2048 + c * 128, t0 = c * 128;
    LAS float* acum = (LAS float*)L; LAS float* dtv = (LAS float*)(L + 4096);
    LAS bf16_t* CT = (LAS bf16_t*)(L + 8192); LAS bf16_t* BMt = (LAS bf16_t*)(L + 8192 + 34816); LAS bf16_t* XT = (LAS bf16_t*)(L + 8192 + 2 * 34816);
    LAS float* cwL = (LAS float*)(L + 8192 + 2 * 34816 + 17408);
    LAS bf16_t* MW = CT + wave * 16 * TLD;
    const bf16_t* proj = (const bf16_t*)(a.ws + WS_PROJ); const bf16_t* sin_ = (const bf16_t*)(a.ws + WS_SIN);
    bf16_t* cat = (bf16_t*)(a.ws + WS_CAT); float* ssq = (float*)(a.ws + WS_SSQ_SSD);
    const int xcg = tid >> 6, xtl = tid & 63, p0 = 8 * xcg;
    u32x4 rx[2][4], rz[2];
#define P3_LOAD_RAW(hh) do { _Pragma("unroll") for (int i_ = 0; i_ < 2; ++i_) { const int j_ = xtl + 64 * i_; \
        _Pragma("unroll") for (int w_ = 0; w_ < 4; ++w_) { const int d_ = (t0 + j_ - 3 + w_ >= 0) ? (3 - w_) : 0; \
            rx[i_][w_] = *(const u32x4*)(proj + (size_t)(row0 + j_ - d_) * NPROJ + 1024 + (hh) * 64 + p0); } \
        rz[i_] = *(const u32x4*)(proj + (size_t)(row0 + j_) * NPROJ + (hh) * 64 + p0); } } while (0)
    ssd_dt_acum(a, acum, dtv, row0, g, wave, lane);
    for (int i = tid; i < 640; i += 512) { const int w = i >> 7, c4 = (i & 127) * 4;
        *(LAS f32x4*)(cwL + w * 512 + c4) = *(const f32x4*)((w < 4 ? a.in[I_CONVW] + w * CONVD : a.in[I_CONVB]) + g * 512 + c4); }
    { const int cgi = tid & 15, tl = tid >> 4, n0 = 8 * cgi;
#pragma unroll
      for (int mat = 0; mat < 2; ++mat) { const int ch = 1024 + mat * 256 + g * 128 + n0; ConvW cw; convw_load(cw, a.in[I_CONVW], a.in[I_CONVB], ch);
          LAS bf16_t* dstm = mat ? CT : BMt;
#pragma unroll
          for (int i = 0; i < 4; ++i) { const int j = tl + 32 * i; float v[8]; conv8_prompt(cw, proj, row0 + j, t0 + j, ch, v);
              u32x4 w; w.x = cvt_pk(v[0], v[1]); w.y = cvt_pk(v[2], v[3]); w.z = cvt_pk(v[4], v[5]); w.w = cvt_pk(v[6], v[7]);
              *(LAS u32x4*)(dstm + j * TLD + n0) = w; } } }
    __syncthreads();
    const int r = lane & 15, q4 = lane >> 4;
    bf16x8 aC[4]; f32x4 cb[8];
#pragma unroll
    for (int ks = 0; ks < 4; ++ks) aC[ks] = *(const LAS bf16x8*)(CT + (16 * wave + r) * TLD + 32 * ks + 8 * q4);
#pragma unroll
    for (int t = 0; t < 8; ++t) { cb[t] = (f32x4){0.f, 0.f, 0.f, 0.f};
#pragma unroll
        for (int ks = 0; ks < 4; ++ks) { const bf16x8 fb = *(const LAS bf16x8*)(BMt + (16 * t + r) * TLD + 32 * ks + 8 * q4);
            cb[t] = __builtin_amdgcn_mfma_f32_16x16x32_bf16(aC[ks], fb, cb[t], 0, 0, 0); } }
    float ssacc[4] = {0.f, 0.f, 0.f, 0.f};
    __syncthreads();
    LAS bf16_t* const XT0 = XT; LAS bf16_t* const XT1 = (LAS bf16_t*)(L + 105472);
    LAS bf16_t* const ZT0 = BMt; LAS bf16_t* const ZT1 = (LAS bf16_t*)(L + 122880);
    P3_LOAD_RAW(g * 8);
    for (int e = 0; e < 8; ++e) {
        const int h = g * 8 + e;
        XT = (e & 1) ? XT1 : XT0; LAS bf16_t* const ZT = (e & 1) ? ZT1 : ZT0;
        {
            f32x4 wl[4][2];
#pragma unroll
            for (int w = 0; w < 4; ++w) { wl[w][0] = *(const LAS f32x4*)(cwL + w * 512 + e * 64 + p0); wl[w][1] = *(const LAS f32x4*)(cwL + w * 512 + e * 64 + p0 + 4); }
            const f32x4 bl0 = *(const LAS f32x4*)(cwL + 2048 + e * 64 + p0), bl1 = *(const LAS f32x4*)(cwL + 2048 + e * 64 + p0 + 4);
#pragma unroll
            for (int i = 0; i < 2; ++i) { const int j = xtl + 64 * i; float o[8];
#pragma unroll
                for (int q = 0; q < 4; ++q) { o[q] = bl0[q]; o[4 + q] = bl1[q]; }
#pragma unroll
                for (int w = 0; w < 4; ++w) { float x[8]; unpack8(rx[i][w], x); const float m = (t0 + j - 3 + w >= 0) ? 1.f : 0.f;
#pragma unroll
                    for (int q = 0; q < 4; ++q) { o[q] += (x[q] * m) * wl[w][0][q]; o[4 + q] += (x[4 + q] * m) * wl[w][1][q]; } }
                *(LAS u32x4*)(ZT + j * 64 + p0) = rz[i];
#pragma unroll
                for (int q = 0; q < 8; ++q) XT[swz(p0 + q, j)] = f2bf(silu_(o[q])); }
        }
        if (e < 7) P3_LOAD_RAW(h + 1);
        __syncthreads();
        float ai[4];
#pragma unroll
        for (int k = 0; k < 4; ++k) ai[k] = acum[e * 128 + 16 * wave + 4 * q4 + k];
#pragma unroll
        for (int t = 0; t < 8; ++t) { const int j = 16 * t + r; const float aj = acum[e * 128 + j], dj = dtv[e * 128 + j];
#pragma unroll
            for (int k = 0; k < 4; ++k) { const int i = 16 * wave + 4 * q4 + k; const float m = (j <= i) ? cb[t][k] * __expf(ai[k] - aj) * dj : 0.f;
                MW[(4 * q4 + k) * TLD + j] = f2bf(m); } }
        LDS_WAIT();
        f32x4 acc[4], acc2[4];
#pragma unroll
        for (int pt = 0; pt < 4; ++pt) { acc[pt] = (f32x4){0.f, 0.f, 0.f, 0.f}; acc2[pt] = (f32x4){0.f, 0.f, 0.f, 0.f}; }
        if (c > 0) {
            const bf16_t* sp = sin_ + ((size_t)((b * 16 + c) * 16 + h) * 64) * 128;
#pragma unroll
            for (int ks = 0; ks < 4; ++ks)
#pragma unroll
                for (int pt = 0; pt < 4; ++pt) { const bf16x8 fs = *(const bf16x8*)(sp + (size_t)(16 * pt + r) * 128 + 32 * ks + 8 * q4);
                    acc2[pt] = __builtin_amdgcn_mfma_f32_16x16x32_bf16(aC[ks], fs, acc2[pt], 0, 0, 0); }
        }
#pragma unroll
        for (int ks = 0; ks < 4; ++ks) {
            const bf16x8 fm = *(const LAS bf16x8*)(MW + r * TLD + 32 * ks + 8 * q4);
#pragma unroll
            for (int pt = 0; pt < 4; ++pt) { const bf16x8 fx = *(const LAS bf16x8*)(XT + swzb(16 * pt + r, 4 * ks + q4));
                acc[pt] = __builtin_amdgcn_mfma_f32_16x16x32_bf16(fm, fx, acc[pt], 0, 0, 0); }
        }
        const float Dh = a.in[I_DSSD][h];
#pragma unroll
        for (int k = 0; k < 4; ++k) {
            const int i = 16 * wave + 4 * q4 + k; const float ea = __expf(ai[k]);
#pragma unroll
            for (int pt = 0; pt < 4; ++pt) {
                const int p = 16 * pt + r;
                const float xv = bf2f(XT[swz(p, i)]);
                const float y = acc[pt][k] + ea * acc2[pt][k] + Dh * xv;
                const float z = bf2f(ZT[i * 64 + p]);
                const float yz = y * silu_(z);
                cat[(size_t)(row0 + i) * 2048 + h * 64 + p] = f2bf(yz);
                ssacc[k] += yz * yz;
            }
        }
    }
#undef P3_LOAD_RAW
#pragma unroll
    for (int k = 0; k < 4; ++k) { float s = ssacc[k]; s += shfl_xor_(s, 1); s += shfl_xor_(s, 2); s += shfl_xor_(s, 4); s += shfl_xor_(s, 8);
        if (r == 0) atomicAdd(ssq + row0 + 16 * wave + 4 * q4 + k, s); }
    __syncthreads();
}

DEVI void ssd_step(const Args& a, LAS unsigned char* L, int unit, int tid, int lane) {
    const int g = unit & 1, b = unit >> 1, row = TP + b;
    LAS float* xs = (LAS float*)L; LAS float* Bv = xs + 512; LAS float* Cv = Bv + 128; LAS float* zs = Cv + 128; LAS float* sc = zs + 512;
    const bf16_t* proj = (const bf16_t*)(a.ws + WS_PROJ);
    const int n4 = (tid & 31) * 4, pr = tid >> 5;
    const float* s0p = a.in[I_SSSM] + ((size_t)(b * 16 + g * 8) * 64) * 128; float* s1p = a.out + O_SSMS + ((size_t)(b * 16 + g * 8) * 64) * 128;
    f32x4 s0[4];
#pragma unroll
    for (int it = 0; it < 4; ++it) s0[it] = __builtin_nontemporal_load((const f32x4*)(s0p + (size_t)(it * 16 + pr) * 128 + n4));
    zs[tid] = bf2f(proj[(size_t)row * NPROJ + g * 512 + tid]);
    if (tid < 96) {
        int ch; LAS float* dst;
        if (tid < 64) { ch = g * 512 + 8 * tid; dst = xs + 8 * tid; } else if (tid < 80) { ch = 1024 + g * 128 + 8 * (tid - 64); dst = Bv + 8 * (tid - 64); } else { ch = 1280 + g * 128 + 8 * (tid - 80); dst = Cv + 8 * (tid - 80); }
        ConvW cw; convw_load(cw, a.in[I_CONVW], a.in[I_CONVB], ch);
        float o[8]; float xn[8]; unpack8(*(const u32x4*)(proj + (size_t)row * NPROJ + 1024 + ch), xn);
#pragma unroll
        for (int j = 0; j < 8; ++j) o[j] = cw.b[j] + xn[j] * cw.w[3][j];
#pragma unroll
        for (int w = 0; w < 3; ++w) { const float* sp = a.in[I_SCONV] + ((size_t)b * 3 + w) * CONVD + ch; const f32x4 p = *(const f32x4*)sp, q = *(const f32x4*)(sp + 4);
#pragma unroll
            for (int j = 0; j < 4; ++j) { o[j] += p[j] * cw.w[w][j]; o[4 + j] += q[j] * cw.w[w][4 + j]; } }
#pragma unroll
        for (int j = 0; j < 8; ++j) dst[j] = silu_(o[j]);
    }
    if (tid >= 128 && tid < 136) { const int h = g * 8 + tid - 128; const float dt = softplus_(((const float*)(a.ws + WS_DTRAW))[(size_t)row * 16 + h] + a.in[I_DTB][h]);
        sc[tid - 128] = dt; sc[8 + tid - 128] = expf(-expf(a.in[I_ALOG][h]) * dt); }
    __syncthreads();
    const f32x4 bv = *(const LAS f32x4*)(Bv + n4), cv = *(const LAS f32x4*)(Cv + n4);
    bf16_t* cat = (bf16_t*)(a.ws + WS_CAT); float* ssq = (float*)(a.ws + WS_SSQ_SSD);
    float ssl = 0.f;
    for (int e = 0; e < 8; ++e) {
        const int h = g * 8 + e; const float dt = sc[e], dA = sc[8 + e], Dh = a.in[I_DSSD][h];
        f32x4 sn[4];
#pragma unroll
        for (int it = 0; it < 4; ++it) sn[it] = s0[it] * dA + bv * (dt * xs[e * 64 + it * 16 + pr]);
        if (e < 7) {
#pragma unroll
            for (int it = 0; it < 4; ++it) s0[it] = __builtin_nontemporal_load((const f32x4*)(s0p + (size_t)((e + 1) * 64 + it * 16 + pr) * 128 + n4));
        }
#pragma unroll
        for (int it = 0; it < 4; ++it) {
            const int p = it * 16 + pr;
            __builtin_nontemporal_store(sn[it], (f32x4*)(s1p + (size_t)(e * 64 + p) * 128 + n4));
            float part = (cv[0] * sn[it][0] + cv[1] * sn[it][1]) + (cv[2] * sn[it][2] + cv[3] * sn[it][3]);
            part += shfl_xor_(part, 1); part += shfl_xor_(part, 2); part += shfl_xor_(part, 4); part += shfl_xor_(part, 8); part += shfl_xor_(part, 16);
            if ((tid & 31) == 0) {
                const float y = part + Dh * xs[e * 64 + p]; const float yz = y * silu_(zs[e * 64 + p]);
                cat[(size_t)row * 2048 + h * 64 + p] = f2bf(yz); ssl += yz * yz;
            }
        }
    }
    if ((tid & 31) == 0) sc[16 + pr] = ssl;
    __syncthreads();
    if (tid == 0) { float t = 0.f;
#pragma unroll
        for (int i = 0; i < 16; ++i) t += sc[16 + i];
        atomicAdd(ssq + row, t); }
    __syncthreads();
}

struct S5Setup { float lbr, lbi; bf16x8 fB[8], bC[4], fD; };
template <bool WRITE_Y>
DEVI void s5_setup(const Args& a, S5Setup& st, int g, int lane) {
    const int p = lane, gp = g * 64 + p, r = lane & 15, q4 = lane >> 4;
    const float lr = a.in[I_LAMR][gp], li = a.in[I_LAMI][gp], step = expf(a.in[I_LSTEP][g]);
    const float mag = expf(lr * step); float sn, cs; sincosf(li * step, &sn, &cs);
    const float lbr = mag * cs, lbi = mag * sn; st.lbr = lbr; st.lbi = lbi; const float den = lr * lr + li * li;
    const float kre = ((lbr - 1.f) * lr + lbi * li) / den, kim = (lbi * lr - (lbr - 1.f) * li) / den;
#pragma unroll
    for (int jt = 0; jt < 4; ++jt) {
        const int pp = 16 * jt + r; const float kr = shfl_(kre, pp), ki = shfl_(kim, pp);
        const float* bp = a.in[I_BRE] + (size_t)(g * 64 + pp) * 16 + 8 * (q4 & 1); const float* bq = a.in[I_BIM] + (size_t)(g * 64 + pp) * 16 + 8 * (q4 & 1);
        const f32x4 br0 = *(const f32x4*)bp, br1 = *(const f32x4*)(bp + 4), bi0 = *(const f32x4*)bq, bi1 = *(const f32x4*)(bq + 4);
        u32x4 wr = pack8(br0 * kr - bi0 * ki, br1 * kr - bi1 * ki), wi = pack8(bi0 * kr + br0 * ki, bi1 * kr + br1 * ki);
        if (q4 >= 2) { wr = (u32x4){0u, 0u, 0u, 0u}; wi = (u32x4){0u, 0u, 0u, 0u}; }
        st.fB[jt] = *(const bf16x8*)&wr; st.fB[4 + jt] = *(const bf16x8*)&wi;
    }
    if (WRITE_Y) {
#pragma unroll
        for (int ks = 0; ks < 4; ++ks) { const float* src = (ks < 2 ? a.in[I_CRE] : a.in[I_CIM]) + (size_t)(g * 16 + r) * 64 + 32 * (ks & 1) + 8 * q4;
            f32x4 v0 = *(const f32x4*)src, v1 = *(const f32x4*)(src + 4); if (ks >= 2) { v0 = -v0; v1 = -v1; }
            const u32x4 w = pack8(v0, v1); st.bC[ks] = *(const bf16x8*)&w; }
        const float dv = a.in[I_DS5][g * 16 + r]; f32x4 d0, d1;
#pragma unroll
        for (int j = 0; j < 4; ++j) { d0[j] = (q4 < 2 && 8 * q4 + j == r) ? dv : 0.f; d1[j] = (q4 < 2 && 8 * q4 + 4 + j == r) ? dv : 0.f; }
        const u32x4 w = pack8(d0, d1); st.fD = *(const bf16x8*)&w;
    }
}
template <bool WRITE_Y>
DEVI void s5_unit(const Args& a, const S5Setup& st, LAS unsigned char* Lw, int g, int row0_, int ntok, const float* cin_re_, const float* cin_im_, float* out_re_, float* out_im_, int lane, int nseq, int seq_rows, int seq_state) {
    LAS float* BU = (LAS float*)Lw; LAS bf16_t* SX = (LAS bf16_t*)(Lw + 10240);
    const bf16_t* proj = (const bf16_t*)(a.ws + WS_PROJ); bf16_t* gb = (bf16_t*)(a.ws + WS_GB);
    const int p = lane, r = lane & 15, q4 = lane >> 4;
    const float lbr = st.lbr, lbi = st.lbi;
  for (int sq = 0; sq < nseq; ++sq) {
    const int row0 = row0_ + sq * seq_rows;
    const float* cin_re = cin_re_ ? cin_re_ + (size_t)sq * seq_state : nullptr; const float* cin_im = cin_im_ ? cin_im_ + (size_t)sq * seq_state : nullptr;
    float* out_re = out_re_ ? out_re_ + (size_t)sq * seq_state : nullptr; float* out_im = out_im_ ? out_im_ + (size_t)sq * seq_state : nullptr;
    float sre = cin_re ? cin_re[p] : 0.f, sim = cin_im ? cin_im[p] : 0.f;
    const bf16_t* up = proj + (size_t)(row0 + r) * NPROJ + 2560 + g * 16 + 8 * (q4 & 1);
    u32x4 un = (u32x4){0u, 0u, 0u, 0u};
    if (q4 < 2 && r < ntok) un = *(const u32x4*)up;
    for (int tb = 0; tb < ntok; tb += 16) {
        const int nt = (ntok - tb) < 16 ? (ntok - tb) : 16;
        const u32x4 uc = un; const bf16x8 fu = *(const bf16x8*)&uc;
        un = (u32x4){0u, 0u, 0u, 0u};
        if (q4 < 2 && tb + 16 + r < ntok) un = *(const u32x4*)(up + (size_t)(tb + 16) * NPROJ);
#pragma unroll
        for (int j = 0; j < 8; ++j) { const f32x4 d = __builtin_amdgcn_mfma_f32_16x16x32_bf16(fu, st.fB[j], (f32x4){0.f, 0.f, 0.f, 0.f}, 0, 0, 0);
            *(LAS f32x4*)(BU + (64 * (j >> 2) + 16 * (j & 3) + r) * 20 + 4 * q4) = d; }
        LDS_WAIT();
        float bur[16], bui[16];
#pragma unroll
        for (int i = 0; i < 4; ++i) { const f32x4 vr = *(const LAS f32x4*)(BU + p * 20 + 4 * i), vi = *(const LAS f32x4*)(BU + (64 + p) * 20 + 4 * i);
#pragma unroll
            for (int k = 0; k < 4; ++k) { bur[4 * i + k] = vr[k]; bui[4 * i + k] = vi[k]; } }
#pragma unroll
        for (int tl = 0; tl < 16; ++tl) {
            if (tl < nt) {
                const float nr = lbr * sre - lbi * sim + bur[tl], ni = lbr * sim + lbi * sre + bui[tl];
                sre = nr; sim = ni;
                if (WRITE_Y) { SX[tl * TLD + p] = f2bf(sre); SX[tl * TLD + 64 + p] = f2bf(sim); }
            }
        }
        if (WRITE_Y) {
            LDS_WAIT();
            f32x4 acc = __builtin_amdgcn_mfma_f32_16x16x32_bf16(fu, st.fD, (f32x4){0.f, 0.f, 0.f, 0.f}, 0, 0, 0);
#pragma unroll
            for (int ks = 0; ks < 4; ++ks) { const bf16x8 fa = *(const LAS bf16x8*)(SX + r * TLD + 32 * ks + 8 * q4); acc = __builtin_amdgcn_mfma_f32_16x16x32_bf16(fa, st.bC[ks], acc, 0, 0, 0); }
#pragma unroll
            for (int k = 0; k < 4; ++k) { const int tl = 4 * q4 + k;
                if (tl < nt) gb[(size_t)(row0 + tb + tl) * 1024 + g * 16 + r] = f2bf(gelu_(acc[k])); }
        }
        LDS_WAIT();
    }
    if (out_re) { out_re[p] = sre; out_im[p] = sim; }
  }
}

DEVI void attn_sample(const Args& a, LAS unsigned char* L, int unit, int tid, int lane, int wave) {
    const int h = unit & 3, b = unit >> 2, row = TP + b;
    LAS float* qs = (LAS float*)L; LAS float* sc = qs + 256; LAS float* red = sc + 256;
    const bf16_t* qb = (const bf16_t*)(a.ws + WS_QB); bf16_t* ob = (bf16_t*)(a.ws + WS_OB);
    const float* kp = a.in[I_CK] + ((size_t)(b * 256 + wave * 32) * 4 + h) * 256 + 4 * lane;
    const float* vp = a.in[I_CV] + ((size_t)(b * 256 + wave * 32) * 4 + h) * 256 + 4 * lane;
    f32x4 kv[32];
#pragma unroll
    for (int i = 0; i < 32; ++i) kv[i] = __builtin_nontemporal_load((const f32x4*)(kp + (size_t)i * 1024));
    if (tid < 256) qs[tid] = bf2f(qb[(size_t)row * 1024 + h * 256 + tid]);
    __syncthreads();
    const f32x4 q = *(const LAS f32x4*)(qs + 4 * lane);
    float myd = 0.f;
#pragma unroll
    for (int i = 0; i < 32; ++i) { const float d = wave_sum((kv[i][0] * q[0] + kv[i][1] * q[1]) + (kv[i][2] * q[2] + kv[i][3] * q[3])); if (lane == i) myd = d; }
    if (lane < 32) sc[wave * 32 + lane] = myd;
#pragma unroll
    for (int i = 0; i < 32; ++i) kv[i] = __builtin_nontemporal_load((const f32x4*)(vp + (size_t)i * 1024));
    __syncthreads();
    const f32x4 s4 = *(const LAS f32x4*)(sc + 4 * lane);
    float mx = fmaxf(fmaxf(s4[0], s4[1]), fmaxf(s4[2], s4[3]));
#pragma unroll
    for (int o = 1; o < 64; o <<= 1) mx = fmaxf(mx, shfl_xor_(mx, o));
    const float inv = 1.f / wave_sum((__expf(s4[0] - mx) + __expf(s4[1] - mx)) + (__expf(s4[2] - mx) + __expf(s4[3] - mx)));
    f32x4 acc = (f32x4){0.f, 0.f, 0.f, 0.f};
#pragma unroll
    for (int i = 0; i < 32; ++i) { const float pm = __expf(sc[wave * 32 + i] - mx) * inv; acc += kv[i] * pm; }
    *(LAS f32x4*)(red + wave * 256 + 4 * lane) = acc;
    __syncthreads();
    if (tid < 256) { float o = 0.f;
#pragma unroll
        for (int w = 0; w < 8; ++w) o += red[w * 256 + tid];
        ob[(size_t)row * 1024 + h * 256 + tid] = f2bf(o); }
    __syncthreads();
}

constexpr int NPH = 14;
__global__ void __launch_bounds__(512, 2) hymba_fwd(Args a) {
    extern __shared__ __attribute__((aligned(16))) unsigned char lds_raw[];
    LAS unsigned char* L = (LAS unsigned char*)lds_raw;
    const int wave = __builtin_amdgcn_readfirstlane((int)threadIdx.x >> 6);
#define lane (lane_id_())
#define tid (wave * 64 + lane_id_())
    const int G = gridDim.x, bid = blockIdx.x, gw = bid * 8 + wave, NGW = G * 8, NT = G * 512;
#define gt (bid * 512 + tid)
    unsigned char* ws = a.ws;
    volatile LAS unsigned* MISC = (volatile LAS unsigned*)(L + MISC_OFF);
    if (tid < 32) MISC[tid] = 0u;
    __syncthreads();
    XcdBarrier bar; bar.bar = (unsigned*)(ws + WS_BAR); bar.x = 0; bar.st = nullptr;
    if (a.ph_hi - a.ph_lo > 1) bar = xcd_barrier_post((unsigned*)(ws + WS_BAR), MISC + 8, wave == 0 && lane_id_() == 0);
    if (a.ph_lo < 0) cg::this_grid().sync();
    const int lo = a.ph_lo, hi = a.ph_hi;
#define IN(k) (lo <= (k) && (k) < hi)
#ifndef PROBE_BAR2
#define PROBE_BAR2 0
#endif
#ifndef PROBE_MASK
#define PROBE_MASK 0
#endif
    unsigned long long tph = PROBE_MASK ? __builtin_amdgcn_s_memrealtime() : 0ull;
#ifndef PROBE_SUB
#define PROBE_SUB 0
#endif
    unsigned long long ts0 = 0ull;
#define SUBSPIN(id) do { if (PROBE_SUB == (id)) { __syncthreads(); const unsigned long long t1_ = __builtin_amdgcn_s_memrealtime(), d_ = t1_ - ts0; while (__builtin_amdgcn_s_memrealtime() - t1_ < d_) __builtin_amdgcn_s_sleep(8); } if (PROBE_SUB) ts0 = __builtin_amdgcn_s_memrealtime(); } while (0)
#define SEAM(k) do { if (((PROBE_MASK) >> (k)) & 1) { __syncthreads(); const unsigned long long t1_ = __builtin_amdgcn_s_memrealtime(), d_ = t1_ - tph; \
        while (__builtin_amdgcn_s_memrealtime() - t1_ < d_) __builtin_amdgcn_s_sleep(8); } \
    if (IN(k) && IN((k) + 1)) { xcd_barrier(bar, wave); if (PROBE_BAR2) xcd_barrier(bar, wave); } if (PROBE_MASK) tph = __builtin_amdgcn_s_memrealtime(); } while (0)
    bf16_t* const proj = (bf16_t*)(ws + WS_PROJ);
    float* const x1f = (float*)(ws + WS_X1F);

    if (IN(0)) { p0_prologue(a, L, tid, lane, wave); __syncthreads(); } SEAM(0);

    if (IN(1)) {
        { pg8::Gemm g{(const bf16_t*)(ws + WS_HB), (const bf16_t*)(ws + WS_WT_IN), 1024, 1024, 1024, 0}; pg8::StaticOrder S; S.init(SKN(1) ? 64 : 65, 14, G, bid);
          const FIn fin{proj, a.out + O_CONVP, a.out + O_CONVS}; pg8::EpiRow<FIn> E{fin}; pg8::gemm_phase(L, g, S, E, wave);
          for (int u = G - 1 - bid - 64; SKN(1) && u >= 0 && u < 56; u += G) sgemm_unit((const bf16_t*)(ws + WS_HB) + (size_t)TP * 1024, 1024, (const bf16_t*)(ws + WS_WT_IN), 1024, 1024, u >> 2, u & 3, fin, lane, wave); }
        { pg8::Gemm g{(const bf16_t*)(ws + WS_MEMB), (const bf16_t*)(ws + WS_WT_KV), 1024, 1024, 1024, 0}; pg8::StaticOrder S; S.init(8, 8, G, G - 1 - bid);
          pg8::EpiRow<FKV> E{FKV{a.out + O_MEMK, a.out + O_MEMV, (bf16_t*)(ws + WS_KB), (bf16_t*)(ws + WS_VT)}}; pg8::gemm_phase(L, g, S, E, wave); }
    } SEAM(1);

    if (IN(2)) {
        if (PROBE_SUB) ts0 = __builtin_amdgcn_s_memrealtime();
        for (int u = bid; u < 256; u += G) ssd_pass1(a, L, u, tid, lane, wave);
        SUBSPIN(1);
        for (int u = bid; u < 256; u += G) ssd_step(a, L, u, tid, lane);
        SUBSPIN(2);
        float* er = (float*)(ws + WS_S5END); float* ei = er + 8 * 64 * S5NCH * 64;
        { S5Setup st; int gc = -1;
          for (int u = gw; u < 8 * 64 * S5NCH; u += NGW) { const int g = (u & 7) | (((u >> 6) & 7) << 3), k = (u >> 3) & 7, b = u >> 9;
            const size_t ix = (size_t)((b * 64 + g) * S5NCH + k) * 64;
            if (g != gc) { s5_setup<false>(a, st, g, lane); gc = g; }
            s5_unit<false>(a, st, L + wave * 14592, g, b * 2048 + k * S5LC, S5LC, nullptr, nullptr, er + ix, ei + ix, lane, 1, 0, 0); } }
    } SEAM(2);

    if (IN(3)) {
        p3_weights(a, L, lane, wave);
        const float* cs = (const float*)(ws + WS_CS); const float* dec = (const float*)(ws + WS_DECAY); bf16_t* sin_ = (bf16_t*)(ws + WS_SIN); float* sout = a.out + O_SSMP;
        for (int i = gt; i < 8 * 16 * 64 * 32; i += NT) {
            const int n4 = (i & 31) * 4, p = (i >> 5) & 63, h = (i >> 11) & 15, b = i >> 15;
            f32x4 S = (f32x4){0.f, 0.f, 0.f, 0.f};
            f32x4 cv[16]; float dv[16];
#pragma unroll
            for (int c = 0; c < 16; ++c) { cv[c] = __builtin_nontemporal_load((const f32x4*)(cs + ((size_t)((b * 16 + c) * 16 + h) * 64 + p) * 128 + n4)); dv[c] = dec[(b * 16 + c) * 16 + h]; }
#pragma unroll
            for (int c = 0; c < 16; ++c) { const size_t off = ((size_t)((b * 16 + c) * 16 + h) * 64 + p) * 128 + n4;
                u32x2 w; w.x = cvt_pk(S[0], S[1]); w.y = cvt_pk(S[2], S[3]); *(u32x2*)(sin_ + off) = w;
                S = S * dv[c] + cv[c]; }
            *(f32x4*)(sout + ((size_t)(b * 16 + h) * 64 + p) * 128 + n4) = S;
        }
        const float* er = (const float*)(ws + WS_S5END); const float* ei = er + 8 * 64 * S5NCH * 64; float* cr = (float*)(ws + WS_S5CAR); float* ci = cr + 8 * 64 * S5NCH * 64;
        for (int i = gt; i < 8 * 64 * 64; i += NT) {
            const int p = i & 63, g = (i >> 6) & 63, b = i >> 12, gp = g * 64 + p;
            const float lr = a.in[I_LAMR][gp], li = a.in[I_LAMI][gp], step = expf(a.in[I_LSTEP][g]);
            const float mag = expf(lr * step); float sn, cs_; sincosf(li * step, &sn, &cs_);
            float pr = mag * cs_, pi = mag * sn;
#pragma unroll
            for (int s = 0; s < 8; ++s) { const float nr = pr * pr - pi * pi, ni = 2.f * pr * pi; pr = nr; pi = ni; }
            float c_r = 0.f, c_i = 0.f; float evr[S5NCH], evi[S5NCH];
#pragma unroll
            for (int k = 0; k < S5NCH; ++k) { const size_t off = ((size_t)((b * 64 + g) * S5NCH + k)) * 64 + p; evr[k] = er[off]; evi[k] = ei[off]; }
#pragma unroll
            for (int k = 0; k < S5NCH; ++k) { const size_t off = ((size_t)((b * 64 + g) * S5NCH + k)) * 64 + p;
                cr[off] = c_r; ci[off] = c_i;
                const float nr = pr * c_r - pi * c_i + evr[k], ni = pr * c_i + pi * c_r + evi[k]; c_r = nr; c_i = ni; }
            a.out[O_S5RP + (size_t)(b * 64 + g) * 64 + p] = c_r; a.out[O_S5IP + (size_t)(b * 64 + g) * 64 + p] = c_i;
        }
    } SEAM(3);

    if (IN(4)) {
        if (PROBE_SUB) ts0 = __builtin_amdgcn_s_memrealtime();
        for (int u = bid; u < 256; u += G) ssd_pass3(a, L, u, tid, lane, wave);
        SUBSPIN(4);
        const float* cr = (const float*)(ws + WS_S5CAR); const float* ci = cr + 8 * 64 * S5NCH * 64;
        { S5Setup st; int gc = -1;
          for (int u = gw; u < 8 * 64 * S5NCH + 2048; u += NGW) {
            if (u < 8 * 64 * S5NCH) { const int g = (u & 7) | (((u >> 6) & 7) << 3), k = (u >> 3) & 7, b = u >> 9;
                const size_t ix = (size_t)((b * 64 + g) * S5NCH + k) * 64;
                if (g != gc) { s5_setup<true>(a, st, g, lane); gc = g; }
                s5_unit<true>(a, st, L + wave * 14592, g, b * 2048 + k * S5LC, S5LC, cr + ix, ci + ix, nullptr, nullptr, lane, 1, 0, 0); }
            else { const int v = u - 8 * 64 * S5NCH, g = (v & 7) | (((v >> 6) & 7) << 3), b4 = (((v >> 3) & 7) | ((v >> 9) << 3)) * 4; const size_t so = (size_t)(b4 * 64 + g) * 64;
                if (g != gc) { s5_setup<true>(a, st, g, lane); gc = g; }
                s5_unit<true>(a, st, L + wave * 14592, g, TP + b4, 1, a.in[I_SS5R] + so, a.in[I_SS5I] + so, a.out + O_S5RS + so, a.out + O_S5IS + so, lane, 4, 1, 64 * 64); }
          } }
        __syncthreads();
    } SEAM(4);

    if (IN(5)) {
        pg8::Gemm g{(const bf16_t*)(ws + WS_GB), (const bf16_t*)(ws + WS_WT_GLU), 1024, 1024, 1024, 0}; pg8::StaticOrder S; S.init(SKN(5) ? 64 : 65, 4, G, bid);
        const FGlu fg{(const bf16_t*)(ws + WS_GB), a.in[I_BGLU], (bf16_t*)(ws + WS_CAT), (const float*)(ws + WS_SSQ_SSD)}; pg8::EpiRow<FGlu> E{fg}; pg8::gemm_phase(L, g, S, E, wave);
        if (PROBE_SUB) { __syncthreads(); ts0 = __builtin_amdgcn_s_memrealtime(); }
        for (int u = bid; SKN(5) && u < 128; u += G) sgemm3_unit(L, (const bf16_t*)(ws + WS_GB) + (size_t)TP * 1024, 1024, (const bf16_t*)(ws + WS_WT_GLU), 1024, 1024, u, fg, lane, wave);
        SUBSPIN(5);
    } SEAM(5);

    if (IN(6)) {
        pg8::Gemm g{(const bf16_t*)(ws + WS_CAT), (const bf16_t*)(ws + WS_WT_OUT), 2048, 2048, 2048, 0}; pg8::StaticOrder S; S.init(SKN(6) ? 64 : 65, 4, G, bid);
        const FResT<false> fr{a.in[I_XP], a.in[I_XS], nullptr, nullptr, (bf16_t*)(ws + WS_X1B), (float*)(ws + WS_SSQ1)}; pg8::EpiRow<FResT<false>> E{fr}; pg8::gemm_phase(L, g, S, E, wave, (const float*)(ws + WS_SSQ_SSD));
        if (PROBE_SUB) { __syncthreads(); ts0 = __builtin_amdgcn_s_memrealtime(); }
        for (int u = bid; SKN(6) && u < 128; u += G) sgemm3_unit(L, (const bf16_t*)(ws + WS_CAT) + (size_t)TP * 2048, 2048, (const bf16_t*)(ws + WS_WT_OUT), 2048, 2048, u, fr, lane, wave, (const float*)(ws + WS_SSQ_SSD));
        SUBSPIN(5);
    } SEAM(6);

    if (IN(7)) {
        pg8::Gemm g{(const bf16_t*)(ws + WS_X1B), (const bf16_t*)(ws + WS_WT_XQ), 1024, 1024, 1024, 0}; pg8::StaticOrder S; S.init(SKN(7) ? 64 : 65, 4, G, bid);
        const FQ fq_{(bf16_t*)(ws + WS_QB), (const float*)(ws + WS_SSQ1)}; pg8::EpiRow<FQ> E{fq_}; pg8::gemm_phase(L, g, S, E, wave);
        if (PROBE_SUB) { __syncthreads(); ts0 = __builtin_amdgcn_s_memrealtime(); }
        for (int u = bid; SKN(7) && u < 128; u += G) sgemm3_unit(L, (const bf16_t*)(ws + WS_X1B) + (size_t)TP * 1024, 1024, (const bf16_t*)(ws + WS_WT_XQ), 1024, 1024, u, fq_, lane, wave);
        SUBSPIN(5);
    } SEAM(7);

    if (IN(8)) {
        { pg8::Gemm g{(const bf16_t*)(ws + WS_QB), (const bf16_t*)(ws + WS_KB), 1024, 1024, 256, 1}; pg8::StaticOrder S; S.init(64, 4, G, bid);
          pg8::EpiRow<FS> E{FS{(bf16_t*)(ws + WS_PB), (float*)(ws + WS_LSUM)}}; pg8::gemm_phase(L, g, S, E, wave); }
    }

    if (IN(9)) {
        pg8::Gemm g{(const bf16_t*)(ws + WS_PB), (const bf16_t*)(ws + WS_VT), 1024, 256, 256, 2}; pg8::StaticOrder S; S.init(64, 4, G, bid);
        pg8::EpiRow<FPV> E{FPV{(bf16_t*)(ws + WS_OB), (const float*)(ws + WS_LSUM)}}; pg8::gemm_phase(L, g, S, E, wave);
        for (int u = bid; u < TS * 4; u += G) attn_sample(a, L, u, tid, lane, wave);
    } SEAM(9);

    if (IN(10)) {
        pg8::Gemm g{(const bf16_t*)(ws + WS_OB), (const bf16_t*)(ws + WS_WT_XO), 1024, 1024, 1024, 0}; pg8::StaticOrder S; S.init(SKN(10) ? 64 : 65, 4, G, bid);
        bf16_t* const x1b = (bf16_t*)(ws + WS_X1B);
        const FResT<true> fr{x1b, x1b + (size_t)TP * 1024, nullptr, nullptr, x1b, (float*)(ws + WS_SSQ2)}; pg8::EpiRow<FResT<true>> E{fr}; pg8::gemm_phase(L, g, S, E, wave);
        if (PROBE_SUB) { __syncthreads(); ts0 = __builtin_amdgcn_s_memrealtime(); }
        for (int u = bid; SKN(10) && u < 128; u += G) sgemm3_unit(L, (const bf16_t*)(ws + WS_OB) + (size_t)TP * 1024, 1024, (const bf16_t*)(ws + WS_WT_XO), 1024, 1024, u, fr, lane, wave);
        SUBSPIN(5);
    } SEAM(10);

    if (IN(11)) {
        pg8::Gemm g{(const bf16_t*)(ws + WS_X1B), (const bf16_t*)(ws + WS_WT_GU), 1024, 1024, 1024, 0}; pg8::StaticOrder S; S.init(SKN(11) ? 64 : 65, 22, G, bid);
        const FUp fu{(bf16_t*)(ws + WS_MID), (const float*)(ws + WS_SSQ2)}; pg8::EpiRow<FUp> E{fu}; pg8::gemm_phase(L, g, S, E, wave);
        for (int u = G - 1 - bid; SKN(11) && u < 88; u += G) sgemm_unit((const bf16_t*)(ws + WS_X1B) + (size_t)TP * 1024, 1024, (const bf16_t*)(ws + WS_WT_GU), 1024, 1024, u >> 2, u & 3, fu, lane, wave);
    } SEAM(11);

    if (IN(12)) {
        pg8::Gemm g{(const bf16_t*)(ws + WS_MID), (const bf16_t*)(ws + WS_WT_DOWN), DFF, DFF, DFF, 0}; pg8::StaticOrder S; S.init(SKN(12) ? 64 : 65, 4, G, bid);
        bf16_t* const x1b = (bf16_t*)(ws + WS_X1B);
        const FResT<true> fr{x1b, x1b + (size_t)TP * 1024, a.out + O_YP, a.out + O_YS, nullptr, (float*)(ws + WS_SSQ3)};
        const bool fuse_norm = SKN(12) && G == 256 && (hi - lo > 1);
        if (fuse_norm) { const EpiFinal E{x1b, a.out + O_YP, (float*)(ws + WS_SSQ3), a.in[I_FING], &bar, wave}; pg8::gemm_phase(L, g, S, E, wave); }
        else { pg8::EpiRow<FResT<true>> E{fr}; pg8::gemm_phase(L, g, S, E, wave); }
        if (PROBE_SUB) { __syncthreads(); ts0 = __builtin_amdgcn_s_memrealtime(); }
        for (int u = bid; SKN(12) && u < 128; u += G) sgemm3_unit(L, (const bf16_t*)(ws + WS_MID) + (size_t)TP * DFF, DFF, (const bf16_t*)(ws + WS_WT_DOWN), DFF, DFF, u, fr, lane, wave);
        SUBSPIN(5);
    } SEAM(12);

    if (IN(13)) {
        const float* ssq = (const float*)(ws + WS_SSQ3); const float* fg = a.in[I_FING];
        const bool fused13 = SKN(12) && G == 256 && (hi - lo > 1);
        for (int row0 = fused13 ? TP + gw : gw; row0 < TP + TS; row0 += 4 * NGW) {
            f32x4 v[4][4]; float rs[4]; float* yp[4];
#pragma unroll
            for (int i = 0; i < 4; ++i) { const int row = row0 + i * NGW; const bool ok = row < TP + TS; const int rr = ok ? row : row0;
                yp[i] = (rr < TP ? a.out + O_YP + (size_t)rr * 1024 : a.out + O_YS + (size_t)(rr - TP) * 1024) + 4 * lane;
                rs[i] = rsqrtf(ssq[rr] * (1.f / 1024.f) + EPS);
#pragma unroll
                for (int j = 0; j < 4; ++j) v[i][j] = *(const f32x4*)(yp[i] + 256 * j); }
#pragma unroll
            for (int i = 0; i < 4; ++i) { const int row = row0 + i * NGW;
                if (row < TP + TS) {
#pragma unroll
                    for (int j = 0; j < 4; ++j) { const f32x4 gg = *(const f32x4*)(fg + 4 * lane + 256 * j); *(f32x4*)(yp[i] + 256 * j) = v[i][j] * rs[i] * gg; } } }
        }
    } SEAM(13);
#undef IN
#undef SEAM
#undef lane
#undef tid
#undef gt
}

extern "C" void kernel_launch(void* const* d_in, const int* in_sizes, int n_in, void* d_out, int out_size, void* d_ws, size_t ws_size, hipStream_t stream) {
    static int grid = 0;
    if (grid == 0) {
        if (n_in != 38 || ws_size < WS_END) { fprintf(stderr, "kernel_launch: unexpected n_in %d / ws %zu\n", n_in, ws_size); grid = -1; return; }
        int dev = 0, cus = 0, per_cu = 0;
        if (hipGetDevice(&dev) != hipSuccess || hipDeviceGetAttribute(&cus, hipDeviceAttributeMultiprocessorCount, dev) != hipSuccess) { grid = -1; return; }
        if (hipFuncSetAttribute((const void*)hymba_fwd, hipFuncAttributeMaxDynamicSharedMemorySize, LDS_BYTES) != hipSuccess) { fprintf(stderr, "kernel_launch: hipFuncSetAttribute failed\n"); grid = -1; return; }
        if (hipOccupancyMaxActiveBlocksPerMultiprocessor(&per_cu, (const void*)hymba_fwd, 512, LDS_BYTES) != hipSuccess || per_cu < 1) { fprintf(stderr, "kernel_launch: occupancy query says %d\n", per_cu); per_cu = 1; }
        (void)hipGetLastError();
        grid = cus;
    }
    if (grid < 0) return;
    (void)hipMemsetAsync((char*)d_ws + WS_BAR, 0, XCD_BAR_WORDS * 4, stream);
    Args a{};
    for (int i = 0; i < 38; ++i) a.in[i] = (const float*)d_in[i];
    a.out = (float*)d_out; a.ws = (unsigned char*)d_ws;
#if MK_MULTI
    for (int ph = 0; ph < NPH; ++ph) { a.ph_lo = ph; a.ph_hi = ph + 1; hipLaunchKernelGGL(hymba_fwd, dim3(grid), dim3(512), LDS_BYTES, stream, a); }
#else
    a.ph_lo = 0; a.ph_hi = NPH;
    void* args[] = {&a};
    hipError_t e = hipLaunchCooperativeKernel((const void*)hymba_fwd, dim3(grid), dim3(512), args, LDS_BYTES, stream);
    if (e != hipSuccess) fprintf(stderr, "kernel_launch: cooperative launch failed: %s (grid %d)\n", hipGetErrorString(e), grid);
#endif
}
```

```cpp
#include <hip/hip_runtime.h>
#include <hip/hip_cooperative_groups.h>
#include <cstdio>
#include <cstdint>
namespace cg = cooperative_groups;

#ifndef SK_MASK
#define SK_MASK 0x14E0
#endif
#define SKN(k) (((SK_MASK) >> (k)) & 1)
#ifndef MK_MULTI
#define MK_MULTI 0

#endif

#define DEVI __device__ __forceinline__
#define LAS __attribute__((address_space(3)))
typedef unsigned short bf16_t;
typedef short bf16x8 __attribute__((ext_vector_type(8)));
typedef float f32x4 __attribute__((ext_vector_type(4)));
typedef unsigned u32x4 __attribute__((ext_vector_type(4)));
typedef unsigned u32x2 __attribute__((ext_vector_type(2)));

constexpr int TP = 16384, TS = 128, TALL = 16640;
constexpr int DM = 1024, NPROJ = 3584, WIN_LD = 3600, DFF = 2816, CONVD = 1536;
constexpr float EPS = 1e-6f;
constexpr int S5LC = 256, S5NCH = 8;

constexpr size_t MiB = 1u << 20;
constexpr size_t WS_SSQ_SSD = 0, WS_SSQ1 = 128 * 1024, WS_SSQ2 = 256 * 1024, WS_SSQ3 = 384 * 1024, WS_LSUM = 512 * 1024, WS_ZERO_END = 896 * 1024;
constexpr size_t WS_DECAY = 896 * 1024;
constexpr size_t WS_BAR = 960 * 1024;
constexpr size_t WS_DTRAW = 1 * MiB;
constexpr size_t WS_WT_IN = 3 * MiB, WS_WT_GLU = 10 * MiB, WS_WT_OUT = 12 * MiB, WS_WT_XQ = 16 * MiB, WS_WT_KV = 18 * MiB, WS_WT_XO = 22 * MiB,
                 WS_WT_GU = 24 * MiB, WS_WT_DOWN = 35 * MiB;
constexpr size_t WS_KB = 41 * MiB, WS_VT = 45 * MiB, WS_MEMB = 49 * MiB, WS_S5END = 53 * MiB, WS_S5CAR = 61 * MiB;
constexpr size_t WS_PROJ = 70 * MiB, WS_MID = 70 * MiB;
constexpr size_t WS_HB = 184 * MiB, WS_X1B = 184 * MiB;
constexpr size_t WS_CS = 217 * MiB, WS_QB = 217 * MiB, WS_PB = 250 * MiB;
constexpr size_t WS_SIN = 281 * MiB, WS_OB = 283 * MiB;
constexpr size_t WS_CAT = 316 * MiB, WS_GB = 382 * MiB, WS_X1F = 415 * MiB, WS_END = 481 * MiB;

constexpr size_t O_YP = 0, O_YS = 16777216, O_CONVP = 16908288, O_SSMP = 16945152, O_S5RP = 17993728, O_S5IP = 18026496,
                 O_MEMK = 18059264, O_MEMV = 20156416, O_CONVS = 22253568, O_SSMS = 22843392, O_S5RS = 39620608, O_S5IS = 40144896;

constexpr int LDS_BYTES = 147456;
constexpr int MISC_OFF = 131072 + 8192;

struct Args { const float* in[38]; float* out; unsigned char* ws; int ph_lo, ph_hi; };
enum { I_XP = 0, I_XS, I_MEM, I_SCONV, I_SSSM, I_SS5R, I_SS5I, I_CK, I_CV, I_LN1, I_WIN, I_CONVW, I_CONVB, I_DTB, I_ALOG, I_DSSD, I_GN,
       I_LAMR, I_LAMI, I_LSTEP, I_BRE, I_BIM, I_CRE, I_CIM, I_DS5, I_WGLU, I_BGLU, I_WOUT, I_LN2, I_WXQ, I_WXK, I_WXV, I_WXO, I_LN3,
       I_WGATE, I_WUP, I_WDOWN, I_FING };

DEVI unsigned cvt_pk(float lo, float hi) { unsigned r; asm("v_cvt_pk_bf16_f32 %0, %1, %2" : "=v"(r) : "v"(lo), "v"(hi)); return r; }
DEVI bf16_t f2bf(float x) { return (bf16_t)(cvt_pk(x, 0.f) & 0xffffu); }
DEVI float bf2f(unsigned b) { return __uint_as_float(b << 16); }
DEVI float bflo(unsigned w) { return __uint_as_float(w << 16); }
DEVI float bfhi(unsigned w) { return __uint_as_float(w & 0xffff0000u); }
DEVI float rcp_(float x) { return __builtin_amdgcn_rcpf(x); }
DEVI float silu_(float x) { return x * rcp_(1.f + __expf(-x)); }
DEVI float sigmoid_(float x) { return rcp_(1.f + __expf(-x)); }
DEVI float gelu_(float x) { const float y = 0.7978845608f * (x + 0.044715f * x * x * x); const float t = 1.f - 2.f * rcp_(1.f + __expf(2.f * y)); return 0.5f * x * (1.f + t); }
DEVI float softplus_(float x) { return x > 20.f ? x : log1pf(expf(x)); }
DEVI int lane_id_() { int l = (int)__builtin_amdgcn_mbcnt_hi(~0u, __builtin_amdgcn_mbcnt_lo(~0u, 0u)); asm volatile("" : "+v"(l)); return l; }
DEVI float shfl_xor_(float v, int m) { return __builtin_bit_cast(float, __builtin_amdgcn_ds_bpermute((lane_id_() ^ m) << 2, __builtin_bit_cast(int, v))); }
DEVI float shfl_up_(float v, int o) { const int l = lane_id_(); return __builtin_bit_cast(float, __builtin_amdgcn_ds_bpermute((l >= o ? l - o : l) << 2, __builtin_bit_cast(int, v))); }
DEVI float shfl_(float v, int src) { return __builtin_bit_cast(float, __builtin_amdgcn_ds_bpermute(src << 2, __builtin_bit_cast(int, v))); }
DEVI float wave_sum(float v) {
    const int l = lane_id_();
#pragma unroll
    for (int o = 1; o < 64; o <<= 1) v += __builtin_bit_cast(float, __builtin_amdgcn_ds_bpermute((l ^ o) << 2, __builtin_bit_cast(int, v)));
    return v;
}
DEVI u32x4 pack8(const f32x4& a, const f32x4& b) { u32x4 w; w.x = cvt_pk(a[0], a[1]); w.y = cvt_pk(a[2], a[3]); w.z = cvt_pk(b[0], b[1]); w.w = cvt_pk(b[2], b[3]); return w; }
DEVI void unpack8(const u32x4& w, float* o) { o[0] = bflo(w.x); o[1] = bfhi(w.x); o[2] = bflo(w.y); o[3] = bfhi(w.y); o[4] = bflo(w.z); o[5] = bfhi(w.z); o[6] = bflo(w.w); o[7] = bfhi(w.w); }
#define LDS_WAIT() asm volatile("s_waitcnt lgkmcnt(0)" ::: "memory")

namespace pg8 {
constexpr int BM = 256, BK = 64, HALF = 128, HTB = HALF * BK * 2, STAGE_BYTES = 8 * HTB, NXCD = 8, WGM = 8;
DEVI int lds_byte(int r, int c) { const int st = (r >> 4) * 2 + (c >> 5), rr = r & 15, cc = c & 31, ob = rr * 64 + cc * 2; return st * 1024 + (ob ^ (((ob >> 9) & 1) << 5)); }
DEVI void stage_rc(int b, int& R, int& C) { const int st = b / 1024, sb = b % 1024, swz = sb ^ (((sb >> 9) & 1) << 5); R = (st >> 1) * 16 + swz / 64; C = (st & 1) * 32 + (swz % 64) / 2; }
DEVI int perm32(int rho) { const int n = rho >> 4, i = rho & 15; return 8 * (i >> 2) + 4 * n + (i & 3); }

struct Unit { int pm, pn; };
struct Gemm { const bf16_t* A; const bf16_t* Bt; int lda, ldb, K, mode; };
DEVI size_t a_off(const Gemm& g, const Unit& u) { size_t o = (size_t)u.pm * 256 * g.lda; if (g.mode) o += (size_t)u.pn * 256; return o * 2; }
DEVI size_t b_off(const Gemm& g, const Unit& u) {
    const size_t r = g.mode == 0 ? (size_t)u.pn : (g.mode == 1 ? (size_t)(u.pm >> 3) : (size_t)((u.pm >> 3) * 4 + u.pn));
    size_t o = r * 256 * g.ldb; if (g.mode == 1) o += (size_t)u.pn * 256; return o * 2;
}
struct StaticOrder {
    int nM, nN, nwg, G, c;
    DEVI void init(int nM_, int nN_, int G_, int c_) { nM = nM_; nN = nN_; nwg = nM * nN; G = G_; c = c_; }
    DEVI bool next(int i, Unit& u) const {
        const long L = (long)i * G + c; if (L >= nwg) return false;
        int wgid = (int)L; { const int q = nwg / NXCD, r = nwg % NXCD, xcd = wgid % NXCD, off = wgid / NXCD; wgid = (xcd < r ? xcd * (q + 1) : r * (q + 1) + (xcd - r) * q) + off; }
        const int nig = WGM * nN, gid = wgid / nig, fm = gid * WGM, gsz = (nM - fm) < WGM ? (nM - fm) : WGM;
        u.pm = fm + ((wgid % nig) % gsz); u.pn = (wgid % nig) / gsz; return true;
    }
};

template <class F> struct EpiRow {
    F f;
    DEVI void operator()(const f32x4 (&acc)[2][2][4][2], const Unit& u, int wr, int wc, int fr, int fq) const {
        const int c8 = wc * 32 + 8 * fq;
        typename F::UC uc; f.unit(u.pn, c8, uc);
#pragma unroll
        for (int ai = 0; ai < 2; ++ai) {
#pragma unroll
            for (int m0 = 0; m0 < 4; m0 += F::NB) {
                typename F::Pre p[F::NB];
#pragma unroll
                for (int m = 0; m < F::NB; ++m) f.load(u.pm * BM + ai * HALF + wr * 64 + (m0 + m) * 16 + fr, u.pn, c8, p[m]);
#pragma unroll
                for (int m = 0; m < F::NB; ++m) f.apply(u.pm * BM + ai * HALF + wr * 64 + (m0 + m) * 16 + fr, u.pn, c8, acc[ai][0][m0 + m][0], acc[ai][0][m0 + m][1], acc[ai][1][m0 + m][0], acc[ai][1][m0 + m][1], p[m], uc);
            }
        }
    }
};
template <class F> DEVI void epi_one(const F& f, int row, int pn, int c8, const f32x4& a0, const f32x4& a1, const f32x4& b0, const f32x4& b1) {
    typename F::UC uc; f.unit(pn, c8, uc); typename F::Pre p; f.load(row, pn, c8, p); f.apply(row, pn, c8, a0, a1, b0, b1, p, uc);
}

template <class Epi, class Sched>
DEVI void gemm_phase(LAS unsigned char* lds, const Gemm g, const Sched& S, const Epi& E, int wid, const float* hs = nullptr) {
    const int lane = lane_id_(), tid = wid * 64 + lane, wr = wid >> 2, wc = wid & 3, fr = lane & 15, fq = lane >> 4;
    const int K = g.K, nt = K / BK;
    unsigned voffA[2], voffB[2];
#pragma unroll
    for (int i = 0; i < 2; ++i) { int R, C; stage_rc(tid * 16 + i * 8192, R, C); const int Rb = (R & ~31) + perm32(R & 31);
        voffA[i] = (unsigned)(R * g.lda + C) * 2u; voffB[i] = (unsigned)(Rb * g.ldb + C) * 2u; }
    const size_t kstep = (size_t)(BK * 2);
    const size_t hsA = (size_t)HALF * g.lda * 2, hsB = (size_t)HALF * g.ldb * 2;
    const unsigned ldsw = (unsigned)wid * 1024u;
    const int aoff = lds_byte(wr * 64 + fr, fq * 8), boff = lds_byte(wc * 32 + fr, fq * 8);
#define PG8_SA(b, h) (((b) * 2 + (h)) * HTB)
#define PG8_SB(b, h) ((4 + (b) * 2 + (h)) * HTB)
#define PG8_STAGE(bufoff, gbase, voff) do { _Pragma("unroll") for (int _i = 0; _i < 2; ++_i) \
        __builtin_amdgcn_global_load_lds((const unsigned*)((const char*)(gbase) + (voff)[_i]), (LAS unsigned*)(lds + (bufoff) + ldsw + _i * 8192), 16, 0, 0); } while (0)
#define PG8_LDA(dst, b, h) do { _Pragma("unroll") for (int m = 0; m < 4; ++m) _Pragma("unroll") for (int k = 0; k < 2; ++k) dst[m][k] = *(const LAS bf16x8*)(lds + PG8_SA(b, h) + aoff + m * 2048 + k * 1024); } while (0)
#define PG8_LDB(dst, b, h) do { _Pragma("unroll") for (int n = 0; n < 2; ++n) _Pragma("unroll") for (int k = 0; k < 2; ++k) dst[n][k] = *(const LAS bf16x8*)(lds + PG8_SB(b, h) + boff + n * 2048 + k * 1024); } while (0)
#define PG8_MMA(ai, bj, At, Bt) do { __builtin_amdgcn_s_setprio(1); _Pragma("unroll") for (int m = 0; m < 4; ++m) _Pragma("unroll") for (int n = 0; n < 2; ++n) _Pragma("unroll") for (int k = 0; k < 2; ++k) \
        acc[ai][bj][m][n] = __builtin_amdgcn_mfma_f32_16x16x32_bf16(Bt[n][k], At[m][k], acc[ai][bj][m][n], 0, 0, 0); __builtin_amdgcn_s_setprio(0); } while (0)
#define PG8_WAIT_V(n) asm volatile("s_waitcnt vmcnt(" #n ")" ::: "memory")
#define PG8_WAIT_L(n) asm volatile("s_waitcnt lgkmcnt(" #n ")" ::: "memory")
#define PG8_BAR __builtin_amdgcn_s_barrier()
#define PG8_SCHED __builtin_amdgcn_sched_barrier(0)
    Unit cur, nxt; int ui = 0;
    if (!S.next(0, cur)) return;
    LAS float* const RS = (LAS float*)(lds + STAGE_BYTES);
    if (hs) { if (tid < 256) RS[tid] = rsqrtf(hs[cur.pm * BM + tid] * (1.f / 1024.f) + EPS); }
    f32x4 acc[2][2][4][2];
#pragma unroll
    for (int a = 0; a < 2; ++a)
#pragma unroll
        for (int b = 0; b < 2; ++b)
#pragma unroll
            for (int m = 0; m < 4; ++m)
#pragma unroll
                for (int n = 0; n < 2; ++n) acc[a][b][m][n] = (f32x4){0.f, 0.f, 0.f, 0.f};
    bf16x8 At[4][2], B0[2][2], B1[2][2];
    const char* cA = (const char*)g.A + a_off(g, cur); const char* cB = (const char*)g.Bt + b_off(g, cur);
    PG8_STAGE(PG8_SB(0, 0), cB, voffB); PG8_STAGE(PG8_SB(0, 1), cB + hsB, voffB); PG8_STAGE(PG8_SA(0, 0), cA, voffA); PG8_STAGE(PG8_SA(0, 1), cA + hsA, voffA);
    if (wr == 1) PG8_BAR;
    PG8_WAIT_V(2); PG8_BAR;
    PG8_STAGE(PG8_SB(1, 0), cB + kstep, voffB); PG8_STAGE(PG8_SA(1, 0), cA + kstep, voffA); PG8_STAGE(PG8_SB(1, 1), cB + hsB + kstep, voffB);
    PG8_WAIT_V(6); PG8_BAR;
    for (;;) {
        const bool has_next = S.next(ui + 1, nxt);
        const char* nA = has_next ? (const char*)g.A + a_off(g, nxt) : cA; const char* nB = has_next ? (const char*)g.Bt + b_off(g, nxt) : cB;
        for (int t = 0; t < nt; t += 2) {
            const bool last = (t == nt - 2);
            if (hs && t == (nt >> 1)) {
#pragma unroll
                for (int ai = 0; ai < 2; ++ai)
#pragma unroll
                    for (int m = 0; m < 4; ++m) { const float rs = RS[ai * HALF + wr * 64 + m * 16 + fr];
#pragma unroll
                        for (int bj = 0; bj < 2; ++bj)
#pragma unroll
                            for (int n = 0; n < 2; ++n) acc[ai][bj][m][n] = acc[ai][bj][m][n] * rs; }
            }
            const char* a1 = cA + (size_t)(t + 1) * kstep;
            const char* a2 = last ? nA : cA + (size_t)(t + 2) * kstep; const char* b2 = last ? nB : cB + (size_t)(t + 2) * kstep;
            const char* a3 = a2 + kstep; const char* b3 = b2 + kstep;
            PG8_LDB(B0, 0, 0); PG8_LDB(B1, 0, 1); PG8_SCHED; PG8_LDA(At, 0, 0); PG8_STAGE(PG8_SA(1, 1), a1 + hsA, voffA);
            PG8_WAIT_V(8); PG8_WAIT_L(0); PG8_BAR; PG8_MMA(0, 0, At, B0); PG8_MMA(0, 1, At, B1); PG8_BAR; PG8_SCHED;
            PG8_LDA(At, 0, 1); PG8_STAGE(PG8_SB(0, 0), b2, voffB); PG8_STAGE(PG8_SB(0, 1), b2 + hsB, voffB); PG8_STAGE(PG8_SA(0, 0), a2, voffA);
            PG8_WAIT_V(8); PG8_WAIT_L(0); PG8_BAR; PG8_MMA(1, 0, At, B0); PG8_MMA(1, 1, At, B1); PG8_BAR; PG8_SCHED;
            PG8_LDB(B0, 1, 0); PG8_LDB(B1, 1, 1); PG8_SCHED; PG8_LDA(At, 1, 0); PG8_STAGE(PG8_SA(0, 1), a2 + hsA, voffA);
            PG8_WAIT_V(8); PG8_WAIT_L(0); PG8_BAR; PG8_MMA(0, 0, At, B0); PG8_MMA(0, 1, At, B1); PG8_BAR; PG8_SCHED;
            PG8_LDA(At, 1, 1); PG8_STAGE(PG8_SB(1, 0), b3, voffB); PG8_STAGE(PG8_SB(1, 1), b3 + hsB, voffB); PG8_STAGE(PG8_SA(1, 0), a3, voffA);
            PG8_WAIT_V(8); PG8_WAIT_L(0); PG8_BAR; PG8_MMA(1, 0, At, B0); PG8_MMA(1, 1, At, B1); PG8_BAR; PG8_SCHED;
        }
        if (wr == 0) PG8_BAR;
        E(acc, cur, wr, wc, fr, fq);
        if (!has_next) break;
#pragma unroll
        for (int a = 0; a < 2; ++a)
#pragma unroll
            for (int b = 0; b < 2; ++b)
#pragma unroll
                for (int m = 0; m < 4; ++m)
#pragma unroll
                    for (int n = 0; n < 2; ++n) acc[a][b][m][n] = (f32x4){0.f, 0.f, 0.f, 0.f};
        cur = nxt; cA = nA; cB = nB; ++ui;
        if (wr == 1) PG8_BAR;
    }
    PG8_WAIT_V(0);
    PG8_BAR;
#undef PG8_SA
#undef PG8_SB
#undef PG8_STAGE
#undef PG8_LDA
#undef PG8_LDB
#undef PG8_MMA
#undef PG8_WAIT_V
#undef PG8_WAIT_L
#undef PG8_BAR
#undef PG8_SCHED
}
}

struct FIn {
    bf16_t* proj; float* convP; float* convS;
    static constexpr int NB = 4; struct UC {}; struct Pre {};
    DEVI void unit(int, int, UC&) const {} DEVI void load(int, int, int, Pre&) const {}
    DEVI void apply(int row, int pn, int c8, const f32x4& a0, const f32x4& a1, const f32x4& b0, const f32x4& b1, const Pre&, const UC&) const {
#pragma unroll
        for (int bj = 0; bj < 2; ++bj) {
            const int col = pn * 256 + bj * 128 + c8; const f32x4 v0 = bj ? b0 : a0, v1 = bj ? b1 : a1;
            *(u32x4*)(proj + (size_t)row * NPROJ + col) = pack8(v0, v1);
            if (col >= 1024 && col < 2560) {
                float* dst = nullptr;
                if (row < TP) { const int t = row & 2047; if (t >= 2045) dst = convP + ((size_t)(row >> 11) * 3 + (t - 2045)) * CONVD + (col - 1024); }
                else if (row < TP + TS) dst = convS + ((size_t)(row - TP) * 3 + 2) * CONVD + (col - 1024);
                if (dst) { *(f32x4*)dst = v0; *(f32x4*)(dst + 4) = v1; }
            }
        }
    }
};
struct FKV {
    float* outk; float* outv; bf16_t* kb; bf16_t* vt;
    static constexpr int NB = 4; struct UC {}; struct Pre {};
    DEVI void unit(int, int, UC&) const {} DEVI void load(int, int, int, Pre&) const {}
    DEVI void apply(int row, int pn, int c8, const f32x4& a0, const f32x4& a1, const f32x4& b0, const f32x4& b1, const Pre&, const UC&) const {
#pragma unroll
        for (int bj = 0; bj < 2; ++bj) {
            const int col = pn * 256 + bj * 128 + c8; const f32x4 v0 = bj ? b0 : a0, v1 = bj ? b1 : a1;
            if (col < 1024) {
                float* d = outk + (size_t)row * 1024 + col; *(f32x4*)d = v0; *(f32x4*)(d + 4) = v1;
                *(u32x4*)(kb + (size_t)row * 1024 + col) = pack8(v0, v1);
            } else {
                const int c = col - 1024; float* d = outv + (size_t)row * 1024 + c; *(f32x4*)d = v0; *(f32x4*)(d + 4) = v1;
                const int b = row >> 8, m = row & 255, h = c >> 8, dd = c & 255;
                bf16_t* t = vt + ((size_t)(b * 4 + h) * 256 + dd) * 256 + m;
#pragma unroll
                for (int j = 0; j < 4; ++j) { t[(size_t)j * 256] = f2bf(v0[j]); t[(size_t)(j + 4) * 256] = f2bf(v1[j]); }
            }
        }
    }
};
struct FGlu {
    const bf16_t* gb; const float* bglu; bf16_t* cat; const float* ssq;
    static constexpr int NB = 4; struct UC { f32x4 b[2][2]; }; struct Pre { u32x4 g[2]; };
    DEVI void unit(int pn, int c8, UC& uc) const {
#pragma unroll
        for (int bj = 0; bj < 2; ++bj) { const int col = pn * 256 + bj * 128 + c8; uc.b[bj][0] = *(const f32x4*)(bglu + col); uc.b[bj][1] = *(const f32x4*)(bglu + col + 4); } }
    DEVI void load(int row, int pn, int c8, Pre& p) const {
#pragma unroll
        for (int bj = 0; bj < 2; ++bj) p.g[bj] = *(const u32x4*)(gb + (size_t)row * 1024 + pn * 256 + bj * 128 + c8); }
    DEVI void apply(int row, int pn, int c8, const f32x4& a0, const f32x4& a1, const f32x4& b0, const f32x4& b1, const Pre& p, const UC& uc) const {
#pragma unroll
        for (int bj = 0; bj < 2; ++bj) {
            const int col = pn * 256 + bj * 128 + c8; const f32x4 v0 = bj ? b0 : a0, v1 = bj ? b1 : a1;
            float g[8]; unpack8(p.g[bj], g);
            f32x4 y0, y1;
#pragma unroll
            for (int j = 0; j < 4; ++j) { y0[j] = g[j] * sigmoid_(v0[j] + uc.b[bj][0][j]); y1[j] = g[4 + j] * sigmoid_(v1[j] + uc.b[bj][1][j]); }
            *(u32x4*)(cat + (size_t)row * 2048 + 1024 + col) = pack8(y0, y1);
        }
    }
};
template <bool BB>
struct FResT {
    const void* baseP; const void* baseS; float* outP; float* outS; bf16_t* outb; float* ssq;
    static constexpr int NB = 4; struct UC {}; struct Pre { f32x4 x[2][2]; };
    DEVI void unit(int, int, UC&) const {}
    DEVI void load(int row, int pn, int c8, Pre& p) const {
        const int rr = row < TP + TS ? row : 0;
#pragma unroll
        for (int bj = 0; bj < 2; ++bj) { const int col = pn * 256 + bj * 128 + c8;
            if (BB) { const bf16_t* base = rr < TP ? (const bf16_t*)baseP + (size_t)rr * 1024 : (const bf16_t*)baseS + (size_t)(rr - TP) * 1024;
                float f[8]; unpack8(*(const u32x4*)(base + col), f); p.x[bj][0] = (f32x4){f[0], f[1], f[2], f[3]}; p.x[bj][1] = (f32x4){f[4], f[5], f[6], f[7]}; }
            else { const float* base = rr < TP ? (const float*)baseP + (size_t)rr * 1024 : (const float*)baseS + (size_t)(rr - TP) * 1024;
                p.x[bj][0] = __builtin_nontemporal_load((const f32x4*)(base + col)); p.x[bj][1] = __builtin_nontemporal_load((const f32x4*)(base + col + 4)); } } }
    DEVI void apply(int row, int pn, int c8, const f32x4& a0, const f32x4& a1, const f32x4& b0, const f32x4& b1, const Pre& p, const UC&) const {
        const bool valid = row < TP + TS;
        float* out = outP ? (row < TP ? outP + (size_t)row * 1024 : outS + (size_t)(row - TP) * 1024) : nullptr;
        float ss = 0.f;
        if (valid) {
#pragma unroll
            for (int bj = 0; bj < 2; ++bj) {
                const int col = pn * 256 + bj * 128 + c8; const f32x4 v0 = bj ? b0 : a0, v1 = bj ? b1 : a1;
                const f32x4 x0 = p.x[bj][0] + v0, x1 = p.x[bj][1] + v1;
                if (out) { *(f32x4*)(out + col) = x0; *(f32x4*)(out + col + 4) = x1; }
                if (outb) *(u32x4*)(outb + (size_t)row * 1024 + col) = pack8(x0, x1);
                ss += (x0[0] * x0[0] + x0[1] * x0[1]) + (x0[2] * x0[2] + x0[3] * x0[3]) + (x1[0] * x1[0] + x1[1] * x1[1]) + (x1[2] * x1[2] + x1[3] * x1[3]);
            }
        }
        ss += shfl_xor_(ss, 16); ss += shfl_xor_(ss, 32);
        if (valid && ((c8 >> 3) & 3) == 0) atomicAdd(ssq + row, ss);
    }
};
struct FQ {
    bf16_t* qb; const float* ssq;
    static constexpr int NB = 4; struct UC {}; struct Pre { float ss; };
    DEVI void unit(int, int, UC&) const {} DEVI void load(int row, int, int, Pre& p) const { p.ss = ssq[row]; }
    DEVI void apply(int row, int pn, int c8, const f32x4& a0, const f32x4& a1, const f32x4& b0, const f32x4& b1, const Pre& p, const UC&) const {
        const float rs = rsqrtf(p.ss * (1.f / 1024.f) + EPS) * 0.0625f;
        *(u32x4*)(qb + (size_t)row * 1024 + pn * 256 + c8) = pack8(a0 * rs, a1 * rs);
        *(u32x4*)(qb + (size_t)row * 1024 + pn * 256 + 128 + c8) = pack8(b0 * rs, b1 * rs);
    }
};
struct FS {
    bf16_t* pb; float* lsum;
    static constexpr int NB = 4; struct UC {}; struct Pre {};
    DEVI void unit(int, int, UC&) const {} DEVI void load(int, int, int, Pre&) const {}
    DEVI void apply(int row, int pn, int c8, const f32x4& a0, const f32x4& a1, const f32x4& b0, const f32x4& b1, const Pre&, const UC&) const {
        float ls = 0.f;
#pragma unroll
        for (int bj = 0; bj < 2; ++bj) {
            const f32x4 v0 = bj ? b0 : a0, v1 = bj ? b1 : a1; f32x4 e0, e1;
#pragma unroll
            for (int j = 0; j < 4; ++j) { e0[j] = __expf(v0[j]); e1[j] = __expf(v1[j]); }
            const u32x4 w = pack8(e0, e1);
            *(u32x4*)(pb + (size_t)row * 1024 + pn * 256 + bj * 128 + c8) = w;
            ls += (bflo(w.x) + bfhi(w.x)) + (bflo(w.y) + bfhi(w.y)) + (bflo(w.z) + bfhi(w.z)) + (bflo(w.w) + bfhi(w.w));
        }
        ls += shfl_xor_(ls, 16); ls += shfl_xor_(ls, 32);
        if (((c8 >> 3) & 3) == 0) atomicAdd(lsum + (size_t)row * 4 + pn, ls);
    }
};
struct FPV {
    bf16_t* ob; const float* lsum;
    static constexpr int NB = 4; struct UC {}; struct Pre { float l; };
    DEVI void unit(int, int, UC&) const {} DEVI void load(int row, int pn, int, Pre& p) const { p.l = __hip_atomic_load(lsum + (size_t)row * 4 + pn, __ATOMIC_RELAXED, __HIP_MEMORY_SCOPE_AGENT); }
    DEVI void apply(int row, int pn, int c8, const f32x4& a0, const f32x4& a1, const f32x4& b0, const f32x4& b1, const Pre& p, const UC&) const {
        const float inv = 1.f / p.l;
        *(u32x4*)(ob + (size_t)row * 1024 + pn * 256 + c8) = pack8(a0 * inv, a1 * inv);
        *(u32x4*)(ob + (size_t)row * 1024 + pn * 256 + 128 + c8) = pack8(b0 * inv, b1 * inv);
    }
};
struct FUp {
    bf16_t* mid; const float* ssq;
    static constexpr int NB = 4; struct UC {}; struct Pre { float ss; };
    DEVI void unit(int, int, UC&) const {} DEVI void load(int row, int, int, Pre& p) const { p.ss = ssq[row]; }
    DEVI void apply(int row, int pn, int c8, const f32x4& a0, const f32x4& a1, const f32x4& b0, const f32x4& b1, const Pre& p, const UC&) const {
        const float rs = rsqrtf(p.ss * (1.f / 1024.f) + EPS);
        f32x4 y0, y1;
#pragma unroll
        for (int j = 0; j < 4; ++j) { y0[j] = silu_(a0[j] * rs) * (b0[j] * rs); y1[j] = silu_(a1[j] * rs) * (b1[j] * rs); }
        *(u32x4*)(mid + (size_t)row * DFF + pn * 128 + c8) = pack8(y0, y1);
    }
};

template <class F>
DEVI void sgemm_unit(const bf16_t* A, int lda, const bf16_t* Wt, int ldb, int K, int pn, int wc, const F& f, int lane_, int wave) {
    int lane = lane_; asm volatile("" : "+v"(lane));
    const int r = lane & 15, q = lane >> 4;
    const bf16_t* ap = A + (size_t)(16 * wave + r) * lda + 8 * q;
    const bf16_t* wp[4];
#pragma unroll
    for (int t = 0; t < 4; ++t) wp[t] = Wt + (size_t)(256 * pn + 128 * (t >> 1) + 32 * wc + 8 * (r >> 2) + 4 * (t & 1) + (r & 3)) * ldb + 8 * q;
    f32x4 acc[4];
#pragma unroll
    for (int t = 0; t < 4; ++t) acc[t] = (f32x4){0.f, 0.f, 0.f, 0.f};
    for (int k0 = 0; k0 < K; k0 += 128) {
        bf16x8 fa[4], fw[4][4];
#pragma unroll
        for (int u = 0; u < 4; ++u) { fa[u] = *(const bf16x8*)(ap + k0 + 32 * u);
#pragma unroll
            for (int t = 0; t < 4; ++t) fw[u][t] = *(const bf16x8*)(wp[t] + k0 + 32 * u); }
#pragma unroll
        for (int u = 0; u < 4; ++u)
#pragma unroll
            for (int t = 0; t < 4; ++t) acc[t] = __builtin_amdgcn_mfma_f32_16x16x32_bf16(fw[u][t], fa[u], acc[t], 0, 0, 0);
    }
    pg8::epi_one(f, TP + 16 * wave + r, pn, 32 * wc + 8 * q, acc[0], acc[1], acc[2], acc[3]);
}

template <class F>
DEVI void sgemm2_unit(LAS unsigned char* L, const bf16_t* A, int lda, const bf16_t* Wt, int ldb, int K, int unit, const F& f, int lane_, int wave) {
    int lane = lane_; asm volatile("" : "+v"(lane));
    const int tq = unit & 3, wc = (unit >> 2) & 3, pn = unit >> 4;
    const int r = lane & 15, q = lane >> 4, tg = wave & 1, kq = wave >> 1;
    const int NK = K >> 5, per = (((NK >> 2) + 7) >> 3) << 3, ksb = kq * per, cnt = (NK - ksb) < per ? (NK - ksb) : per;
    const bf16_t* ap = A + (size_t)(32 * tq + 16 * tg + r) * lda + 8 * q + 32 * ksb;
    const bf16_t* wp[4];
#pragma unroll
    for (int t = 0; t < 4; ++t) wp[t] = Wt + (size_t)(256 * pn + 128 * (t >> 1) + 32 * wc + 8 * (r >> 2) + 4 * (t & 1) + (r & 3)) * ldb + 8 * q + 32 * ksb;
    f32x4 acc[4];
#pragma unroll
    for (int t = 0; t < 4; ++t) acc[t] = (f32x4){0.f, 0.f, 0.f, 0.f};
    for (int c0 = 0; c0 < cnt; c0 += 8) {
        bf16x8 fa[8], fw[8][4];
#pragma unroll
        for (int u = 0; u < 8; ++u) { fa[u] = *(const bf16x8*)(ap + (c0 + u) * 32);
#pragma unroll
            for (int t = 0; t < 4; ++t) fw[u][t] = *(const bf16x8*)(wp[t] + (c0 + u) * 32); }
#pragma unroll
        for (int u = 0; u < 8; ++u)
#pragma unroll
            for (int t = 0; t < 4; ++t) acc[t] = __builtin_amdgcn_mfma_f32_16x16x32_bf16(fw[u][t], fa[u], acc[t], 0, 0, 0);
    }
    LAS f32x4* red = (LAS f32x4*)L;
#pragma unroll
    for (int t = 0; t < 4; ++t) red[(wave * 4 + t) * 64 + lane] = acc[t];
    __syncthreads();
    if (kq == 0) {
#pragma unroll
        for (int t = 0; t < 4; ++t) acc[t] = (red[(tg * 4 + t) * 64 + lane] + red[((tg + 2) * 4 + t) * 64 + lane]) + (red[((tg + 4) * 4 + t) * 64 + lane] + red[((tg + 6) * 4 + t) * 64 + lane]);
        pg8::epi_one(f, TP + 32 * tq + 16 * tg + r, pn, 32 * wc + 8 * q, acc[0], acc[1], acc[2], acc[3]);
    }
    __syncthreads();
}

template <class F>
DEVI void sgemm3_unit(LAS unsigned char* L, const bf16_t* A, int lda, const bf16_t* Wt, int ldb, int K, int unit, const F& f, int lane_, int wave, const float* hs = nullptr) {
    int lane = lane_; asm volatile("" : "+v"(lane));
    const int tg = unit & 7, wc = (unit >> 3) & 3, pn = unit >> 5;
    const int r = lane & 15, q = lane >> 4;
    const int NK = K >> 5, per = (((NK >> 3) + 3) >> 2) << 2, ksb = wave * per; int cnt = NK - ksb; cnt = cnt < 0 ? 0 : (cnt < per ? cnt : per);
    const bf16_t* ap = A + (size_t)(16 * tg + r) * lda + 8 * q + 32 * ksb;
    const bf16_t* wp[4];
#pragma unroll
    for (int t = 0; t < 4; ++t) wp[t] = Wt + (size_t)(256 * pn + 128 * (t >> 1) + 32 * wc + 8 * (r >> 2) + 4 * (t & 1) + (r & 3)) * ldb + 8 * q + 32 * ksb;
    f32x4 acc[4];
#pragma unroll
    for (int t = 0; t < 4; ++t) acc[t] = (f32x4){0.f, 0.f, 0.f, 0.f};
    typename F::UC euc; typename F::Pre epre;
    if (wave == 0) { f.unit(pn, 32 * wc + 8 * q, euc); f.load(TP + 16 * tg + r, pn, 32 * wc + 8 * q, epre); }
    for (int c0 = 0; c0 < cnt; c0 += 4) {
        bf16x8 fa[4], fw[4][4];
#pragma unroll
        for (int u = 0; u < 4; ++u) { fa[u] = *(const bf16x8*)(ap + (c0 + u) * 32);
#pragma unroll
            for (int t = 0; t < 4; ++t) fw[u][t] = *(const bf16x8*)(wp[t] + (c0 + u) * 32); }
#pragma unroll
        for (int u = 0; u < 4; ++u)
#pragma unroll
            for (int t = 0; t < 4; ++t) acc[t] = __builtin_amdgcn_mfma_f32_16x16x32_bf16(fw[u][t], fa[u], acc[t], 0, 0, 0);
    }
    LAS f32x4* red = (LAS f32x4*)L;
#pragma unroll
    for (int t = 0; t < 4; ++t) red[(wave * 4 + t) * 64 + lane] = acc[t];
    __syncthreads();
    if (wave == 0) {
        const float hrs = hs ? rsqrtf(hs[TP + 16 * tg + r] * (1.f / 1024.f) + EPS) : 1.f;
#pragma unroll
        for (int t = 0; t < 4; ++t) { f32x4 v = red[t * 64 + lane];
#pragma unroll
            for (int w = 1; w < 4; ++w) v += red[(w * 4 + t) * 64 + lane];
            v = v * hrs;
#pragma unroll
            for (int w = 4; w < 8; ++w) v += red[(w * 4 + t) * 64 + lane];
            acc[t] = v; }
        f.apply(TP + 16 * tg + r, pn, 32 * wc + 8 * q, acc[0], acc[1], acc[2], acc[3], epre, euc);
    }
    __syncthreads();
}

#define XB_TMO      128
#define XB_XCNT(j)  (256  + 64 * (j))
#define XB_XSUB(j)  (1280 + 64 * (j))
#define XB_XGEN(j)  (2304 + 64 * (j))
#define XB_TOP      3328
#define XB_TOPGEN   3392
#define XCD_BAR_WORDS 3456
#define XB_SPIN_CAP (1u << 22)
DEVI unsigned xb_ld(unsigned* p)              { return __hip_atomic_load(p, __ATOMIC_RELAXED, __HIP_MEMORY_SCOPE_AGENT); }
DEVI unsigned xb_add(unsigned* p, unsigned v) { return __hip_atomic_fetch_add(p, v, __ATOMIC_RELAXED, __HIP_MEMORY_SCOPE_AGENT); }
DEVI unsigned xb_xcc_id() { return (unsigned)__builtin_amdgcn_s_getreg((3 << 11) | 20) & 0xFu; }
#define XB_SPIN(cond, bar) do { unsigned _sp = 0; while (cond) { __builtin_amdgcn_s_sleep(1); \
    if ((++_sp & 255u) == 0u) { if (xb_ld(&(bar)[XB_TMO])) break; if (_sp > XB_SPIN_CAP) { atomicAdd(&(bar)[XB_TMO], 1u); break; } } } } while (0)
struct XcdBarrier { unsigned* bar; unsigned x; volatile LAS unsigned* st; };
DEVI XcdBarrier xcd_barrier_post(unsigned* bar, volatile LAS unsigned* st, bool t0) {
    XcdBarrier b; b.bar = bar; b.x = xb_xcc_id(); b.st = st;
    if (t0) (void)xb_add(&bar[XB_XCNT(b.x)], 1u);
    return b;
}
DEVI void xcd_barrier_complete(unsigned* bar, unsigned x, unsigned& nloc, unsigned& nx) {
    const unsigned G = gridDim.x * gridDim.y * gridDim.z;
    unsigned sum, cnt, mine, sp = 0u;
    for (;;) {
        sum = 0u; cnt = 0u; mine = 0u;
#pragma unroll
        for (unsigned j = 0; j < 16; ++j) { const unsigned c = xb_ld(&bar[XB_XCNT(j)]); sum += c; cnt += (c > 0u) ? 1u : 0u; mine = (j == x) ? c : mine; }
        if (sum == G) break;
        __builtin_amdgcn_s_sleep(1);
        if ((++sp & 255u) == 0u) { if (xb_ld(&bar[XB_TMO])) break; if (sp > XB_SPIN_CAP) { atomicAdd(&bar[XB_TMO], 1u); break; } }
    }
    nloc = mine > 0u ? mine : 1u; nx = cnt > 0u ? cnt : 1u;
}
DEVI void xcd_barrier(const XcdBarrier& b, int wave) {
    asm volatile("s_waitcnt vmcnt(0)" ::: "memory");
    __syncthreads();
    if (wave == 0 && lane_id_() == 0) {
        unsigned* bar = b.bar;
        __builtin_amdgcn_s_waitcnt(0);
        unsigned nloc = b.st[0], nx = b.st[1];
        if (nloc == 0u) { xcd_barrier_complete(bar, b.x, nloc, nx); b.st[0] = nloc; b.st[1] = nx; }
        const unsigned old = xb_add(&bar[XB_XSUB(b.x)], 1u);
        const unsigned gen = old / nloc;
        if (old + 1u == (gen + 1u) * nloc) {
            __builtin_amdgcn_fence(__ATOMIC_RELEASE, "agent");
            asm volatile("s_waitcnt vmcnt(0)" ::: "memory");
            const unsigned og = xb_add(&bar[XB_TOP], 1u);
            const unsigned tg = og / nx;
            if (og + 1u == (tg + 1u) * nx) xb_add(&bar[XB_TOPGEN], 1u);
            else XB_SPIN(xb_ld(&bar[XB_TOPGEN]) == tg, bar);
            __builtin_amdgcn_fence(__ATOMIC_ACQUIRE, "agent");
            xb_add(&bar[XB_XGEN(b.x)], 1u);
            asm volatile("s_waitcnt vmcnt(0)" ::: "memory");
        } else {
            XB_SPIN(xb_ld(&bar[XB_XGEN(b.x)]) == gen, bar);
            __builtin_amdgcn_fence(__ATOMIC_ACQUIRE, "agent");
            asm volatile("s_waitcnt vmcnt(0)" ::: "memory");
        }
    }
    __syncthreads();
}

struct EpiFinal {
    const bf16_t* base; float* out; float* ssq; const float* fing; const XcdBarrier* bar; int wave;
    DEVI void operator()(f32x4 (&acc)[2][2][4][2], const pg8::Unit& u, int wr, int wc, int fr, int fq) const {
        const int c8 = wc * 32 + 8 * fq;
#pragma unroll
        for (int ai = 0; ai < 2; ++ai)
#pragma unroll
            for (int m0 = 0; m0 < 4; m0 += 2) {
                f32x4 x[2][2][2];
#pragma unroll
                for (int m = 0; m < 2; ++m) { const int row = u.pm * 256 + ai * 128 + wr * 64 + (m0 + m) * 16 + fr;
#pragma unroll
                    for (int bj = 0; bj < 2; ++bj) { float f[8]; unpack8(*(const u32x4*)(base + (size_t)row * 1024 + u.pn * 256 + bj * 128 + c8), f);
                        x[m][bj][0] = (f32x4){f[0], f[1], f[2], f[3]}; x[m][bj][1] = (f32x4){f[4], f[5], f[6], f[7]}; } }
#pragma unroll
                for (int m = 0; m < 2; ++m) { const int row = u.pm * 256 + ai * 128 + wr * 64 + (m0 + m) * 16 + fr; float ss = 0.f;
#pragma unroll
                    for (int bj = 0; bj < 2; ++bj)
#pragma unroll
                        for (int n = 0; n < 2; ++n) { f32x4 v = acc[ai][bj][m0 + m][n] + x[m][bj][n]; acc[ai][bj][m0 + m][n] = v; ss += (v[0] * v[0] + v[1] * v[1]) + (v[2] * v[2] + v[3] * v[3]); }
                    ss += shfl_xor_(ss, 16); ss += shfl_xor_(ss, 32);
                    if (fq == 0) atomicAdd(ssq + row, ss); }
            }
        xcd_barrier(*bar, wave);
        f32x4 gg[2][2];
#pragma unroll
        for (int bj = 0; bj < 2; ++bj) { const float* gp = fing + u.pn * 256 + bj * 128 + c8; gg[bj][0] = *(const f32x4*)gp; gg[bj][1] = *(const f32x4*)(gp + 4); }
#pragma unroll
        for (int ai = 0; ai < 2; ++ai)
#pragma unroll
            for (int m = 0; m < 4; ++m) { const int row = u.pm * 256 + ai * 128 + wr * 64 + m * 16 + fr;
                const float rs = rsqrtf(__hip_atomic_load(ssq + row, __ATOMIC_RELAXED, __HIP_MEMORY_SCOPE_AGENT) * (1.f / 1024.f) + EPS);
#pragma unroll
                for (int bj = 0; bj < 2; ++bj) { float* op = out + (size_t)row * 1024 + u.pn * 256 + bj * 128 + c8;
                    *(f32x4*)op = acc[ai][bj][m][0] * rs * gg[bj][0]; *(f32x4*)(op + 4) = acc[ai][bj][m][1] * rs * gg[bj][1]; } }
    }
};

DEVI void tr_item(const float* W, int ldw, int K, bf16_t* WT, int dst_row, const float* scale, int slim, LAS float* scr, int k0, int n_src0, int lane) {
    float wv[32];
#pragma unroll
    for (int i = 0; i < 32; ++i) wv[i] = __builtin_nontemporal_load(W + (size_t)(k0 + 2 * i + (lane >> 5)) * ldw + n_src0 + (lane & 31));
    if (scale) {
#pragma unroll
        for (int i = 0; i < 32; ++i) { const int k = k0 + 2 * i + (lane >> 5); const float sv = scale[k < slim ? k : slim - 1]; wv[i] *= (k < slim) ? sv : 1.f; }
    }
#pragma unroll
    for (int i = 0; i < 32; ++i) scr[(2 * i + (lane >> 5)) * 33 + (lane & 31)] = wv[i];
    LDS_WAIT();
    const int c = lane & 7;
#pragma unroll
    for (int j = 0; j < 4; ++j) { const int n = (lane >> 3) + 8 * j; const LAS float* s = scr + (8 * c) * 33 + n;
        u32x4 o; o.x = cvt_pk(s[0 * 33], s[1 * 33]); o.y = cvt_pk(s[2 * 33], s[3 * 33]); o.z = cvt_pk(s[4 * 33], s[5 * 33]); o.w = cvt_pk(s[6 * 33], s[7 * 33]);
        *(u32x4*)(WT + (size_t)(dst_row + n) * K + k0 + 8 * c) = o; }
    LDS_WAIT();
}
DEVI void p0_prologue(const Args& a, LAS unsigned char* L, int tid, int lane, int wave) {
    unsigned char* ws = a.ws;
    const int G = gridDim.x, gw = blockIdx.x * 8 + wave, NGW = G * 8, gt = blockIdx.x * 512 + tid, NT = G * 512;
    for (int i = gt; i < (int)(WS_ZERO_END / 16); i += NT) ((u32x4*)ws)[i] = (u32x4){0u, 0u, 0u, 0u};
    LAS float* scr = (LAS float*)(L + wave * 8448);
    constexpr int J0 = 16 * 80, J1 = 16 * 32, J5 = 512, J6 = 512;
    for (int it = gw; it < J0 + J1 + J5 + J6; it += NGW) {
        int r = it;
        if (r < J0) { tr_item(a.in[I_WIN], WIN_LD, 1024, (bf16_t*)(ws + WS_WT_IN), (r % 80) * 32, nullptr, 0, scr, (r / 80) * 64, (r % 80) * 32, lane); continue; } r -= J0;
        if (r < J1) { tr_item(a.in[I_WIN], WIN_LD, 1024, (bf16_t*)(ws + WS_WT_IN), 2560 + (r % 32) * 32, nullptr, 0, scr, (r / 32) * 64, 2576 + (r % 32) * 32, lane); continue; } r -= J1;
        if (r < J5) { tr_item(a.in[I_WXK], 1024, 1024, (bf16_t*)(ws + WS_WT_KV), (r % 32) * 32, nullptr, 0, scr, (r / 32) * 64, (r % 32) * 32, lane); continue; } r -= J5;
        tr_item(a.in[I_WXV], 1024, 1024, (bf16_t*)(ws + WS_WT_KV), 1024 + (r % 32) * 32, nullptr, 0, scr, (r / 32) * 64, (r % 32) * 32, lane);
    }
    { const float* mp = a.in[I_MEM]; bf16_t* mb = (bf16_t*)(ws + WS_MEMB);
      for (int i = gt; i < 2048 * 1024 / 8; i += NT) { const f32x4 v0 = __builtin_nontemporal_load((const f32x4*)(mp + (size_t)i * 8)), v1 = __builtin_nontemporal_load((const f32x4*)(mp + (size_t)i * 8 + 4)); *(u32x4*)(mb + (size_t)i * 8) = pack8(v0, v1); } }
    { const float* sc = a.in[I_SCONV]; float* cs = a.out + O_CONVS;
      for (int i = gt; i < TS * 2 * CONVD / 4; i += NT) { const int e = i * 4, b = e / (2 * CONVD), rem = e % (2 * CONVD), r = rem / CONVD, c = rem % CONVD;
          *(f32x4*)(cs + ((size_t)b * 3 + r) * CONVD + c) = *(const f32x4*)(sc + ((size_t)b * 3 + r + 1) * CONVD + c); } }
    __syncthreads();
    LAS float* slab = (LAS float*)L;
    for (int i = tid; i < 1024 * 4; i += 512) { const int k = i >> 2, c4 = (i & 3) * 4; *(LAS f32x4*)(slab + k * 20 + c4) = *(const f32x4*)(a.in[I_WIN] + (size_t)k * WIN_LD + 2560 + c4); }
    __syncthreads();
    bf16_t* hb = (bf16_t*)(ws + WS_HB); float* dtraw = (float*)(ws + WS_DTRAW);
    float g1[16];
#pragma unroll
    for (int j = 0; j < 16; ++j) g1[j] = a.in[I_LN1][lane + 64 * j];
    float xn[16];
#pragma unroll
    for (int j = 0; j < 16; ++j) xn[j] = 0.f;
    if (gw < TP + TS) { const float* src = gw < TP ? a.in[I_XP] + (size_t)gw * 1024 : a.in[I_XS] + (size_t)(gw - TP) * 1024;
#pragma unroll
        for (int j = 0; j < 16; ++j) xn[j] = __builtin_nontemporal_load(src + lane + 64 * j); }
    for (int row = gw; row < TALL; row += NGW) {
        if (row >= TP + TS) {
#pragma unroll
            for (int j = 0; j < 16; ++j) hb[(size_t)row * 1024 + lane + 64 * j] = 0;
            if (lane < 16) dtraw[(size_t)row * 16 + lane] = 0.f;
            continue;
        }
        float x[16]; float ss = 0.f;
#pragma unroll
        for (int j = 0; j < 16; ++j) { x[j] = xn[j]; ss += x[j] * x[j]; }
        { const int nr = row + NGW;
          if (nr < TP + TS) { const float* src = nr < TP ? a.in[I_XP] + (size_t)nr * 1024 : a.in[I_XS] + (size_t)(nr - TP) * 1024;
#pragma unroll
              for (int j = 0; j < 16; ++j) xn[j] = __builtin_nontemporal_load(src + lane + 64 * j); } }
        const float rstd = rsqrtf(wave_sum(ss) * (1.f / 1024.f) + EPS);
        float acc[16];
#pragma unroll
        for (int e = 0; e < 16; ++e) acc[e] = 0.f;
#pragma unroll
        for (int j = 0; j < 16; ++j) {
            const float h = x[j] * rstd * g1[j];
            hb[(size_t)row * 1024 + lane + 64 * j] = f2bf(h);
            const LAS float* wrow = slab + (lane + 64 * j) * 20;
#pragma unroll
            for (int q = 0; q < 4; ++q) { const f32x4 w = *(const LAS f32x4*)(wrow + 4 * q);
                acc[4 * q] += h * w[0]; acc[4 * q + 1] += h * w[1]; acc[4 * q + 2] += h * w[2]; acc[4 * q + 3] += h * w[3]; }
        }
        float outv = 0.f;
#pragma unroll
        for (int e = 0; e < 16; ++e) { const float s = wave_sum(acc[e]); if (lane == e) outv = s; }
        if (lane < 16) dtraw[(size_t)row * 16 + lane] = outv;
    }
}

DEVI void p3_weights(const Args& a, LAS unsigned char* L, int lane, int wave) {
    unsigned char* ws = a.ws; const int gw = blockIdx.x * 8 + wave, NGW = gridDim.x * 8;
    LAS float* scr = (LAS float*)(L + wave * 8448);
    constexpr int J2 = 512, J3 = 32 * 32, J4 = 512, J7 = 512, J8 = 16 * 88, J9 = 16 * 88, J10 = 44 * 32;
    for (int it = gw; it < J2 + J3 + J4 + J7 + J8 + J9 + J10; it += NGW) {
        int r = it;
        if (r < J2) { tr_item(a.in[I_WGLU], 1024, 1024, (bf16_t*)(ws + WS_WT_GLU), (r % 32) * 32, nullptr, 0, scr, (r / 32) * 64, (r % 32) * 32, lane); continue; } r -= J2;
        if (r < J3) { tr_item(a.in[I_WOUT], 1024, 2048, (bf16_t*)(ws + WS_WT_OUT), (r % 32) * 32, a.in[I_GN], 1024, scr, (r / 32) * 64, (r % 32) * 32, lane); continue; } r -= J3;
        if (r < J4) { tr_item(a.in[I_WXQ], 1024, 1024, (bf16_t*)(ws + WS_WT_XQ), (r % 32) * 32, a.in[I_LN2], 1024, scr, (r / 32) * 64, (r % 32) * 32, lane); continue; } r -= J4;
        if (r < J7) { tr_item(a.in[I_WXO], 1024, 1024, (bf16_t*)(ws + WS_WT_XO), (r % 32) * 32, nullptr, 0, scr, (r / 32) * 64, (r % 32) * 32, lane); continue; } r -= J7;
        if (r < J8) { const int n0 = (r % 88) * 32; tr_item(a.in[I_WGATE], DFF, 1024, (bf16_t*)(ws + WS_WT_GU), (n0 >> 7) * 256 + (n0 & 127), a.in[I_LN3], 1024, scr, (r / 88) * 64, n0, lane); continue; } r -= J8;
        if (r < J9) { const int n0 = (r % 88) * 32; tr_item(a.in[I_WUP], DFF, 1024, (bf16_t*)(ws + WS_WT_GU), (n0 >> 7) * 256 + 128 + (n0 & 127), a.in[I_LN3], 1024, scr, (r / 88) * 64, n0, lane); continue; } r -= J9;
        tr_item(a.in[I_WDOWN], 1024, DFF, (bf16_t*)(ws + WS_WT_DOWN), (r % 32) * 32, nullptr, 0, scr, (r / 32) * 64, (r % 32) * 32, lane);
    }
}

struct ConvW { float w[4][8]; float b[8]; };
DEVI void convw_load(ConvW& cw, const float* conv_w, const float* conv_b, int ch) {
#pragma unroll
    for (int w = 0; w < 4; ++w) { const f32x4 p = *(const f32x4*)(conv_w + w * CONVD + ch), q = *(const f32x4*)(conv_w + w * CONVD + ch + 4);
#pragma unroll
        for (int j = 0; j < 4; ++j) { cw.w[w][j] = p[j]; cw.w[w][4 + j] = q[j]; } }
    const f32x4 p = *(const f32x4*)(conv_b + ch), q = *(const f32x4*)(conv_b + ch + 4);
#pragma unroll
    for (int j = 0; j < 4; ++j) { cw.b[j] = p[j]; cw.b[4 + j] = q[j]; }
}
DEVI void conv8_prompt(const ConvW& cw, const bf16_t* proj, int row, int t, int ch, float* o) {
    u32x4 raw[4];
#pragma unroll
    for (int w = 0; w < 4; ++w) { const int d = (t - 3 + w >= 0) ? (3 - w) : 0;
        raw[w] = *(const u32x4*)(proj + (size_t)(row - d) * NPROJ + 1024 + ch); }
#pragma unroll
    for (int j = 0; j < 8; ++j) o[j] = cw.b[j];
#pragma unroll
    for (int w = 0; w < 4; ++w) { float x[8]; unpack8(raw[w], x); const float m = (t - 3 + w >= 0) ? 1.f : 0.f;
#pragma unroll
        for (int j = 0; j < 8; ++j) o[j] += (x[j] * m) * cw.w[w][j]; }
#pragma unroll
    for (int j = 0; j < 8; ++j) o[j] = silu_(o[j]);
}
DEVI void ssd_dt_acum(const Args& a, LAS float* acum, LAS float* dtv, int row0, int g, int wave, int lane) {
    const int h = g * 8 + wave; const float* dtraw = (const float*)(a.ws + WS_DTRAW);
    const float A = -expf(a.in[I_ALOG][h]), bias = a.in[I_DTB][h];
    const float d0 = softplus_(dtraw[(size_t)(row0 + 2 * lane) * 16 + h] + bias), d1 = softplus_(dtraw[(size_t)(row0 + 2 * lane + 1) * 16 + h] + bias);
    const float v0 = d0 * A, v1 = v0 + d1 * A;
    float s = v1;
#pragma unroll
    for (int o = 1; o < 64; o <<= 1) { const float t = shfl_up_(s, o); if (lane >= o) s += t; }
    const float ex = s - v1;
    acum[wave * 128 + 2 * lane] = ex + v0; acum[wave * 128 + 2 * lane + 1] = ex + v1;
    dtv[wave * 128 + 2 * lane] = d0; dtv[wave * 128 + 2 * lane + 1] = d1;
}
constexpr int TLD = 136;
DEVI int swz(int r, int j) { return r * TLD + (j ^ (((r >> 3) & 15) << 3)); }
DEVI int swzb(int r, int kb) { return r * TLD + ((kb ^ ((r >> 3) & 15)) << 3); }

DEVI void ssd_pass1(const Args& a, LAS unsigned char* L, int unit, int tid, int lane, int wave) {
    const int g = unit & 1, c = (unit >> 1) & 15, b = unit >> 5, row0 = b * 2048 + c * 128, t0 = c * 128;
    LAS float* acum = (LAS float*)L; LAS float* dtv = (LAS float*)(L + 4096);
    LAS bf16_t* BT = (LAS bf16_t*)(L + 8192); LAS bf16_t* XW = (LAS bf16_t*)(L + 8192 + 128 * TLD * 2 + wave * (32 * TLD * 2));
    const bf16_t* proj = (const bf16_t*)(a.ws + WS_PROJ); float* cs = (float*)(a.ws + WS_CS);
    ssd_dt_acum(a, acum, dtv, row0, g, wave, lane);
    { const int cgi = tid >> 5, tl = tid & 31, n0 = 8 * cgi; ConvW cw; convw_load(cw, a.in[I_CONVW], a.in[I_CONVB], 1024 + g * 128 + n0);
#pragma unroll
      for (int i = 0; i < 4; ++i) { const int j = tl + 32 * i; float v[8]; conv8_prompt(cw, proj, row0 + j, t0 + j, 1024 + g * 128 + n0, v);
#pragma unroll
          for (int q = 0; q < 8; ++q) BT[swz(n0 + q, j)] = f2bf(v[q]); } }
    __syncthreads();
    const int r = lane & 15, q4 = lane >> 4, e = wave, h = g * 8 + e;
    const float aend = acum[e * 128 + 127];
    float* dst = cs + ((size_t)((b * 16 + c) * 16 + h) * 64) * 128;
    for (int half = 0; half < 2; ++half) {
        { const int cgi = lane & 3, tl = lane >> 2, p0 = 32 * half + 8 * cgi; ConvW cw; convw_load(cw, a.in[I_CONVW], a.in[I_CONVB], h * 64 + p0);
#pragma unroll 4
          for (int tb = 0; tb < 8; ++tb) { const int j = 16 * tb + tl; float v[8]; conv8_prompt(cw, proj, row0 + j, t0 + j, h * 64 + p0, v);
              const float sc = dtv[e * 128 + j] * __expf(aend - acum[e * 128 + j]);
#pragma unroll
              for (int q = 0; q < 8; ++q) XW[swz(8 * cgi + q, j)] = f2bf(v[q] * sc); } }
        LDS_WAIT();
        f32x4 acc[2][8];
#pragma unroll
        for (int pt = 0; pt < 2; ++pt)
#pragma unroll
            for (int t = 0; t < 8; ++t) acc[pt][t] = (f32x4){0.f, 0.f, 0.f, 0.f};
#pragma unroll
        for (int ks = 0; ks < 4; ++ks) {
            const bf16x8 fa0 = *(const LAS bf16x8*)(XW + swzb(r, 4 * ks + q4)), fa1 = *(const LAS bf16x8*)(XW + swzb(16 + r, 4 * ks + q4));
#pragma unroll
            for (int t = 0; t < 8; ++t) { const bf16x8 fb = *(const LAS bf16x8*)(BT + swzb(16 * t + r, 4 * ks + q4));
                acc[0][t] = __builtin_amdgcn_mfma_f32_16x16x32_bf16(fa0, fb, acc[0][t], 0, 0, 0);
                acc[1][t] = __builtin_amdgcn_mfma_f32_16x16x32_bf16(fa1, fb, acc[1][t], 0, 0, 0); }
        }
#pragma unroll
        for (int pt = 0; pt < 2; ++pt)
#pragma unroll
            for (int t = 0; t < 8; ++t)
#pragma unroll
                for (int k = 0; k < 4; ++k) dst[(size_t)(32 * half + 16 * pt + 4 * q4 + k) * 128 + 16 * t + r] = acc[pt][t][k];
        LDS_WAIT();
    }
    if (lane == 0) ((float*)(a.ws + WS_DECAY))[(b * 16 + c) * 16 + h] = __expf(aend);
    __syncthreads();
}

DEVI void ssd_pass3(const Args& a, LAS unsigned char* L, int unit, int tid, int lane, int wave) {
    const int g = unit & 1, c = (unit >> 1) & 15, b = unit >> 5, row0 = b * 2048 + c * 128, t0 = c * 128;
    LAS float* acum = (LAS float*)L; LAS float* dtv = (LAS float*)(L + 4096);
    LAS bf16_t* CT = (LAS bf16_t*)(L + 8192); LAS bf16_t* BMt = (LAS bf16_t*)(L + 8192 + 34816); LAS bf16_t* XT = (LAS bf16_t*)(L + 8192 + 2 * 34816);
    LAS float* cwL = (LAS float*)(L + 8192 + 2 * 34816 + 17408);
    LAS bf16_t* MW = CT + wave * 16 * TLD;
    const bf16_t* proj = (const bf16_t*)(a.ws + WS_PROJ); const bf16_t* sin_ = (const bf16_t*)(a.ws + WS_SIN);
    bf16_t* cat = (bf16_t*)(a.ws + WS_CAT); float* ssq = (float*)(a.ws + WS_SSQ_SSD);
    const int xcg = tid >> 6, xtl = tid & 63, p0 = 8 * xcg;
    u32x4 rx[2][4], rz[2];
#define P3_LOAD_RAW(hh) do { _Pragma("unroll") for (int i_ = 0; i_ < 2; ++i_) { const int j_ = xtl + 64 * i_; \
        _Pragma("unroll") for (int w_ = 0; w_ < 4; ++w_) { const int d_ = (t0 + j_ - 3 + w_ >= 0) ? (3 - w_) : 0; \
            rx[i_][w_] = *(const u32x4*)(proj + (size_t)(row0 + j_ - d_) * NPROJ + 1024 + (hh) * 64 + p0); } \
        rz[i_] = *(const u32x4*)(proj + (size_t)(row0 + j_) * NPROJ + (hh) * 64 + p0); } } while (0)
    ssd_dt_acum(a, acum, dtv, row0, g, wave, lane);
    for (int i = tid; i < 640; i += 512) { const int w = i >> 7, c4 = (i & 127) * 4;
        *(LAS f32x4*)(cwL + w * 512 + c4) = *(const f32x4*)((w < 4 ? a.in[I_CONVW] + w * CONVD : a.in[I_CONVB]) + g * 512 + c4); }
    { const int cgi = tid & 15, tl = tid >> 4, n0 = 8 * cgi;
#pragma unroll
      for (int mat = 0; mat < 2; ++mat) { const int ch = 1024 + mat * 256 + g * 128 + n0; ConvW cw; convw_load(cw, a.in[I_CONVW], a.in[I_CONVB], ch);
          LAS bf16_t* dstm = mat ? CT : BMt;
#pragma unroll
          for (int i = 0; i < 4; ++i) { const int j = tl + 32 * i; float v[8]; conv8_prompt(cw, proj, row0 + j, t0 + j, ch, v);
              u32x4 w; w.x = cvt_pk(v[0], v[1]); w.y = cvt_pk(v[2], v[3]); w.z = cvt_pk(v[4], v[5]); w.w = cvt_pk(v[6], v[7]);
              *(LAS u32x4*)(dstm + j * TLD + n0) = w; } } }
    __syncthreads();
    const int r = lane & 15, q4 = lane >> 4;
    bf16x8 aC[4]; f32x4 cb[8];
#pragma unroll
    for (int ks = 0; ks < 4; ++ks) aC[ks] = *(const LAS bf16x8*)(CT + (16 * wave + r) * TLD + 32 * ks + 8 * q4);
#pragma unroll
    for (int t = 0; t < 8; ++t) { cb[t] = (f32x4){0.f, 0.f, 0.f, 0.f};
#pragma unroll
        for (int ks = 0; ks < 4; ++ks) { const bf16x8 fb = *(const LAS bf16x8*)(BMt + (16 * t + r) * TLD + 32 * ks + 8 * q4);
            cb[t] = __builtin_amdgcn_mfma_f32_16x16x32_bf16(aC[ks], fb, cb[t], 0, 0, 0); } }
    float ssacc[4] = {0.f, 0.f, 0.f, 0.f};
    __syncthreads();
    LAS bf16_t* const XT0 = XT; LAS bf16_t* const XT1 = (LAS bf16_t*)(L + 105472);
    LAS bf16_t* const ZT0 = BMt; LAS bf16_t* const ZT1 = (LAS bf16_t*)(L + 122880);
    P3_LOAD_RAW(g * 8);
    for (int e = 0; e < 8; ++e) {
        const int h = g * 8 + e;
        XT = (e & 1) ? XT1 : XT0; LAS bf16_t* const ZT = (e & 1) ? ZT1 : ZT0;
        {
            f32x4 wl[4][2];
#pragma unroll
            for (int w = 0; w < 4; ++w) { wl[w][0] = *(const LAS f32x4*)(cwL + w * 512 + e * 64 + p0); wl[w][1] = *(const LAS f32x4*)(cwL + w * 512 + e * 64 + p0 + 4); }
            const f32x4 bl0 = *(const LAS f32x4*)(cwL + 2048 + e * 64 + p0), bl1 = *(const LAS f32x4*)(cwL + 2048 + e * 64 + p0 + 4);
#pragma unroll
            for (int i = 0; i < 2; ++i) { const int j = xtl + 64 * i; float o[8];
#pragma unroll
                for (int q = 0; q < 4; ++q) { o[q] = bl0[q]; o[4 + q] = bl1[q]; }
#pragma unroll
                for (int w = 0; w < 4; ++w) { float x[8]; unpack8(rx[i][w], x); const float m = (t0 + j - 3 + w >= 0) ? 1.f : 0.f;
#pragma unroll
                    for (int q = 0; q < 4; ++q) { o[q] += (x[q] * m) * wl[w][0][q]; o[4 + q] += (x[4 + q] * m) * wl[w][1][q]; } }
                *(LAS u32x4*)(ZT + j * 64 + p0) = rz[i];
#pragma unroll
                for (int q = 0; q < 8; ++q) XT[swz(p0 + q, j)] = f2bf(silu_(o[q])); }
        }
        if (e < 7) P3_LOAD_RAW(h + 1);
        __syncthreads();
        float ai[4];
#pragma unroll
        for (int k = 0; k < 4; ++k) ai[k] = acum[e * 128 + 16 * wave + 4 * q4 + k];
#pragma unroll
        for (int t = 0; t < 8; ++t) { const int j = 16 * t + r; const float aj = acum[e * 128 + j], dj = dtv[e * 128 + j];
#pragma unroll
            for (int k = 0; k < 4; ++k) { const int i = 16 * wave + 4 * q4 + k; const float m = (j <= i) ? cb[t][k] * __expf(ai[k] - aj) * dj : 0.f;
                MW[(4 * q4 + k) * TLD + j] = f2bf(m); } }
        LDS_WAIT();
        f32x4 acc[4], acc2[4];
#pragma unroll
        for (int pt = 0; pt < 4; ++pt) { acc[pt] = (f32x4){0.f, 0.f, 0.f, 0.f}; acc2[pt] = (f32x4){0.f, 0.f, 0.f, 0.f}; }
        if (c > 0) {
            const bf16_t* sp = sin_ + ((size_t)((b * 16 + c) * 16 + h) * 64) * 128;
#pragma unroll
            for (int ks = 0; ks < 4; ++ks)
#pragma unroll
                for (int pt = 0; pt < 4; ++pt) { const bf16x8 fs = *(const bf16x8*)(sp + (size_t)(16 * pt + r) * 128 + 32 * ks + 8 * q4);
                    acc2[pt] = __builtin_amdgcn_mfma_f32_16x16x32_bf16(aC[ks], fs, acc2[pt], 0, 0, 0); }
        }
#pragma unroll
        for (int ks = 0; ks < 4; ++ks) {
            const bf16x8 fm = *(const LAS bf16x8*)(MW + r * TLD + 32 * ks + 8 * q4);
#pragma unroll
            for (int pt = 0; pt < 4; ++pt) { const bf16x8 fx = *(const LAS bf16x8*)(XT + swzb(16 * pt + r, 4 * ks + q4));
                acc[pt] = __builtin_amdgcn_mfma_f32_16x16x32_bf16(fm, fx, acc[pt], 0, 0, 0); }
        }
        const float Dh = a.in[I_DSSD][h];
#pragma unroll
        for (int k = 0; k < 4; ++k) {
            const int i = 16 * wave + 4 * q4 + k; const float ea = __expf(ai[k]);
#pragma unroll
            for (int pt = 0; pt < 4; ++pt) {
                const int p = 16 * pt + r;
                const float xv = bf2f(XT[swz(p, i)]);
                const float y = acc[pt][k] + ea * acc2[pt][k] + Dh * xv;
                const float z = bf2f(ZT[i * 64 + p]);
                const float yz = y * silu_(z);
                cat[(size_t)(row0 + i) * 2048 + h * 64 + p] = f2bf(yz);
                ssacc[k] += yz * yz;
            }
        }
    }
#undef P3_LOAD_RAW
#pragma unroll
    for (int k = 0; k < 4; ++k) { float s = ssacc[k]; s += shfl_xor_(s, 1); s += shfl_xor_(s, 2); s += shfl_xor_(s, 4); s += shfl_xor_(s, 8);
        if (r == 0) atomicAdd(ssq + row0 + 16 * wave + 4 * q4 + k, s); }
    __syncthreads();
}

DEVI void ssd_step(const Args& a, LAS unsigned char* L, int unit, int tid, int lane) {
    const int g = unit & 1, b = unit >> 1, row = TP + b;
    LAS float* xs = (LAS float*)L; LAS float* Bv = xs + 512; LAS float* Cv = Bv + 128; LAS float* zs = Cv + 128; LAS float* sc = zs + 512;
    const bf16_t* proj = (const bf16_t*)(a.ws + WS_PROJ);
    const int n4 = (tid & 31) * 4, pr = tid >> 5;
    const float* s0p = a.in[I_SSSM] + ((size_t)(b * 16 + g * 8) * 64) * 128; float* s1p = a.out + O_SSMS + ((size_t)(b * 16 + g * 8) * 64) * 128;
    f32x4 s0[4];
#pragma unroll
    for (int it = 0; it < 4; ++it) s0[it] = __builtin_nontemporal_load((const f32x4*)(s0p + (size_t)(it * 16 + pr) * 128 + n4));
    zs[tid] = bf2f(proj[(size_t)row * NPROJ + g * 512 + tid]);
    if (tid < 96) {
        int ch; LAS float* dst;
        if (tid < 64) { ch = g * 512 + 8 * tid; dst = xs + 8 * tid; } else if (tid < 80) { ch = 1024 + g * 128 + 8 * (tid - 64); dst = Bv + 8 * (tid - 64); } else { ch = 1280 + g * 128 + 8 * (tid - 80); dst = Cv + 8 * (tid - 80); }
        ConvW cw; convw_load(cw, a.in[I_CONVW], a.in[I_CONVB], ch);
        float o[8]; float xn[8]; unpack8(*(const u32x4*)(proj + (size_t)row * NPROJ + 1024 + ch), xn);
#pragma unroll
        for (int j = 0; j < 8; ++j) o[j] = cw.b[j] + xn[j] * cw.w[3][j];
#pragma unroll
        for (int w = 0; w < 3; ++w) { const float* sp = a.in[I_SCONV] + ((size_t)b * 3 + w) * CONVD + ch; const f32x4 p = *(const f32x4*)sp, q = *(const f32x4*)(sp + 4);
#pragma unroll
            for (int j = 0; j < 4; ++j) { o[j] += p[j] * cw.w[w][j]; o[4 + j] += q[j] * cw.w[w][4 + j]; } }
#pragma unroll
        for (int j = 0; j < 8; ++j) dst[j] = silu_(o[j]);
    }
    if (tid >= 128 && tid < 136) { const int h = g * 8 + tid - 128; const float dt = softplus_(((const float*)(a.ws + WS_DTRAW))[(size_t)row * 16 + h] + a.in[I_DTB][h]);
        sc[tid - 128] = dt; sc[8 + tid - 128] = expf(-expf(a.in[I_ALOG][h]) * dt); }
    __syncthreads();
    const f32x4 bv = *(const LAS f32x4*)(Bv + n4), cv = *(const LAS f32x4*)(Cv + n4);
    bf16_t* cat = (bf16_t*)(a.ws + WS_CAT); float* ssq = (float*)(a.ws + WS_SSQ_SSD);
    float ssl = 0.f;
    for (int e = 0; e < 8; ++e) {
        const int h = g * 8 + e; const float dt = sc[e], dA = sc[8 + e], Dh = a.in[I_DSSD][h];
        f32x4 sn[4];
#pragma unroll
        for (int it = 0; it < 4; ++it) sn[it] = s0[it] * dA + bv * (dt * xs[e * 64 + it * 16 + pr]);
        if (e < 7) {
#pragma unroll
            for (int it = 0; it < 4; ++it) s0[it] = __builtin_nontemporal_load((const f32x4*)(s0p + (size_t)((e + 1) * 64 + it * 16 + pr) * 128 + n4));
        }
#pragma unroll
        for (int it = 0; it < 4; ++it) {
            const int p = it * 16 + pr;
            __builtin_nontemporal_store(sn[it], (f32x4*)(s1p + (size_t)(e * 64 + p) * 128 + n4));
            float part = (cv[0] * sn[it][0] + cv[1] * sn[it][1]) + (cv[2] * sn[it][2] + cv[3] * sn[it][3]);
            part += shfl_xor_(part, 1); part += shfl_xor_(part, 2); part += shfl_xor_(part, 4); part += shfl_xor_(part, 8); part += shfl_xor_(part, 16);
            if ((tid & 31) == 0) {
                const float y = part + Dh * xs[e * 64 + p]; const float yz = y * silu_(zs[e * 64 + p]);
                cat[(size_t)row * 2048 + h * 64 + p] = f2bf(yz); ssl += yz * yz;
            }
        }
    }
    if ((tid & 31) == 0) sc[16 + pr] = ssl;
    __syncthreads();
    if (tid == 0) { float t = 0.f;
#pragma unroll
        for (int i = 0; i < 16; ++i) t += sc[16 + i];
        atomicAdd(ssq + row, t); }
    __syncthreads();
}

struct S5Setup { float lbr, lbi; bf16x8 fB[8], bC[4], fD; };
template <bool WRITE_Y>
DEVI void s5_setup(const Args& a, S5Setup& st, int g, int lane) {
    const int p = lane, gp = g * 64 + p, r = lane & 15, q4 = lane >> 4;
    const float lr = a.in[I_LAMR][gp], li = a.in[I_LAMI][gp], step = expf(a.in[I_LSTEP][g]);
    const float mag = expf(lr * step); float sn, cs; sincosf(li * step, &sn, &cs);
    const float lbr = mag * cs, lbi = mag * sn; st.lbr = lbr; st.lbi = lbi; const float den = lr * lr + li * li;
    const float kre = ((lbr - 1.f) * lr + lbi * li) / den, kim = (lbi * lr - (lbr - 1.f) * li) / den;
#pragma unroll
    for (int jt = 0; jt < 4; ++jt) {
        const int pp = 16 * jt + r; const float kr = shfl_(kre, pp), ki = shfl_(kim, pp);
        const float* bp = a.in[I_BRE] + (size_t)(g * 64 + pp) * 16 + 8 * (q4 & 1); const float* bq = a.in[I_BIM] + (size_t)(g * 64 + pp) * 16 + 8 * (q4 & 1);
        const f32x4 br0 = *(const f32x4*)bp, br1 = *(const f32x4*)(bp + 4), bi0 = *(const f32x4*)bq, bi1 = *(const f32x4*)(bq + 4);
        u32x4 wr = pack8(br0 * kr - bi0 * ki, br1 * kr - bi1 * ki), wi = pack8(bi0 * kr + br0 * ki, bi1 * kr + br1 * ki);
        if (q4 >= 2) { wr = (u32x4){0u, 0u, 0u, 0u}; wi = (u32x4){0u, 0u, 0u, 0u}; }
        st.fB[jt] = *(const bf16x8*)&wr; st.fB[4 + jt] = *(const bf16x8*)&wi;
    }
    if (WRITE_Y) {
#pragma unroll
        for (int ks = 0; ks < 4; ++ks) { const float* src = (ks < 2 ? a.in[I_CRE] : a.in[I_CIM]) + (size_t)(g * 16 + r) * 64 + 32 * (ks & 1) + 8 * q4;
            f32x4 v0 = *(const f32x4*)src, v1 = *(const f32x4*)(src + 4); if (ks >= 2) { v0 = -v0; v1 = -v1; }
            const u32x4 w = pack8(v0, v1); st.bC[ks] = *(const bf16x8*)&w; }
        const float dv = a.in[I_DS5][g * 16 + r]; f32x4 d0, d1;
#pragma unroll
        for (int j = 0; j < 4; ++j) { d0[j] = (q4 < 2 && 8 * q4 + j == r) ? dv : 0.f; d1[j] = (q4 < 2 && 8 * q4 + 4 + j == r) ? dv : 0.f; }
        const u32x4 w = pack8(d0, d1); st.fD = *(const bf16x8*)&w;
    }
}
template <bool WRITE_Y>
DEVI void s5_unit(const Args& a, const S5Setup& st, LAS unsigned char* Lw, int g, int row0_, int ntok, const float* cin_re_, const float* cin_im_, float* out_re_, float* out_im_, int lane, int nseq, int seq_rows, int seq_state) {
    LAS float* BU = (LAS float*)Lw; LAS bf16_t* SX = (LAS bf16_t*)(Lw + 10240);
    const bf16_t* proj = (const bf16_t*)(a.ws + WS_PROJ); bf16_t* gb = (bf16_t*)(a.ws + WS_GB);
    const int p = lane, r = lane & 15, q4 = lane >> 4;
    const float lbr = st.lbr, lbi = st.lbi;
  for (int sq = 0; sq < nseq; ++sq) {
    const int row0 = row0_ + sq * seq_rows;
    const float* cin_re = cin_re_ ? cin_re_ + (size_t)sq * seq_state : nullptr; const float* cin_im = cin_im_ ? cin_im_ + (size_t)sq * seq_state : nullptr;
    float* out_re = out_re_ ? out_re_ + (size_t)sq * seq_state : nullptr; float* out_im = out_im_ ? out_im_ + (size_t)sq * seq_state : nullptr;
    float sre = cin_re ? cin_re[p] : 0.f, sim = cin_im ? cin_im[p] : 0.f;
    const bf16_t* up = proj + (size_t)(row0 + r) * NPROJ + 2560 + g * 16 + 8 * (q4 & 1);
    u32x4 un = (u32x4){0u, 0u, 0u, 0u};
    if (q4 < 2 && r < ntok) un = *(const u32x4*)up;
    for (int tb = 0; tb < ntok; tb += 16) {
        const int nt = (ntok - tb) < 16 ? (ntok - tb) : 16;
        const u32x4 uc = un; const bf16x8 fu = *(const bf16x8*)&uc;
        un = (u32x4){0u, 0u, 0u, 0u};
        if (q4 < 2 && tb + 16 + r < ntok) un = *(const u32x4*)(up + (size_t)(tb + 16) * NPROJ);
#pragma unroll
        for (int j = 0; j < 8; ++j) { const f32x4 d = __builtin_amdgcn_mfma_f32_16x16x32_bf16(fu, st.fB[j], (f32x4){0.f, 0.f, 0.f, 0.f}, 0, 0, 0);
            *(LAS f32x4*)(BU + (64 * (j >> 2) + 16 * (j & 3) + r) * 20 + 4 * q4) = d; }
        LDS_WAIT();
        float bur[16], bui[16];
#pragma unroll
        for (int i = 0; i < 4; ++i) { const f32x4 vr = *(const LAS f32x4*)(BU + p * 20 + 4 * i), vi = *(const LAS f32x4*)(BU + (64 + p) * 20 + 4 * i);
#pragma unroll
            for (int k = 0; k < 4; ++k) { bur[4 * i + k] = vr[k]; bui[4 * i + k] = vi[k]; } }
#pragma unroll
        for (int tl = 0; tl < 16; ++tl) {
            if (tl < nt) {
                const float nr = lbr * sre - lbi * sim + bur[tl], ni = lbr * sim + lbi * sre + bui[tl];
                sre = nr; sim = ni;
                if (WRITE_Y) { SX[tl * TLD + p] = f2bf(sre); SX[tl * TLD + 64 + p] = f2bf(sim); }
            }
        }
        if (WRITE_Y) {
            LDS_WAIT();
            f32x4 acc = __builtin_amdgcn_mfma_f32_16x16x32_bf16(fu, st.fD, (f32x4){0.f, 0.f, 0.f, 0.f}, 0, 0, 0);
#pragma unroll
            for (int ks = 0; ks < 4; ++ks) { const bf16x8 fa = *(const LAS bf16x8*)(SX + r * TLD + 32 * ks + 8 * q4); acc = __builtin_amdgcn_mfma_f32_16x16x32_bf16(fa, st.bC[ks], acc, 0, 0, 0); }
#pragma unroll
            for (int k = 0; k < 4; ++k) { const int tl = 4 * q4 + k;
                if (tl < nt) gb[(size_t)(row0 + tb + tl) * 1024 + g * 16 + r] = f2bf(gelu_(acc[k])); }
        }
        LDS_WAIT();
    }
    if (out_re) { out_re[p] = sre; out_im[p] = sim; }
  }
}

DEVI void attn_sample(const Args& a, LAS unsigned char* L, int unit, int tid, int lane, int wave) {
    const int h = unit & 3, b = unit >> 2, row = TP + b;
    LAS float* qs = (LAS float*)L; LAS float* sc = qs + 256; LAS float* red = sc + 256;
    const bf16_t* qb = (const bf16_t*)(a.ws + WS_QB); bf16_t* ob = (bf16_t*)(a.ws + WS_OB);
    const float* kp = a.in[I_CK] + ((size_t)(b * 256 + wave * 32) * 4 + h) * 256 + 4 * lane;
    const float* vp = a.in[I_CV] + ((size_t)(b * 256 + wave * 32) * 4 + h) * 256 + 4 * lane;
    f32x4 kv[32];
#pragma unroll
    for (int i = 0; i < 32; ++i) kv[i] = __builtin_nontemporal_load((const f32x4*)(kp + (size_t)i * 1024));
    if (tid < 256) qs[tid] = bf2f(qb[(size_t)row * 1024 + h * 256 + tid]);
    __syncthreads();
    const f32x4 q = *(const LAS f32x4*)(qs + 4 * lane);
    float myd = 0.f;
#pragma unroll
    for (int i = 0; i < 32; ++i) { const float d = wave_sum((kv[i][0] * q[0] + kv[i][1] * q[1]) + (kv[i][2] * q[2] + kv[i][3] * q[3])); if (lane == i) myd = d; }
    if (lane < 32) sc[wave * 32 + lane] = myd;
#pragma unroll
    for (int i = 0; i < 32; ++i) kv[i] = __builtin_nontemporal_load((const f32x4*)(vp + (size_t)i * 1024));
    __syncthreads();
    const f32x4 s4 = *(const LAS f32x4*)(sc + 4 * lane);
    float mx = fmaxf(fmaxf(s4[0], s4[1]), fmaxf(s4[2], s4[3]));
#pragma unroll
    for (int o = 1; o < 64; o <<= 1) mx = fmaxf(mx, shfl_xor_(mx, o));
    const float inv = 1.f / wave_sum((__expf(s4[0] - mx) + __expf(s4[1] - mx)) + (__expf(s4[2] - mx) + __expf(s4[3] - mx)));
    f32x4 acc = (f32x4){0.f, 0.f, 0.f, 0.f};
#pragma unroll
    for (int i = 0; i < 32; ++i) { const float pm = __expf(sc[wave * 32 + i] - mx) * inv; acc += kv[i] * pm; }
    *(LAS f32x4*)(red + wave * 256 + 4 * lane) = acc;
    __syncthreads();
    if (tid < 256) { float o = 0.f;
#pragma unroll
        for (int w = 0; w < 8; ++w) o += red[w * 256 + tid];
        ob[(size_t)row * 1024 + h * 256 + tid] = f2bf(o); }
    __syncthreads();
}

constexpr int NPH = 14;
__global__ void __launch_bounds__(512, 2) hymba_fwd(Args a) {
    extern __shared__ __attribute__((aligned(16))) unsigned char lds_raw[];
    LAS unsigned char* L = (LAS unsigned char*)lds_raw;
    const int wave = __builtin_amdgcn_readfirstlane((int)threadIdx.x >> 6);
#define lane (lane_id_())
#define tid (wave * 64 + lane_id_())
    const int G = gridDim.x, bid = blockIdx.x, gw = bid * 8 + wave, NGW = G * 8, NT = G * 512;
#define gt (bid * 512 + tid)
    unsigned char* ws = a.ws;
    volatile LAS unsigned* MISC = (volatile LAS unsigned*)(L + MISC_OFF);
    if (tid < 32) MISC[tid] = 0u;
    __syncthreads();
    XcdBarrier bar; bar.bar = (unsigned*)(ws + WS_BAR); bar.x = 0; bar.st = nullptr;
    if (a.ph_hi - a.ph_lo > 1) bar = xcd_barrier_post((unsigned*)(ws + WS_BAR), MISC + 8, wave == 0 && lane_id_() == 0);
    if (a.ph_lo < 0) cg::this_grid().sync();
    const int lo = a.ph_lo, hi = a.ph_hi;
#define IN(k) (lo <= (k) && (k) < hi)
#ifndef PROBE_BAR2
#define PROBE_BAR2 0
#endif
#ifndef PROBE_MASK
#define PROBE_MASK 0
#endif
    unsigned long long tph = PROBE_MASK ? __builtin_amdgcn_s_memrealtime() : 0ull;
#ifndef PROBE_SUB
#define PROBE_SUB 0
#endif
    unsigned long long ts0 = 0ull;
#define SUBSPIN(id) do { if (PROBE_SUB == (id)) { __syncthreads(); const unsigned long long t1_ = __builtin_amdgcn_s_memrealtime(), d_ = t1_ - ts0; while (__builtin_amdgcn_s_memrealtime() - t1_ < d_) __builtin_amdgcn_s_sleep(8); } if (PROBE_SUB) ts0 = __builtin_amdgcn_s_memrealtime(); } while (0)
#define SEAM(k) do { if (((PROBE_MASK) >> (k)) & 1) { __syncthreads(); const unsigned long long t1_ = __builtin_amdgcn_s_memrealtime(), d_ = t1_ - tph; \
        while (__builtin_amdgcn_s_memrealtime() - t1_ < d_) __builtin_amdgcn_s_sleep(8); } \
    if (IN(k) && IN((k) + 1)) { xcd_barrier(bar, wave); if (PROBE_BAR2) xcd_barrier(bar, wave); } if (PROBE_MASK) tph = __builtin_amdgcn_s_memrealtime(); } while (0)
    bf16_t* const proj = (bf16_t*)(ws + WS_PROJ);
    float* const x1f = (float*)(ws + WS_X1F);

    if (IN(0)) { p0_prologue(a, L, tid, lane, wave); __syncthreads(); } SEAM(0);

    if (IN(1)) {
        { pg8::Gemm g{(const bf16_t*)(ws + WS_HB), (const bf16_t*)(ws + WS_WT_IN), 1024, 1024, 1024, 0}; pg8::StaticOrder S; S.init(SKN(1) ? 64 : 65, 14, G, bid);
          const FIn fin{proj, a.out + O_CONVP, a.out + O_CONVS}; pg8::EpiRow<FIn> E{fin}; pg8::gemm_phase(L, g, S, E, wave);
          for (int u = G - 1 - bid - 64; SKN(1) && u >= 0 && u < 56; u += G) sgemm_unit((const bf16_t*)(ws + WS_HB) + (size_t)TP * 1024, 1024, (const bf16_t*)(ws + WS_WT_IN), 1024, 1024, u >> 2, u & 3, fin, lane, wave); }
        { pg8::Gemm g{(const bf16_t*)(ws + WS_MEMB), (const bf16_t*)(ws + WS_WT_KV), 1024, 1024, 1024, 0}; pg8::StaticOrder S; S.init(8, 8, G, G - 1 - bid);
          pg8::EpiRow<FKV> E{FKV{a.out + O_MEMK, a.out + O_MEMV, (bf16_t*)(ws + WS_KB), (bf16_t*)(ws + WS_VT)}}; pg8::gemm_phase(L, g, S, E, wave); }
    } SEAM(1);

    if (IN(2)) {
        if (PROBE_SUB) ts0 = __builtin_amdgcn_s_memrealtime();
        for (int u = bid; u < 256; u += G) ssd_pass1(a, L, u, tid, lane, wave);
        SUBSPIN(1);
        for (int u = bid; u < 256; u += G) ssd_step(a, L, u, tid, lane);
        SUBSPIN(2);
        float* er = (float*)(ws + WS_S5END); float* ei = er + 8 * 64 * S5NCH * 64;
        { S5Setup st; int gc = -1;
          for (int u = gw; u < 8 * 64 * S5NCH; u += NGW) { const int g = (u & 7) | (((u >> 6) & 7) << 3), k = (u >> 3) & 7, b = u >> 9;
            const size_t ix = (size_t)((b * 64 + g) * S5NCH + k) * 64;
            if (g != gc) { s5_setup<false>(a, st, g, lane); gc = g; }
            s5_unit<false>(a, st, L + wave * 14592, g, b * 2048 + k * S5LC, S5LC, nullptr, nullptr, er + ix, ei + ix, lane, 1, 0, 0); } }
    } SEAM(2);

    if (IN(3)) {
        p3_weights(a, L, lane, wave);
        const float* cs = (const float*)(ws + WS_CS); const float* dec = (const float*)(ws + WS_DECAY); bf16_t* sin_ = (bf16_t*)(ws + WS_SIN); float* sout = a.out + O_SSMP;
        for (int i = gt; i < 8 * 16 * 64 * 32; i += NT) {
            const int n4 = (i & 31) * 4, p = (i >> 5) & 63, h = (i >> 11) & 15, b = i >> 15;
            f32x4 S = (f32x4){0.f, 0.f, 0.f, 0.f};
            f32x4 cv[16]; float dv[16];
#pragma unroll
            for (int c = 0; c < 16; ++c) { cv[c] = __builtin_nontemporal_load((const f32x4*)(cs + ((size_t)((b * 16 + c) * 16 + h) * 64 + p) * 128 + n4)); dv[c] = dec[(b * 16 + c) * 16 + h]; }
#pragma unroll
            for (int c = 0; c < 16; ++c) { const size_t off = ((size_t)((b * 16 + c) * 16 + h) * 64 + p) * 128 + n4;
                u32x2 w; w.x = cvt_pk(S[0], S[1]); w.y = cvt_pk(S[2], S[3]); *(u32x2*)(sin_ + off) = w;
                S = S * dv[c] + cv[c]; }
            *(f32x4*)(sout + ((size_t)(b * 16 + h) * 64 + p) * 128 + n4) = S;
        }
        const float* er = (const float*)(ws + WS_S5END); const float* ei = er + 8 * 64 * S5NCH * 64; float* cr = (float*)(ws + WS_S5CAR); float* ci = cr + 8 * 64 * S5NCH * 64;
        for (int i = gt; i < 8 * 64 * 64; i += NT) {
            const int p = i & 63, g = (i >> 6) & 63, b = i >> 12, gp = g * 64 + p;
            const float lr = a.in[I_LAMR][gp], li = a.in[I_LAMI][gp], step = expf(a.in[I_LSTEP][g]);
            const float mag = expf(lr * step); float sn, cs_; sincosf(li * step, &sn, &cs_);
            float pr = mag * cs_, pi = mag * sn;
#pragma unroll
            for (int s = 0; s < 8; ++s) { const float nr = pr * pr - pi * pi, ni = 2.f * pr * pi; pr = nr; pi = ni; }
            float c_r = 0.f, c_i = 0.f; float evr[S5NCH], evi[S5NCH];
#pragma unroll
            for (int k = 0; k < S5NCH; ++k) { const size_t off = ((size_t)((b * 64 + g) * S5NCH + k)) * 64 + p; evr[k] = er[off]; evi[k] = ei[off]; }
#pragma unroll
            for (int k = 0; k < S5NCH; ++k) { const size_t off = ((size_t)((b * 64 + g) * S5NCH + k)) * 64 + p;
                cr[off] = c_r; ci[off] = c_i;
                const float nr = pr * c_r - pi * c_i + evr[k], ni = pr * c_i + pi * c_r + evi[k]; c_r = nr; c_i = ni; }
            a.out[O_S5RP + (size_t)(b * 64 + g) * 64 + p] = c_r; a.out[O_S5IP + (size_t)(b * 64 + g) * 64 + p] = c_i;
        }
    } SEAM(3);

    if (IN(4)) {
        if (PROBE_SUB) ts0 = __builtin_amdgcn_s_memrealtime();
        for (int u = bid; u < 256; u += G) ssd_pass3(a, L, u, tid, lane, wave);
        SUBSPIN(4);
        const float* cr = (const float*)(ws + WS_S5CAR); const float* ci = cr + 8 * 64 * S5NCH * 64;
        { S5Setup st; int gc = -1;
          for (int u = gw; u < 8 * 64 * S5NCH + 2048; u += NGW) {
            if (u < 8 * 64 * S5NCH) { const int g = (u & 7) | (((u >> 6) & 7) << 3), k = (u >> 3) & 7, b = u >> 9;
                const size_t ix = (size_t)((b * 64 + g) * S5NCH + k) * 64;
                if (g != gc) { s5_setup<true>(a, st, g, lane); gc = g; }
                s5_unit<true>(a, st, L + wave * 14592, g, b * 2048 + k * S5LC, S5LC, cr + ix, ci + ix, nullptr, nullptr, lane, 1, 0, 0); }
            else { const int v = u - 8 * 64 * S5NCH, g = (v & 7) | (((v >> 6) & 7) << 3), b4 = (((v >> 3) & 7) | ((v >> 9) << 3)) * 4; const size_t so = (size_t)(b4 * 64 + g) * 64;
                if (g != gc) { s5_setup<true>(a, st, g, lane); gc = g; }
                s5_unit<true>(a, st, L + wave * 14592, g, TP + b4, 1, a.in[I_SS5R] + so, a.in[I_SS5I] + so, a.out + O_S5RS + so, a.out + O_S5IS + so, lane, 4, 1, 64 * 64); }
          } }
        __syncthreads();
    } SEAM(4);

    if (IN(5)) {
        pg8::Gemm g{(const bf16_t*)(ws + WS_GB), (const bf16_t*)(ws + WS_WT_GLU), 1024, 1024, 1024, 0}; pg8::StaticOrder S; S.init(SKN(5) ? 64 : 65, 4, G, bid);
        const FGlu fg{(const bf16_t*)(ws + WS_GB), a.in[I_BGLU], (bf16_t*)(ws + WS_CAT), (const float*)(ws + WS_SSQ_SSD)}; pg8::EpiRow<FGlu> E{fg}; pg8::gemm_phase(L, g, S, E, wave);
        if (PROBE_SUB) { __syncthreads(); ts0 = __builtin_amdgcn_s_memrealtime(); }
        for (int u = bid; SKN(5) && u < 128; u += G) sgemm3_unit(L, (const bf16_t*)(ws + WS_GB) + (size_t)TP * 1024, 1024, (const bf16_t*)(ws + WS_WT_GLU), 1024, 1024, u, fg, lane, wave);
        SUBSPIN(5);
    } SEAM(5);

    if (IN(6)) {
        pg8::Gemm g{(const bf16_t*)(ws + WS_CAT), (const bf16_t*)(ws + WS_WT_OUT), 2048, 2048, 2048, 0}; pg8::StaticOrder S; S.init(SKN(6) ? 64 : 65, 4, G, bid);
        const FResT<false> fr{a.in[I_XP], a.in[I_XS], nullptr, nullptr, (bf16_t*)(ws + WS_X1B), (float*)(ws + WS_SSQ1)}; pg8::EpiRow<FResT<false>> E{fr}; pg8::gemm_phase(L, g, S, E, wave, (const float*)(ws + WS_SSQ_SSD));
        if (PROBE_SUB) { __syncthreads(); ts0 = __builtin_amdgcn_s_memrealtime(); }
        for (int u = bid; SKN(6) && u < 128; u += G) sgemm3_unit(L, (const bf16_t*)(ws + WS_CAT) + (size_t)TP * 2048, 2048, (const bf16_t*)(ws + WS_WT_OUT), 2048, 2048, u, fr, lane, wave, (const float*)(ws + WS_SSQ_SSD));
        SUBSPIN(5);
    } SEAM(6);

    if (IN(7)) {
        pg8::Gemm g{(const bf16_t*)(ws + WS_X1B), (const bf16_t*)(ws + WS_WT_XQ), 1024, 1024, 1024, 0}; pg8::StaticOrder S; S.init(SKN(7) ? 64 : 65, 4, G, bid);
        const FQ fq_{(bf16_t*)(ws + WS_QB), (const float*)(ws + WS_SSQ1)}; pg8::EpiRow<FQ> E{fq_}; pg8::gemm_phase(L, g, S, E, wave);
        if (PROBE_SUB) { __syncthreads(); ts0 = __builtin_amdgcn_s_memrealtime(); }
        for (int u = bid; SKN(7) && u < 128; u += G) sgemm3_unit(L, (const bf16_t*)(ws + WS_X1B) + (size_t)TP * 1024, 1024, (const bf16_t*)(ws + WS_WT_XQ), 1024, 1024, u, fq_, lane, wave);
        SUBSPIN(5);
    } SEAM(7);

    if (IN(8)) {
        { pg8::Gemm g{(const bf16_t*)(ws + WS_QB), (const bf16_t*)(ws + WS_KB), 1024, 1024, 256, 1}; pg8::StaticOrder S; S.init(64, 4, G, bid);
          pg8::EpiRow<FS> E{FS{(bf16_t*)(ws + WS_PB), (float*)(ws + WS_LSUM)}}; pg8::gemm_phase(L, g, S, E, wave); }
    }

    if (IN(9)) {
        pg8::Gemm g{(const bf16_t*)(ws + WS_PB), (const bf16_t*)(ws + WS_VT), 1024, 256, 256, 2}; pg8::StaticOrder S; S.init(64, 4, G, bid);
        pg8::EpiRow<FPV> E{FPV{(bf16_t*)(ws + WS_OB), (const float*)(ws + WS_LSUM)}}; pg8::gemm_phase(L, g, S, E, wave);
        for (int u = bid; u < TS * 4; u += G) attn_sample(a, L, u, tid, lane, wave);
    } SEAM(9);

    if (IN(10)) {
        pg8::Gemm g{(const bf16_t*)(ws + WS_OB), (const bf16_t*)(ws + WS_WT_XO), 1024, 1024, 1024, 0}; pg8::StaticOrder S; S.init(SKN(10) ? 64 : 65, 4, G, bid);
        bf16_t* const x1b = (bf16_t*)(ws + WS_X1B);
        const FResT<true> fr{x1b, x1b + (size_t)TP * 1024, nullptr, nullptr, x1b, (float*)(ws + WS_SSQ2)}; pg8::EpiRow<FResT<true>> E{fr}; pg8::gemm_phase(L, g, S, E, wave);
        if (PROBE_SUB) { __syncthreads(); ts0 = __builtin_amdgcn_s_memrealtime(); }
        for (int u = bid; SKN(10) && u < 128; u += G) sgemm3_unit(L, (const bf16_t*)(ws + WS_OB) + (size_t)TP * 1024, 1024, (const bf16_t*)(ws + WS_WT_XO), 1024, 1024, u, fr, lane, wave);
        SUBSPIN(5);
    } SEAM(10);

    if (IN(11)) {
        pg8::Gemm g{(const bf16_t*)(ws + WS_X1B), (const bf16_t*)(ws + WS_WT_GU), 1024, 1024, 1024, 0}; pg8::StaticOrder S; S.init(SKN(11) ? 64 : 65, 22, G, bid);
        const FUp fu{(bf16_t*)(ws + WS_MID), (const float*)(ws + WS_SSQ2)}; pg8::EpiRow<FUp> E{fu}; pg8::gemm_phase(L, g, S, E, wave);
        for (int u = G - 1 - bid; SKN(11) && u < 88; u += G) sgemm_unit((const bf16_t*)(ws + WS_X1B) + (size_t)TP * 1024, 1024, (const bf16_t*)(ws + WS_WT_GU), 1024, 1024, u >> 2, u & 3, fu, lane, wave);
    } SEAM(11);

    if (IN(12)) {
        pg8::Gemm g{(const bf16_t*)(ws + WS_MID), (const bf16_t*)(ws + WS_WT_DOWN), DFF, DFF, DFF, 0}; pg8::StaticOrder S; S.init(SKN(12) ? 64 : 65, 4, G, bid);
        bf16_t* const x1b = (bf16_t*)(ws + WS_X1B);
        const FResT<true> fr{x1b, x1b + (size_t)TP * 1024, a.out + O_YP, a.out + O_YS, nullptr, (float*)(ws + WS_SSQ3)};
        const bool fuse_norm = SKN(12) && G == 256 && (hi - lo > 1);
        if (fuse_norm) { const EpiFinal E{x1b, a.out + O_YP, (float*)(ws + WS_SSQ3), a.in[I_FING], &bar, wave}; pg8::gemm_phase(L, g, S, E, wave); }
        else { pg8::EpiRow<FResT<true>> E{fr}; pg8::gemm_phase(L, g, S, E, wave); }
        if (PROBE_SUB) { __syncthreads(); ts0 = __builtin_amdgcn_s_memrealtime(); }
        for (int u = bid; SKN(12) && u < 128; u += G) sgemm3_unit(L, (const bf16_t*)(ws + WS_MID) + (size_t)TP * DFF, DFF, (const bf16_t*)(ws + WS_WT_DOWN), DFF, DFF, u, fr, lane, wave);
        SUBSPIN(5);
    } SEAM(12);

    if (IN(13)) {
        const float* ssq = (const float*)(ws + WS_SSQ3); const float* fg = a.in[I_FING];
        const bool fused13 = SKN(12) && G == 256 && (hi - lo > 1);
        for (int row0 = fused13 ? TP + gw : gw; row0 < TP + TS; row0 += 4 * NGW) {
            f32x4 v[4][4]; float rs[4]; float* yp[4];
#pragma unroll
            for (int i = 0; i < 4; ++i) { const int row = row0 + i * NGW; const bool ok = row < TP + TS; const int rr = ok ? row : row0;
                yp[i] = (rr < TP ? a.out + O_YP + (size_t)rr * 1024 : a.out + O_YS + (size_t)(rr - TP) * 1024) + 4 * lane;
                rs[i] = rsqrtf(ssq[rr] * (1.f / 1024.f) + EPS);
#pragma unroll
                for (int j = 0; j < 4; ++j) v[i][j] = *(const f32x4*)(yp[i] + 256 * j); }
#pragma unroll
            for (int i = 0; i < 4; ++i) { const int row = row0 + i * NGW;
                if (row < TP + TS) {
#pragma unroll
                    for (int j = 0; j < 4; ++j) { const f32x4 gg = *(const f32x4*)(fg + 4 * lane + 256 * j); *(f32x4*)(yp[i] + 256 * j) = v[i][j] * rs[i] * gg; } } }
        }
    } SEAM(13);
#undef IN
#undef SEAM
#undef lane
#undef tid
#undef gt
}

extern "C" void kernel_launch(void* const* d_in, const int* in_sizes, int n_in, void* d_out, int out_size, void* d_ws, size_t ws_size, hipStream_t stream) {
    static int grid = 0;
    if (grid == 0) {
        if (n_in != 38 || ws_size < WS_END) { fprintf(stderr, "kernel_launch: unexpected n_in %d / ws %zu\n", n_in, ws_size); grid = -1; return; }
        int dev = 0, cus = 0, per_cu = 0;
        if (hipGetDevice(&dev) != hipSuccess || hipDeviceGetAttribute(&cus, hipDeviceAttributeMultiprocessorCount, dev) != hipSuccess) { grid = -1; return; }
        if (hipFuncSetAttribute((const void*)hymba_fwd, hipFuncAttributeMaxDynamicSharedMemorySize, LDS_BYTES) != hipSuccess) { fprintf(stderr, "kernel_launch: hipFuncSetAttribute failed\n"); grid = -1; return; }
        if (hipOccupancyMaxActiveBlocksPerMultiprocessor(&per_cu, (const void*)hymba_fwd, 512, LDS_BYTES) != hipSuccess || per_cu < 1) { fprintf(stderr, "kernel_launch: occupancy query says %d\n", per_cu); per_cu = 1; }
        (void)hipGetLastError();
        grid = cus;
    }
    if (grid < 0) return;
    (void)hipMemsetAsync((char*)d_ws + WS_BAR, 0, XCD_BAR_WORDS * 4, stream);
    Args a{};
    for (int i = 0; i < 38; ++i) a.in[i] = (const float*)d_in[i];
    a.out = (float*)d_out; a.ws = (unsigned char*)d_ws;
#if MK_MULTI
    for (int ph = 0; ph < NPH; ++ph) { a.ph_lo = ph; a.ph_hi = ph + 1; hipLaunchKernelGGL(hymba_fwd, dim3(grid), dim3(512), LDS_BYTES, stream, a); }
#else
    a.ph_lo = 0; a.ph_hi = NPH;
    void* args[] = {&a};
    hipError_t e = hipLaunchCooperativeKernel((const void*)hymba_fwd, dim3(grid), dim3(512), args, LDS_BYTES, stream);
    if (e != hipSuccess) fprintf(stderr, "kernel_launch: cooperative launch failed: %s (grid %d)\n", hipGetErrorString(e), grid);
#endif
}
```
